# Optimizing an MI355X kernel written in HIP

```python
import jax
import jax.numpy as jnp
from jax import lax
import numpy as np


D_MODEL = 2048
BATCH = 2
SEQ = 16384
DEPTH = 4

PLE_DIM = 256
D_FF = 4 * D_MODEL
N_EVEN = (DEPTH + 1) // 2
N_ODD = DEPTH // 2
NORM_EPS = 1e-6

POOL_WINDOWS = (2, 4, 8, 16)
POOL_GROUP = D_MODEL // 16
POOL_WIDTH = POOL_GROUP * len(POOL_WINDOWS)

GLA_HEADS = 4
GLA_WIDTH = D_MODEL - POOL_WIDTH
GLA_DV = GLA_WIDTH // GLA_HEADS
GLA_DK = GLA_DV // 2
GLA_QK = GLA_HEADS * GLA_DK
GLA_GATE_RANK = 16
GLA_TAU = 16.0
GLA_CHUNK = 64
EVEN_SPLITS = (POOL_WIDTH, POOL_WIDTH + GLA_QK, POOL_WIDTH + 2 * GLA_QK,
               POOL_WIDTH + 2 * GLA_QK + GLA_WIDTH, POOL_WIDTH + 2 * GLA_QK + 2 * GLA_WIDTH)
EVEN_IN = POOL_WIDTH + 2 * GLA_QK + 2 * GLA_WIDTH + GLA_GATE_RANK
EVEN_MIX = POOL_WIDTH + GLA_WIDTH

RWKV_HEAD = 64
RWKV_WIDTH = D_MODEL // 2
RWKV_HEADS = RWKV_WIDTH // RWKV_HEAD
RWKV_DECAY_RANK = 64
RWKV_A_RANK = 64
RWKV_GATE_RANK = 160
RWKV_SPLITS = (RWKV_WIDTH, 2 * RWKV_WIDTH, 3 * RWKV_WIDTH, 3 * RWKV_WIDTH + RWKV_DECAY_RANK,
               3 * RWKV_WIDTH + RWKV_DECAY_RANK + RWKV_A_RANK)
RWKV_IN = 3 * RWKV_WIDTH + RWKV_DECAY_RANK + RWKV_A_RANK + RWKV_GATE_RANK
RWKV_LN_EPS = 64e-5

DIL_WIDTH = D_MODEL - RWKV_WIDTH
DIL_HEAD = 128
DIL_HEADS = DIL_WIDTH // DIL_HEAD
DIL_PATTERNS = ((128, 1), (512, 4), (2048, 16))
DIL_BLOCK = 128
ROPE_THETA = 10000.0
ODD_IN = RWKV_IN + 3 * DIL_WIDTH
ODD_MIX = RWKV_WIDTH + DIL_WIDTH

kernel_name = 'hybrid_pool_gla_rwkv7_dilated_trunk'


def rmsnorm(x, g):
    xf = x.astype(jnp.float32)
    y = xf * lax.rsqrt(jnp.mean(xf * xf, axis=-1, keepdims=True) + NORM_EPS)
    return (y * g.astype(jnp.float32)).astype(x.dtype)


def shift_prev(h):
    return jnp.pad(h[:, :-1], ((0, 0), (1, 0), (0, 0)))


def pool_mixer(u, pool_w, pool_scale):
    S = u.shape[1]
    uf = u.astype(jnp.float32)
    cs = jnp.cumsum(uf, axis=1)
    outs = []
    for gi, w in enumerate(POOL_WINDOWS):
        lo, hi = gi * POOL_GROUP, (gi + 1) * POOL_GROUP
        c = cs[:, :, lo:hi]
        c_lag = jnp.pad(c, ((0, 0), (w, 0), (0, 0)))[:, :S]
        cnt = jnp.minimum(jnp.arange(1, S + 1), w).astype(jnp.float32)[None, :, None]
        pooled = (c - c_lag) / cnt - uf[:, :, lo:hi]
        outs.append(jnp.einsum('bsc,cd->bsd', pooled.astype(u.dtype), pool_w[gi]))
    return jnp.concatenate(outs, axis=-1) * pool_scale


def gla_chunked(q, k, v, gk):
    B, S, H, DK = q.shape
    DV = v.shape[-1]
    C = GLA_CHUNK
    n = S // C

    def to_chunks(t):
        return t.astype(jnp.float32).reshape(B, n, C, H, t.shape[-1]).transpose(1, 0, 3, 2, 4)

    qc = to_chunks(q) * (DK ** -0.5)
    kc, vc, gc = to_chunks(k), to_chunks(v), to_chunks(gk)
    causal = jnp.tril(jnp.ones((C, C), dtype=bool))

    def step(state, inp):
        qi, ki, vi, gi = inp
        b = jnp.cumsum(gi, axis=2)
        b_last = b[:, :, -1:, :]
        o_inter = jnp.einsum('bhcd,bhde->bhce', qi * jnp.exp(b), state)
        diff = jnp.where(causal[:, :, None], b[:, :, :, None, :] - b[:, :, None, :, :], -jnp.inf)
        att = jnp.einsum('bhid,bhjd,bhijd->bhij', qi, ki, jnp.exp(diff))
        o = o_inter + jnp.einsum('bhij,bhje->bhie', att, vi)
        state = state * jnp.exp(b_last)[:, :, 0, :, None] + jnp.einsum(
            'bhcd,bhce->bhde', ki * jnp.exp(b_last - b), vi)
        return state, o

    s0 = jnp.zeros((B, H, DK, DV), jnp.float32)
    _, o = lax.scan(step, s0, (qc, kc, vc, gc))
    return o.transpose(1, 0, 3, 2, 4).reshape(B, S, H, DV)


def rwkv7_time_mix(hc, mu, w0, w2, a0, a2, g2, k_k, k_a, r_k, ln_w, ln_b):
    B, S, _ = hc.shape
    f32 = jnp.float32
    hs = hc + (shift_prev(hc) - hc) * mu
    r, k, v, hw, ha, hg = jnp.split(hs, RWKV_SPLITS, axis=-1)
    w_log = -jax.nn.softplus(-(w0 + jnp.tanh(hw) @ w2).astype(f32)) - 0.5
    decay = jnp.exp(-jnp.exp(w_log))
    a = jax.nn.sigmoid((a0 + ha @ a2).astype(f32))
    g = jax.nn.sigmoid(hg) @ g2

    def heads(t):
        return t.astype(f32).reshape(B, S, RWKV_HEADS, RWKV_HEAD)

    kk = heads(k * k_k)
    kk = kk / jnp.maximum(jnp.linalg.norm(kk, axis=-1, keepdims=True), 1e-12)
    k_mod = k.astype(f32) * (1.0 + (a - 1.0) * k_a)
    rh, kh, vh, wh, ah = heads(r), heads(k_mod), heads(v), heads(decay), heads(a)
    a_vec = -kk
    b_vec = kk * ah

    def tm(t):
        return jnp.moveaxis(t, 1, 0)

    def step(state, inp):
        r_t, w_t, k_t, v_t, a_t, b_t = inp
        sa = jnp.einsum('bhvk,bhk->bhv', state, a_t)
        state = (state * w_t[:, :, None, :] + sa[..., None] * b_t[:, :, None, :]
                 + v_t[..., None] * k_t[:, :, None, :])
        y = jnp.einsum('bhvk,bhk->bhv', state, r_t)
        return state, y

    s0 = jnp.zeros((B, RWKV_HEADS, RWKV_HEAD, RWKV_HEAD), f32)
    _, y = lax.scan(step, s0, (tm(rh), tm(wh), tm(kh), tm(vh), tm(a_vec), tm(b_vec)))
    y = jnp.moveaxis(y, 0, 1)
    mean = jnp.mean(y, axis=-1, keepdims=True)
    var = jnp.mean(jnp.square(y - mean), axis=-1, keepdims=True)
    yn = ((y - mean) * lax.rsqrt(var + RWKV_LN_EPS)).reshape(B, S, RWKV_WIDTH) * ln_w + ln_b
    bonus = (jnp.sum(rh * kh * r_k, axis=-1, keepdims=True) * vh).reshape(B, S, RWKV_WIDTH)
    return ((yn + bonus) * g).astype(hc.dtype)


def rope(x, pos):
    half = x.shape[-1] // 2
    inv = ROPE_THETA ** (-jnp.arange(half, dtype=jnp.float32) / half)
    ang = pos.astype(jnp.float32)[:, None] * inv[None, :]
    cos = jnp.cos(ang)[None, :, None, :]
    sin = jnp.sin(ang)[None, :, None, :]
    xf = x.astype(jnp.float32)
    x1, x2 = xf[..., :half], xf[..., half:]
    return jnp.concatenate([x1 * cos - x2 * sin, x2 * cos + x1 * sin], axis=-1).astype(x.dtype)


def dilated_branch(q, k, v, window, dil):
    B, H, S, Dh = q.shape
    L = S // dil
    nb = -(-L // DIL_BLOCK)
    Lp = nb * DIL_BLOCK
    n_back = window // dil

    def sub(t):
        t = t.astype(jnp.float32).reshape(B, H, L, dil, Dh).transpose(0, 1, 3, 2, 4)
        t = jnp.pad(t, ((0, 0), (0, 0), (0, 0), (0, Lp - L), (0, 0)))
        return t.reshape(B, H, dil, nb, DIL_BLOCK, Dh)

    def with_prev(t):
        prev = jnp.pad(t, ((0, 0), (0, 0), (0, 0), (1, 0), (0, 0), (0, 0)))[:, :, :, :-1]
        return jnp.concatenate([prev, t], axis=4)

    qs = sub(q)
    kb, vb = with_prev(sub(k)), with_prev(sub(v))
    s = jnp.einsum('bhrnqd,bhrnkd->bhrnqk', qs, kb) * (Dh ** -0.5)
    qi = jnp.arange(DIL_BLOCK)[:, None]
    ki = jnp.arange(2 * DIL_BLOCK)[None, :]
    dist = qi + DIL_BLOCK - ki
    blk = jnp.arange(nb)[:, None, None]
    valid = (dist >= 0) & (dist <= n_back) & (blk * DIL_BLOCK + ki - DIL_BLOCK >= 0)
    s = jnp.where(valid, s, -jnp.inf)
    m = jnp.max(s, axis=-1)
    pexp = jnp.exp(s - m[..., None])
    l = jnp.sum(pexp, axis=-1)
    acc = jnp.einsum('bhrnqk,bhrnkd->bhrnqd', pexp, vb)

    def unsub(t):
        extra = t.shape[5:]
        t = t.reshape((B, H, dil, Lp) + extra)[:, :, :, :L]
        t = jnp.moveaxis(t, 2, 3)
        return t.reshape((B, H, S) + extra)

    return unsub(m), unsub(l), unsub(acc)


def dilated_attention(q, k, v):
    branches = [dilated_branch(q, k, v, w, d) for (w, d) in DIL_PATTERNS]
    m_max = jnp.max(jnp.stack([br[0] for br in branches]), axis=0)
    num = jnp.zeros(q.shape, jnp.float32)
    den = jnp.zeros(q.shape[:-1], jnp.float32)
    for m, l, acc in branches:
        c = jnp.exp(m - m_max)
        num = num + c[..., None] * acc
        den = den + c * l
    return num / den[..., None]


def even_mixer(h, w_in, w_out, pool_w, pool_scale, gate_w2, gate_b, gla_norm):
    B, S, _ = h.shape
    z = h @ w_in
    u, q, k, v, gout, glr = jnp.split(z, EVEN_SPLITS, axis=-1)
    a_out = pool_mixer(u, pool_w, pool_scale)
    gk = jax.nn.log_sigmoid((glr @ gate_w2 + gate_b).astype(jnp.float32)) / GLA_TAU
    o = gla_chunked(q.reshape(B, S, GLA_HEADS, GLA_DK), k.reshape(B, S, GLA_HEADS, GLA_DK),
                    v.reshape(B, S, GLA_HEADS, GLA_DV), gk.reshape(B, S, GLA_HEADS, GLA_DK))
    o = rmsnorm(o, gla_norm) * jax.nn.silu(gout.reshape(B, S, GLA_HEADS, GLA_DV).astype(jnp.float32))
    mix = jnp.concatenate([a_out.astype(h.dtype), o.reshape(B, S, GLA_WIDTH).astype(h.dtype)], axis=-1)
    return mix @ w_out


def odd_mixer(h, w_in, w_out, mu, w0, w2, a0, a2, g2, k_k, k_a, r_k, ln_w, ln_b):
    B, S, _ = h.shape
    z = h @ w_in
    hc, hd = z[..., :RWKV_IN], z[..., RWKV_IN:]
    c_out = rwkv7_time_mix(hc, mu, w0, w2, a0, a2, g2, k_k, k_a, r_k, ln_w, ln_b)
    q, k, v = jnp.split(hd, 3, axis=-1)
    pos = jnp.arange(S)
    q = rope(q.reshape(B, S, DIL_HEADS, DIL_HEAD), pos).transpose(0, 2, 1, 3)
    k = rope(k.reshape(B, S, DIL_HEADS, DIL_HEAD), pos).transpose(0, 2, 1, 3)
    v = v.reshape(B, S, DIL_HEADS, DIL_HEAD).transpose(0, 2, 1, 3)
    d_out = dilated_attention(q, k, v).transpose(0, 2, 1, 3).reshape(B, S, DIL_WIDTH)
    mix = jnp.concatenate([c_out.astype(h.dtype), d_out.astype(h.dtype)], axis=-1)
    return mix @ w_out


def setup_inputs(seed: int = 0) -> dict:
    key = jax.random.key(seed)
    ks = iter(jax.random.split(key, 40))
    f32 = jnp.float32

    def nrm(shape, scale):
        return jax.random.normal(next(ks), shape, f32) * scale

    def gain(shape):
        return 1.0 + 0.05 * jax.random.normal(next(ks), shape, f32)

    return {
        'x': nrm((BATCH, SEQ, D_MODEL), 1.0),
        'p': nrm((DEPTH, BATCH, SEQ, PLE_DIM), 1.0),
        'norm_mix_pre': gain((DEPTH, D_MODEL)),
        'norm_mix_post': gain((DEPTH, D_MODEL)),
        'norm_ffn_pre': gain((DEPTH, D_MODEL)),
        'norm_ffn_post': gain((DEPTH, D_MODEL)),
        'ev_w_in': nrm((N_EVEN, D_MODEL, EVEN_IN), D_MODEL ** -0.5),
        'ev_w_out': nrm((N_EVEN, EVEN_MIX, D_MODEL), EVEN_MIX ** -0.5),
        'pool_w': nrm((N_EVEN, len(POOL_WINDOWS), POOL_GROUP, POOL_GROUP), POOL_GROUP ** -0.5),
        'pool_scale': gain((N_EVEN, POOL_WIDTH)),
        'gla_gate_w2': nrm((N_EVEN, GLA_GATE_RANK, GLA_QK), GLA_GATE_RANK ** -0.5),
        'gla_gate_b': nrm((N_EVEN, GLA_QK), 0.1),
        'gla_norm': gain((N_EVEN, GLA_DV)),
        'od_w_in': nrm((N_ODD, D_MODEL, ODD_IN), D_MODEL ** -0.5),
        'od_w_out': nrm((N_ODD, ODD_MIX, D_MODEL), ODD_MIX ** -0.5),
        'rwkv_mu': jax.random.uniform(next(ks), (N_ODD, RWKV_IN), f32),
        'rwkv_w0': nrm((N_ODD, RWKV_WIDTH), 0.5) - 0.5,
        'rwkv_w2': nrm((N_ODD, RWKV_DECAY_RANK, RWKV_WIDTH), 0.5 * RWKV_DECAY_RANK ** -0.5),
        'rwkv_a0': nrm((N_ODD, RWKV_WIDTH), 0.1),
        'rwkv_a2': nrm((N_ODD, RWKV_A_RANK, RWKV_WIDTH), 0.5 * RWKV_A_RANK ** -0.5),
        'rwkv_g2': nrm((N_ODD, RWKV_GATE_RANK, RWKV_WIDTH), RWKV_GATE_RANK ** -0.5),
        'rwkv_k_k': 0.85 + nrm((N_ODD, RWKV_WIDTH), 0.05),
        'rwkv_k_a': gain((N_ODD, RWKV_WIDTH)),
        'rwkv_r_k': nrm((N_ODD, RWKV_HEADS, RWKV_HEAD), 0.1),
        'rwkv_ln_w': gain((N_ODD, RWKV_WIDTH)),
        'rwkv_ln_b': nrm((N_ODD, RWKV_WIDTH), 0.01),
        'ffn_up': nrm((DEPTH, D_MODEL, D_FF), D_MODEL ** -0.5),
        'ffn_down': nrm((DEPTH, D_FF, D_MODEL), D_FF ** -0.5),
        'ple_proj': nrm((DEPTH, PLE_DIM, D_MODEL), PLE_DIM ** -0.5),
        'ple_gate': nrm((DEPTH, D_MODEL, D_MODEL), D_MODEL ** -0.5),
        'ple_norm': gain((DEPTH, D_MODEL)),
    }


def reference(x, p, norm_mix_pre, norm_mix_post, norm_ffn_pre, norm_ffn_post,
              ev_w_in, ev_w_out, pool_w, pool_scale, gla_gate_w2, gla_gate_b, gla_norm,
              od_w_in, od_w_out, rwkv_mu, rwkv_w0, rwkv_w2, rwkv_a0, rwkv_a2, rwkv_g2,
              rwkv_k_k, rwkv_k_a, rwkv_r_k, rwkv_ln_w, rwkv_ln_b,
              ffn_up, ffn_down, ple_proj, ple_gate, ple_norm):
    for i in range(DEPTH):
        j = i // 2
        h = rmsnorm(x, norm_mix_pre[i])
        if i % 2 == 0:
            y = even_mixer(h, ev_w_in[j], ev_w_out[j], pool_w[j], pool_scale[j],
                           gla_gate_w2[j], gla_gate_b[j], gla_norm[j])
        else:
            y = odd_mixer(h, od_w_in[j], od_w_out[j], rwkv_mu[j], rwkv_w0[j], rwkv_w2[j],
                          rwkv_a0[j], rwkv_a2[j], rwkv_g2[j], rwkv_k_k[j], rwkv_k_a[j],
                          rwkv_r_k[j], rwkv_ln_w[j], rwkv_ln_b[j])
        x = x + rmsnorm(y, norm_mix_post[i])
        h = rmsnorm(x, norm_ffn_pre[i])
        y = jnp.square(jax.nn.relu(h @ ffn_up[i])) @ ffn_down[i]
        x = x + rmsnorm(y, norm_ffn_post[i])
        gate = jax.nn.sigmoid(rmsnorm(x, ple_norm[i]) @ ple_gate[i])
        x = x + (p[i] @ ple_proj[i]) * gate
    return x
```

```cpp
#include <hip/hip_runtime.h>
#include <cstdio>
#include <cstdint>
namespace pg8 {
#define PG8_LAS __attribute__((address_space(3)))
typedef unsigned short bf16_t;
typedef short bf16x8 __attribute__((ext_vector_type(8)));
typedef float f32x4 __attribute__((ext_vector_type(4)));
typedef unsigned u32x4 __attribute__((ext_vector_type(4)));
constexpr int BM = 256, BK = 64, HALF = 128, HTB = HALF * BK * 2  , STAGE_BYTES = 8 * HTB, NXCD = 8, WGM = 8;

__host__ __device__ __forceinline__ int lds_byte(int r, int c) { const int st = (r >> 4) * 2 + (c >> 5), rr = r & 15, cc = c & 31, ob = rr * 64 + cc * 2; return st * 1024 + (ob ^ (((ob >> 9) & 1) << 5)); }
__host__ __device__ __forceinline__ void stage_rc(int b, int& R, int& C) { const int st = b / 1024, sb = b % 1024, swz = sb ^ (((sb >> 9) & 1) << 5); R = (st >> 1) * 16 + swz / 64; C = (st & 1) * 32 + (swz % 64) / 2; }
__host__ __device__ __forceinline__ int perm32(int rho) { const int n = rho >> 4, i = rho & 15; return 8 * (i >> 2) + 4 * n + (i & 3); }

struct Unit { int pm, pn; };
struct Gemm { const bf16_t* A; const bf16_t* Bt; int M, N, K; };

struct StaticOrder {
    int nM, nN, nwg, G, c;
    __host__ __device__ void init(int M, int N, int G_, int c_) { nM = M / BM; nN = N / BM; nwg = nM * nN; G = G_; c = c_; }
    __host__ __device__ bool next(int i, Unit& u) const {
        const long L = (long)i * G + c; if (L >= nwg) return false;
        int wgid = (int)L; { const int q = nwg / NXCD, r = nwg % NXCD, xcd = wgid % NXCD, off = wgid / NXCD; wgid = (xcd < r ? xcd * (q + 1) : r * (q + 1) + (xcd - r) * q) + off; }
        const int nig = WGM * nN, gid = wgid / nig, fm = gid * WGM, gsz = (nM - fm) < WGM ? (nM - fm) : WGM;
        u.pm = fm + ((wgid % nig) % gsz); u.pn = (wgid % nig) / gsz; return true;
    }
    __device__ __forceinline__ void a_ready(const Unit&) const {}
    __device__ __forceinline__ void done(const Unit&) const {}
};

__device__ __forceinline__ unsigned cvt_pk_bf16(float lo, float hi) { unsigned r; asm volatile("v_cvt_pk_bf16_f32 %0, %1, %2" : "=v"(r) : "v"(lo), "v"(hi)); return r; }
__device__ __forceinline__ float bflo(unsigned w) { return __uint_as_float(w << 16); }
__device__ __forceinline__ float bfhi(unsigned w) { return __uint_as_float(w & 0xffff0000u); }
template <int ACT  > struct EpiBf16 {
    static constexpr bool PERM = true, AFTER_DRAIN = false;
    bf16_t* O; int ldc;
    __device__ __forceinline__ void operator()(const f32x4 (&acc)[2][2][4][2], const Unit& u, int wr, int wc, int fr, int fq) const {
        const int row0 = u.pm * BM + wr * 64 + fr; const int col0 = u.pn * BM + wc * 32 + 8 * fq;
#pragma unroll
        for (int ai = 0; ai < 2; ++ai)
#pragma unroll
            for (int m = 0; m < 4; ++m) { bf16_t* rowp = O + (size_t)(row0 + ai * HALF + m * 16) * ldc + col0;
#pragma unroll
                for (int bj = 0; bj < 2; ++bj) { f32x4 v0 = acc[ai][bj][m][0], v1 = acc[ai][bj][m][1];
                    if (ACT == 2) {
#pragma unroll
                        for (int e = 0; e < 4; ++e) { float a = fmaxf(v0[e], 0.f), b = fmaxf(v1[e], 0.f); v0[e] = a * a; v1[e] = b * b; } }
                    u32x4 w; w.x = cvt_pk_bf16(v0[0], v0[1]); w.y = cvt_pk_bf16(v0[2], v0[3]); w.z = cvt_pk_bf16(v1[0], v1[1]); w.w = cvt_pk_bf16(v1[2], v1[3]);
                    *(u32x4*)(rowp + bj * HALF) = w; } }
    }
};
struct EpiGate {
    static constexpr bool PERM = true, AFTER_DRAIN = false;
    const bf16_t* PP; float* X; int ldc;
    __device__ __forceinline__ void operator()(const f32x4 (&acc)[2][2][4][2], const Unit& u, int wr, int wc, int fr, int fq) const {
        const int row0 = u.pm * BM + wr * 64 + fr; const int col0 = u.pn * BM + wc * 32 + 8 * fq;
#pragma unroll
        for (int ai = 0; ai < 2; ++ai)
#pragma unroll
            for (int m = 0; m < 4; ++m) { const size_t ro = (size_t)(row0 + ai * HALF + m * 16) * ldc + col0;
#pragma unroll
                for (int bj = 0; bj < 2; ++bj) { const size_t off = ro + bj * HALF;
                    const u32x4 pw = *(const u32x4*)(PP + off); f32x4 x0 = *(const f32x4*)(X + off), x1 = *(const f32x4*)(X + off + 4);
                    const f32x4 a0 = acc[ai][bj][m][0], a1 = acc[ai][bj][m][1];
                    x0[0] += bflo(pw.x) / (1.f + __expf(-a0[0])); x0[1] += bfhi(pw.x) / (1.f + __expf(-a0[1]));
                    x0[2] += bflo(pw.y) / (1.f + __expf(-a0[2])); x0[3] += bfhi(pw.y) / (1.f + __expf(-a0[3]));
                    x1[0] += bflo(pw.z) / (1.f + __expf(-a1[0])); x1[1] += bfhi(pw.z) / (1.f + __expf(-a1[1]));
                    x1[2] += bflo(pw.w) / (1.f + __expf(-a1[2])); x1[3] += bfhi(pw.w) / (1.f + __expf(-a1[3]));
                    *(f32x4*)(X + off) = x0; *(f32x4*)(X + off + 4) = x1; } }
    }
};

template <class Epi, class Sched, bool ALIGN_EPI = false, bool SP2 = false>
__device__ __forceinline__ void gemm_phase(PG8_LAS unsigned char* lds, const Gemm g, const Sched& S, const Epi& E) {
    const int tid = threadIdx.x, wid = __builtin_amdgcn_readfirstlane(tid >> 6), lane = tid & 63, wr = wid >> 2, wc = wid & 3, fr = lane & 15, fq = lane >> 4;
    const int K = g.K, nt = K / BK;
    unsigned voffA[2], voffB[2];
#pragma unroll
    for (int i = 0; i < 2; ++i) { int R, C; stage_rc(tid * 16 + i * 8192, R, C); const int Rb = Epi::PERM ? ((R & ~31) + perm32(R & 31)) : R;
        voffA[i] = (unsigned)(R * K + C) * 2u; voffB[i] = (unsigned)(Rb * K + C) * 2u; }
    const size_t kstep = (size_t)(BK * 2);
    const size_t hstep = (size_t)HALF * K * 2;
    const size_t tstep = 2 * hstep;
    const unsigned ldsw = (unsigned)wid * 1024u;
    const int aoff = lds_byte(wr * 64 + fr, fq * 8), boff = lds_byte(wc * 32 + fr, fq * 8);
#define PG8_SA(b, h) (((b) * 2 + (h)) * HTB)
#define PG8_SB(b, h) ((4 + (b) * 2 + (h)) * HTB)
#define PG8_STAGE(bufoff, gbase, voff) do { _Pragma("unroll") for (int _i = 0; _i < 2; ++_i) \
        __builtin_amdgcn_global_load_lds((const unsigned*)((const char*)(gbase) + (voff)[_i]), (PG8_LAS unsigned*)(lds + (bufoff) + ldsw + _i * 8192), 16, 0, 0); } while (0)
#define PG8_LDA(dst, b, h) do { _Pragma("unroll") for (int m = 0; m < 4; ++m) _Pragma("unroll") for (int k = 0; k < 2; ++k) dst[m][k] = *(const PG8_LAS bf16x8*)(lds + PG8_SA(b, h) + aoff + m * 2048 + k * 1024); } while (0)
#define PG8_LDB(dst, b, h) do { _Pragma("unroll") for (int n = 0; n < 2; ++n) _Pragma("unroll") for (int k = 0; k < 2; ++k) dst[n][k] = *(const PG8_LAS bf16x8*)(lds + PG8_SB(b, h) + boff + n * 2048 + k * 1024); } while (0)
#define PG8_MMA(ai, bj, At, Bt) do { __builtin_amdgcn_s_setprio(1); _Pragma("unroll") for (int m = 0; m < 4; ++m) _Pragma("unroll") for (int n = 0; n < 2; ++n) _Pragma("unroll") for (int k = 0; k < 2; ++k) \
        acc[ai][bj][m][n] = __builtin_amdgcn_mfma_f32_16x16x32_bf16(Bt[n][k], At[m][k], acc[ai][bj][m][n], 0, 0, 0); __builtin_amdgcn_s_setprio(0); } while (0)
#define PG8_WAIT_V(n) asm volatile("s_waitcnt vmcnt(" #n ")" ::: "memory")
#define PG8_WAIT_L(n) asm volatile("s_waitcnt lgkmcnt(" #n ")" ::: "memory")
#define PG8_BAR __builtin_amdgcn_s_barrier()
#define PG8_SCHED __builtin_amdgcn_sched_barrier(0)
    Unit cur, nxt; int ui = 0;
    if (!S.next(0, cur)) return;
    f32x4 acc[2][2][4][2];
#pragma unroll
    for (int a = 0; a < 2; ++a)
#pragma unroll
        for (int b = 0; b < 2; ++b)
#pragma unroll
            for (int m = 0; m < 4; ++m)
#pragma unroll
                for (int n = 0; n < 2; ++n) acc[a][b][m][n] = (f32x4){0.f, 0.f, 0.f, 0.f};
    bf16x8 At[4][2], B0[2][2], B1[2][2];
    const char* cA = (const char*)g.A + (size_t)cur.pm * tstep; const char* cB = (const char*)g.Bt + (size_t)cur.pn * tstep;
    S.a_ready(cur);
    if constexpr (SP2) {
        PG8_STAGE(PG8_SB(0, 0), cB, voffB); PG8_STAGE(PG8_SB(0, 1), cB + hstep, voffB); PG8_STAGE(PG8_SA(0, 0), cA, voffA); PG8_STAGE(PG8_SA(0, 1), cA + hstep, voffA);
        if (wr == 1) PG8_BAR;
        PG8_WAIT_V(2); PG8_BAR;
        PG8_STAGE(PG8_SB(1, 0), cB + kstep, voffB); PG8_STAGE(PG8_SA(1, 0), cA + kstep, voffA); PG8_STAGE(PG8_SB(1, 1), cB + hstep + kstep, voffB);
        PG8_WAIT_V(6); PG8_BAR;
    } else {
        PG8_STAGE(PG8_SB(0, 0), cB, voffB); PG8_STAGE(PG8_SA(0, 0), cA, voffA); PG8_STAGE(PG8_SB(0, 1), cB + hstep, voffB); PG8_STAGE(PG8_SA(0, 1), cA + hstep, voffA);
        if (wr == 1) PG8_BAR;
        PG8_WAIT_V(4); PG8_BAR;
        PG8_STAGE(PG8_SB(1, 0), cB + kstep, voffB); PG8_STAGE(PG8_SA(1, 0), cA + kstep, voffA); PG8_STAGE(PG8_SB(1, 1), cB + hstep + kstep, voffB);
        PG8_WAIT_V(6); PG8_BAR;
    }
    for (;;) {
        const bool has_next = S.next(ui + 1, nxt);
        const char* nA = has_next ? (const char*)g.A + (size_t)nxt.pm * tstep : cA; const char* nB = has_next ? (const char*)g.Bt + (size_t)nxt.pn * tstep : cB;
        for (int t = 0; t < nt; t += 2) {
            const bool last = (t == nt - 2);
            const char* a1 = cA + (size_t)(t + 1) * kstep;
            const char* a2 = last ? nA : cA + (size_t)(t + 2) * kstep; const char* b2 = last ? nB : cB + (size_t)(t + 2) * kstep;
            const char* a3 = a2 + kstep; const char* b3 = b2 + kstep;
            if (last && has_next) S.a_ready(nxt);
            if constexpr (SP2) {
            PG8_LDB(B0, 0, 0); PG8_LDB(B1, 0, 1); PG8_SCHED; PG8_LDA(At, 0, 0); PG8_STAGE(PG8_SA(1, 1), a1 + hstep, voffA);
            PG8_WAIT_V(8); PG8_WAIT_L(0); PG8_BAR; PG8_MMA(0, 0, At, B0); PG8_MMA(0, 1, At, B1); PG8_BAR; PG8_SCHED;
            PG8_LDA(At, 0, 1); PG8_STAGE(PG8_SB(0, 0), b2, voffB); PG8_STAGE(PG8_SB(0, 1), b2 + hstep, voffB); PG8_STAGE(PG8_SA(0, 0), a2, voffA);
            PG8_WAIT_V(8); PG8_WAIT_L(0); PG8_BAR; PG8_MMA(1, 0, At, B0); PG8_MMA(1, 1, At, B1); PG8_BAR; PG8_SCHED;
            PG8_LDB(B0, 1, 0); PG8_LDB(B1, 1, 1); PG8_SCHED; PG8_LDA(At, 1, 0); PG8_STAGE(PG8_SA(0, 1), a2 + hstep, voffA);
            PG8_WAIT_V(8); PG8_WAIT_L(0); PG8_BAR; PG8_MMA(0, 0, At, B0); PG8_MMA(0, 1, At, B1); PG8_BAR; PG8_SCHED;
            PG8_LDA(At, 1, 1); PG8_STAGE(PG8_SB(1, 0), b3, voffB); PG8_STAGE(PG8_SB(1, 1), b3 + hstep, voffB); PG8_STAGE(PG8_SA(1, 0), a3, voffA);
            PG8_WAIT_V(8); PG8_WAIT_L(0); PG8_BAR; PG8_MMA(1, 0, At, B0); PG8_MMA(1, 1, At, B1); PG8_BAR; PG8_SCHED;
            } else {
            PG8_LDB(B0, 0, 0); PG8_SCHED; PG8_LDA(At, 0, 0); PG8_STAGE(PG8_SA(1, 1), a1 + hstep, voffA);
            PG8_WAIT_L(8); PG8_BAR; PG8_WAIT_L(0); PG8_MMA(0, 0, At, B0); PG8_BAR; PG8_SCHED;
            PG8_LDB(B1, 0, 1); PG8_STAGE(PG8_SB(0, 0), b2, voffB);
            PG8_BAR; PG8_WAIT_L(0); PG8_MMA(0, 1, At, B1); PG8_BAR;
            PG8_LDA(At, 0, 1); PG8_STAGE(PG8_SA(0, 0), a2, voffA);
            PG8_BAR; PG8_WAIT_L(0); PG8_MMA(1, 0, At, B0); PG8_BAR; PG8_SCHED;
            PG8_STAGE(PG8_SB(0, 1), b2 + hstep, voffB);
            PG8_WAIT_V(6); PG8_BAR; PG8_MMA(1, 1, At, B1); PG8_BAR;
            PG8_LDB(B0, 1, 0); PG8_SCHED; PG8_LDA(At, 1, 0); PG8_STAGE(PG8_SA(0, 1), a2 + hstep, voffA);
            PG8_WAIT_L(8); PG8_BAR; PG8_WAIT_L(0); PG8_MMA(0, 0, At, B0); PG8_BAR; PG8_SCHED;
            PG8_LDB(B1, 1, 1); PG8_STAGE(PG8_SB(1, 0), b3, voffB);
            PG8_BAR; PG8_WAIT_L(0); PG8_MMA(0, 1, At, B1); PG8_BAR;
            PG8_LDA(At, 1, 1); PG8_STAGE(PG8_SA(1, 0), a3, voffA);
            PG8_BAR; PG8_WAIT_L(0); PG8_MMA(1, 0, At, B0); PG8_BAR; PG8_SCHED;
            PG8_STAGE(PG8_SB(1, 1), b3 + hstep, voffB);
            PG8_WAIT_V(6); PG8_BAR; PG8_MMA(1, 1, At, B1); PG8_BAR;
            }
        }
        if constexpr (ALIGN_EPI) { if (wr == 0) PG8_BAR; }
        if constexpr (!Epi::AFTER_DRAIN) { E(acc, cur, wr, wc, fr, fq); S.done(cur); }
        if (!has_next) break;
#pragma unroll
        for (int a = 0; a < 2; ++a)
#pragma unroll
            for (int b = 0; b < 2; ++b)
#pragma unroll
                for (int m = 0; m < 4; ++m)
#pragma unroll
                    for (int n = 0; n < 2; ++n) acc[a][b][m][n] = (f32x4){0.f, 0.f, 0.f, 0.f};
        cur = nxt; cA = nA; cB = nB; ++ui;
        if constexpr (ALIGN_EPI) { if (wr == 1) PG8_BAR; }
    }
    PG8_WAIT_V(0);
    if constexpr (!ALIGN_EPI) { if (wr == 0) PG8_BAR; }
    PG8_BAR;
    if constexpr (Epi::AFTER_DRAIN) { E.fused(acc, cur, wr, wc, fr, fq, lds, wid, lane); S.done(cur); }
#undef PG8_SA
#undef PG8_SB
#undef PG8_STAGE
#undef PG8_LDA
#undef PG8_LDB
#undef PG8_MMA
#undef PG8_WAIT_V
#undef PG8_WAIT_L
#undef PG8_BAR
#undef PG8_SCHED
}
}
typedef unsigned short bf16;
typedef float f32x4 __attribute__((ext_vector_type(4)));
typedef unsigned u32x4 __attribute__((ext_vector_type(4)));
typedef unsigned u32x2 __attribute__((ext_vector_type(2)));
constexpr int BATCH = 2, SEQ = 16384, DM = 2048, DEPTH = 4, M = BATCH * SEQ, DFF = 8192, PLE = 256;
constexpr int EV_IN = 5136, EV_INP = 5376, OD_IN = 6432, OD_INP = 6656;
constexpr int EZ_Q = 512, EZ_K = 1280, EZ_V = 2048, EZ_G = 3584, EZ_R = 5120;
constexpr int OZ_HW = 3072, OZ_HA = 3136, OZ_HG = 3200, OZ_DQ = 3360, OZ_DK = 4384, OZ_DV = 5408;
constexpr size_t MiB = 1u << 20;
constexpr size_t WS_CTL = 0, WS_WIN = 1 * MiB, WS_WOUT = 27 * MiB, WS_WUP = 35 * MiB, WS_WDN = 67 * MiB, WS_WGT = 99 * MiB, WS_WPJ = 107 * MiB;
constexpr size_t WS_H = 110 * MiB, WS_Y = 238 * MiB, WS_MIX = 366 * MiB, WS_PB = 494 * MiB, WS_Z = 510 * MiB, WS_HID = 510 * MiB;
constexpr size_t WS_T_EV = 846 * MiB, WS_T_OD = 926 * MiB, WS_NEED = 1200 * MiB;
constexpr size_t SLOT = 64 * MiB;

__device__ __forceinline__ unsigned f2bf(float f) { unsigned u = __builtin_bit_cast(unsigned, f); return (u + 0x7fffu + ((u >> 16) & 1u)) >> 16; }
__device__ __forceinline__ unsigned pk2(float lo, float hi) { return f2bf(lo) | (f2bf(hi) << 16); }
__device__ __forceinline__ float bf2f(bf16 h) { return __uint_as_float((unsigned)h << 16); }
__device__ __forceinline__ float wave_sum(float v) {
#pragma unroll
    for (int o = 1; o < 64; o <<= 1) v += __shfl_xor(v, o);
    return v;
}
__device__ __forceinline__ float sigmoidf_(float x) { return 1.f / (1.f + __expf(-x)); }
__device__ __forceinline__ float softplusf_(float x) { return fmaxf(x, 0.f) + log1pf(__expf(-fabsf(x))); }

__global__ void __launch_bounds__(256) k_wt(const float* __restrict__ W, int K, int N, bf16* __restrict__ Wt) {
    __shared__ float tile[64][65];
    const int n0 = blockIdx.x * 64, k0 = blockIdx.y * 64, tid = threadIdx.x, r = tid >> 6, c = tid & 63;
#pragma unroll
    for (int i = 0; i < 16; ++i) { const int kk = r + 4 * i, n = n0 + c; tile[kk][c] = (n < N) ? W[(size_t)(k0 + kk) * N + n] : 0.f; }
    __syncthreads();
#pragma unroll
    for (int j = 0; j < 2; ++j) { const int q = tid + 256 * j, n = q >> 3, kc = q & 7;
        u32x4 o; o.x = pk2(tile[8 * kc + 0][n], tile[8 * kc + 1][n]); o.y = pk2(tile[8 * kc + 2][n], tile[8 * kc + 3][n]);
        o.z = pk2(tile[8 * kc + 4][n], tile[8 * kc + 5][n]); o.w = pk2(tile[8 * kc + 6][n], tile[8 * kc + 7][n]);
        *(u32x4*)(Wt + (size_t)(n0 + n) * K + k0 + 8 * kc) = o; }
}
__global__ void __launch_bounds__(256) k_cvt(const float* __restrict__ s, bf16* __restrict__ d, size_t n4) {
    const size_t i = (size_t)blockIdx.x * 256 + threadIdx.x; if (i >= n4) return;
    const f32x4 v = ((const f32x4*)s)[i]; u32x2 o; o.x = pk2(v[0], v[1]); o.y = pk2(v[2], v[3]); ((u32x2*)d)[i] = o;
}
__global__ void __launch_bounds__(256) k_norm0(const float* __restrict__ xin, float* xout, const float* __restrict__ g, bf16* __restrict__ h) {
    const int row = blockIdx.x * 4 + (threadIdx.x >> 6), lane = threadIdx.x & 63;
    const f32x4* xr = (const f32x4*)(xin + (size_t)row * DM) + lane;
    f32x4 v[8]; float s = 0.f;
#pragma unroll
    for (int j = 0; j < 8; ++j) { v[j] = xr[64 * j]; s += (v[j][0] * v[j][0] + v[j][1] * v[j][1]) + (v[j][2] * v[j][2] + v[j][3] * v[j][3]); }
    s = wave_sum(s); const float rstd = 1.0f / sqrtf(s * (1.0f / DM) + 1e-6f);
    if (xout) { f32x4* xo = (f32x4*)(xout + (size_t)row * DM) + lane;
#pragma unroll
        for (int j = 0; j < 8; ++j) xo[64 * j] = v[j]; }
    u32x2* ho = (u32x2*)(h + (size_t)row * DM) + lane;
#pragma unroll
    for (int j = 0; j < 8; ++j) { const f32x4 gg = ((const f32x4*)g)[lane + 64 * j]; u32x2 o; o.x = pk2(v[j][0] * rstd * gg[0], v[j][1] * rstd * gg[1]); o.y = pk2(v[j][2] * rstd * gg[2], v[j][3] * rstd * gg[3]); ho[64 * j] = o; }
}
__global__ void __launch_bounds__(256) k_norm_res(const bf16* __restrict__ y, float* x, const float* __restrict__ g1, const float* __restrict__ g2, bf16* __restrict__ h) {
    const int row = blockIdx.x * 4 + (threadIdx.x >> 6), lane = threadIdx.x & 63;
    const u32x2* yr = (const u32x2*)(y + (size_t)row * DM) + lane;
    f32x4* xr = (f32x4*)(x + (size_t)row * DM) + lane;
    f32x4 yv[8], xv[8]; float s = 0.f;
#pragma unroll
    for (int j = 0; j < 8; ++j) { const u32x2 w = yr[64 * j]; yv[j][0] = __uint_as_float(w.x << 16); yv[j][1] = __uint_as_float(w.x & 0xffff0000u); yv[j][2] = __uint_as_float(w.y << 16); yv[j][3] = __uint_as_float(w.y & 0xffff0000u);
        xv[j] = xr[64 * j]; s += (yv[j][0] * yv[j][0] + yv[j][1] * yv[j][1]) + (yv[j][2] * yv[j][2] + yv[j][3] * yv[j][3]); }
    s = wave_sum(s); const float rstd = 1.0f / sqrtf(s * (1.0f / DM) + 1e-6f);
    float s2 = 0.f;
#pragma unroll
    for (int j = 0; j < 8; ++j) { const f32x4 gg = ((const f32x4*)g1)[lane + 64 * j]; xv[j] = xv[j] + yv[j] * rstd * gg; xr[64 * j] = xv[j];
        s2 += (xv[j][0] * xv[j][0] + xv[j][1] * xv[j][1]) + (xv[j][2] * xv[j][2] + xv[j][3] * xv[j][3]); }
    s2 = wave_sum(s2); const float rstd2 = 1.0f / sqrtf(s2 * (1.0f / DM) + 1e-6f);
    u32x2* ho = (u32x2*)(h + (size_t)row * DM) + lane;
#pragma unroll
    for (int j = 0; j < 8; ++j) { const f32x4 gg = ((const f32x4*)g2)[lane + 64 * j]; u32x2 o; o.x = pk2(xv[j][0] * rstd2 * gg[0], xv[j][1] * rstd2 * gg[1]); o.y = pk2(xv[j][2] * rstd2 * gg[2], xv[j][3] * rstd2 * gg[3]); ho[64 * j] = o; }
}
struct GArgs { const bf16* A; const bf16* Bt; bf16* O; const bf16* PP; float* X; int Mr, N, K, ldc; };
template <int MODE> __global__ void __launch_bounds__(512, 2) k_gemm(GArgs a) {
    extern __shared__ __attribute__((aligned(16))) unsigned char lds[];
    pg8::Gemm g; g.A = a.A; g.Bt = a.Bt; g.M = a.Mr; g.N = a.N; g.K = a.K;
    pg8::StaticOrder S; S.init(a.Mr, a.N, (int)gridDim.x, (int)blockIdx.x);
    if constexpr (MODE == 0) { pg8::EpiBf16<0> E{a.O, a.ldc}; pg8::gemm_phase<pg8::EpiBf16<0>, pg8::StaticOrder, true, true>((PG8_LAS unsigned char*)lds, g, S, E); }
    else if constexpr (MODE == 2) { pg8::EpiBf16<2> E{a.O, a.ldc}; pg8::gemm_phase<pg8::EpiBf16<2>, pg8::StaticOrder, true, true>((PG8_LAS unsigned char*)lds, g, S, E); }
    else { pg8::EpiGate E{a.PP, a.X, a.ldc}; pg8::gemm_phase<pg8::EpiGate, pg8::StaticOrder, true, true>((PG8_LAS unsigned char*)lds, g, S, E); }
}
__global__ void __launch_bounds__(512) k_pool(const bf16* __restrict__ z, const float* __restrict__ pw, const float* __restrict__ ps, bf16* __restrict__ mix) {
    __shared__ float pooled[512];
    const int m = blockIdx.x, t = m % SEQ, c = threadIdx.x, g = c >> 7, w = 2 << g;
    const int cnt = (t + 1 < w) ? (t + 1) : w;
    float sum = 0.f;
    for (int j = 0; j < cnt; ++j) sum += bf2f(z[(size_t)(m - j) * EV_INP + c]);
    pooled[c] = sum / (float)cnt - bf2f(z[(size_t)m * EV_INP + c]);
    __syncthreads();
    const int d = c & 127; float acc = 0.f;
    const float* wg = pw + (size_t)g * 128 * 128;
    for (int cc = 0; cc < 128; ++cc) acc += pooled[g * 128 + cc] * wg[cc * 128 + d];
    mix[(size_t)m * DM + c] = (bf16)f2bf(acc * ps[c]);
}
__global__ void __launch_bounds__(256) k_gla_gate(const bf16* __restrict__ z, const float* __restrict__ w2, const float* __restrict__ gb, float* __restrict__ GK) {
    __shared__ float glr[16];
    const int m = blockIdx.x, tid = threadIdx.x;
    if (tid < 16) glr[tid] = bf2f(z[(size_t)m * EV_INP + EZ_R + tid]);
    __syncthreads();
#pragma unroll
    for (int i = 0; i < 3; ++i) { const int j = tid + 256 * i; float x = gb[j];
#pragma unroll
        for (int r = 0; r < 16; ++r) x += glr[r] * w2[r * 768 + j];
        GK[(size_t)m * 768 + j] = -softplusf_(-x) * (1.0f / 16.0f); }
}
__global__ void __launch_bounds__(64) k_gla_rec(const bf16* __restrict__ z, const float* __restrict__ GK, float* __restrict__ ORAW) {
    constexpr int TB = 16;
    __shared__ f32x4 qs[TB][48], ks[TB][48], es[TB][48];
    const int bh = blockIdx.x / 6, eb = blockIdx.x % 6, b = bh >> 2, h = bh & 3, lane = threadIdx.x, e = eb * 64 + lane;
    const float scale = 0.07216878364870323f;
    float S[192];
#pragma unroll
    for (int d = 0; d < 192; ++d) S[d] = 0.f;
    for (int t0 = 0; t0 < SEQ; t0 += TB) {
        const size_t m0 = (size_t)b * SEQ + t0;
        float vv[TB];
#pragma unroll
        for (int s = 0; s < TB; ++s) vv[s] = bf2f(z[(m0 + s) * EV_INP + EZ_V + h * 384 + e]);
        __syncthreads();
        for (int i = lane; i < TB * 192; i += 64) { const int s = i / 192, d = i % 192; const size_t m = m0 + s;
            ((float*)qs)[s * 192 + d] = bf2f(z[m * EV_INP + EZ_Q + h * 192 + d]) * scale;
            ((float*)ks)[s * 192 + d] = bf2f(z[m * EV_INP + EZ_K + h * 192 + d]);
            ((float*)es)[s * 192 + d] = __expf(GK[m * 768 + h * 192 + d]); }
        __syncthreads();
        for (int s = 0; s < TB; ++s) {
            float o = 0.f; const float v = vv[s];
#pragma unroll
            for (int d4 = 0; d4 < 48; ++d4) { const f32x4 q4 = qs[s][d4], k4 = ks[s][d4], e4 = es[s][d4];
#pragma unroll
                for (int c = 0; c < 4; ++c) { S[4 * d4 + c] = S[4 * d4 + c] * e4[c] + k4[c] * v; o += q4[c] * S[4 * d4 + c]; } }
            ORAW[(m0 + s) * 1536 + h * 384 + e] = o;
        }
    }
}
__global__ void __launch_bounds__(256) k_gla_fin(const float* __restrict__ ORAW, const bf16* __restrict__ z, const float* __restrict__ gn, bf16* __restrict__ mix) {
    const int m = blockIdx.x, h = threadIdx.x >> 6, lane = threadIdx.x & 63;
    float o[6]; float ss = 0.f;
#pragma unroll
    for (int i = 0; i < 6; ++i) { o[i] = ORAW[(size_t)m * 1536 + h * 384 + lane + 64 * i]; ss += o[i] * o[i]; }
    ss = wave_sum(ss); const float rstd = 1.0f / sqrtf(ss * (1.0f / 384.0f) + 1e-6f);
#pragma unroll
    for (int i = 0; i < 6; ++i) { const int e = lane + 64 * i; const float go = bf2f(z[(size_t)m * EV_INP + EZ_G + h * 384 + e]);
        const float r = o[i] * rstd * gn[e] * (go * sigmoidf_(go)); mix[(size_t)m * DM + 512 + h * 384 + e] = (bf16)f2bf(r); }
}
struct RwkvP { const float *mu, *w0, *w2, *a0, *a2, *g2, *kk, *ka, *rk, *lnw, *lnb; };
__device__ __forceinline__ float tshift(const bf16* __restrict__ z, int m, int t, int col, const float* __restrict__ mu) {
    const float hc = bf2f(z[(size_t)m * OD_INP + col]); const float pv = (t > 0) ? bf2f(z[(size_t)(m - 1) * OD_INP + col]) : 0.f;
    return hc + (pv - hc) * mu[col];
}
__global__ void __launch_bounds__(256) k_rwkv_prep(const bf16* __restrict__ z, RwkvP P, bf16* R, bf16* LD, bf16* KM, bf16* V, bf16* KK, bf16* BV) {
    __shared__ float sm[128];
    const int m = blockIdx.x, t = m % SEQ, tid = threadIdx.x;
    if (tid < 128) { const float v = tshift(z, m, t, OZ_HW + tid, P.mu); sm[tid] = (tid < 64) ? tanhf(v) : v; }
    __syncthreads();
#pragma unroll
    for (int i = 0; i < 4; ++i) { const int c = tid + 256 * i;
        const float r = tshift(z, m, t, c, P.mu), k = tshift(z, m, t, 1024 + c, P.mu), v = tshift(z, m, t, 2048 + c, P.mu);
        float dw = P.w0[c], ap = P.a0[c];
        for (int j = 0; j < 64; ++j) { dw += sm[j] * P.w2[j * 1024 + c]; ap += sm[64 + j] * P.a2[j * 1024 + c]; }
        const float a = sigmoidf_(ap);
        const float wlog = -softplusf_(-dw) - 0.5f; const float ld = -__expf(wlog);
        const float kk = k * P.kk[c]; const float ss = wave_sum(kk * kk); const float kkn = kk / fmaxf(sqrtf(ss), 1e-12f);
        const float km = k * (1.f + (a - 1.f) * P.ka[c]);
        const size_t o = (size_t)m * 1024 + c;
        R[o] = (bf16)f2bf(r); LD[o] = (bf16)f2bf(ld); KM[o] = (bf16)f2bf(km); V[o] = (bf16)f2bf(v); KK[o] = (bf16)f2bf(kkn); BV[o] = (bf16)f2bf(kkn * a); }
}
__global__ void __launch_bounds__(64) k_rwkv_scan(const bf16* __restrict__ R, const bf16* __restrict__ LD, const bf16* __restrict__ KM, const bf16* __restrict__ V, const bf16* __restrict__ KK, const bf16* __restrict__ BV, bf16* __restrict__ Y) {
    constexpr int TB = 8;
    __shared__ f32x4 sh[TB][5][16];
    const int b = blockIdx.x >> 4, h = blockIdx.x & 15, lane = threadIdx.x;
    float S[64];
#pragma unroll
    for (int k = 0; k < 64; ++k) S[k] = 0.f;
    for (int t0 = 0; t0 < SEQ; t0 += TB) {
        float vv[TB];
        __syncthreads();
#pragma unroll
        for (int s = 0; s < TB; ++s) { const size_t o = ((size_t)b * SEQ + t0 + s) * 1024 + h * 64 + lane;
            ((float*)sh[s][0])[lane] = bf2f(R[o]); ((float*)sh[s][1])[lane] = __expf(bf2f(LD[o])); ((float*)sh[s][2])[lane] = bf2f(KM[o]);
            ((float*)sh[s][3])[lane] = bf2f(KK[o]); ((float*)sh[s][4])[lane] = bf2f(BV[o]); vv[s] = bf2f(V[o]); }
        __syncthreads();
        for (int s = 0; s < TB; ++s) {
            float sa = 0.f;
#pragma unroll
            for (int k4 = 0; k4 < 16; ++k4) { const f32x4 a4 = sh[s][3][k4];
#pragma unroll
                for (int c = 0; c < 4; ++c) sa -= S[4 * k4 + c] * a4[c]; }
            const float v = vv[s]; float y = 0.f;
#pragma unroll
            for (int k4 = 0; k4 < 16; ++k4) { const f32x4 w4 = sh[s][1][k4], b4 = sh[s][4][k4], m4 = sh[s][2][k4], r4 = sh[s][0][k4];
#pragma unroll
                for (int c = 0; c < 4; ++c) { const float ns = S[4 * k4 + c] * w4[c] + sa * b4[c] + v * m4[c]; S[4 * k4 + c] = ns; y += ns * r4[c]; } }
            Y[((size_t)b * SEQ + t0 + s) * 1024 + h * 64 + lane] = (bf16)f2bf(y);
        }
    }
}
__global__ void __launch_bounds__(256) k_rwkv_fin(const bf16* __restrict__ z, RwkvP P, const bf16* __restrict__ R, const bf16* __restrict__ KM, const bf16* __restrict__ V, const bf16* __restrict__ Y, bf16* __restrict__ mix) {
    __shared__ float sm[160];
    const int m = blockIdx.x, t = m % SEQ, tid = threadIdx.x;
    if (tid < 160) sm[tid] = sigmoidf_(tshift(z, m, t, OZ_HG + tid, P.mu));
    __syncthreads();
#pragma unroll
    for (int i = 0; i < 4; ++i) { const int c = tid + 256 * i; const size_t o = (size_t)m * 1024 + c;
        float g = 0.f;
        for (int j = 0; j < 160; ++j) g += sm[j] * P.g2[j * 1024 + c];
        const float y = bf2f(Y[o]); const float mean = wave_sum(y) * (1.0f / 64.0f); const float dy = y - mean; const float var = wave_sum(dy * dy) * (1.0f / 64.0f);
        const float yn = dy * (1.0f / sqrtf(var + 64e-5f)) * P.lnw[c] + P.lnb[c];
        const float r = bf2f(R[o]), km = bf2f(KM[o]), v = bf2f(V[o]);
        const float bon = wave_sum(r * km * P.rk[c]) * v;
        mix[(size_t)m * DM + c] = (bf16)f2bf((yn + bon) * g); }
}
__global__ void __launch_bounds__(256) k_rope(bf16* z) {
    const int m = blockIdx.x, t = m % SEQ, tid = threadIdx.x;
#pragma unroll
    for (int i = 0; i < 4; ++i) { const int idx = tid + 256 * i, qk = idx >> 9, h = (idx >> 6) & 7, j = idx & 63;
        const float inv = powf(10000.0f, -(float)j * (1.0f / 64.0f)); const float ang = (float)t * inv;
        const double rev = (double)ang * 0.15915494309189535; const float fr = (float)(rev - rint(rev));
        const float sn = __builtin_amdgcn_sinf(fr), cs = __builtin_amdgcn_cosf(fr);
        bf16* p = z + (size_t)m * OD_INP + (qk ? OZ_DK : OZ_DQ) + h * 128 + j;
        const float x1 = bf2f(p[0]), x2 = bf2f(p[64]);
        p[0] = (bf16)f2bf(x1 * cs - x2 * sn); p[64] = (bf16)f2bf(x2 * cs + x1 * sn); }
}
__global__ void __launch_bounds__(256) k_dil(const bf16* __restrict__ z, bf16* __restrict__ mix) {
    const int gw = blockIdx.x * 4 + (threadIdx.x >> 6), lane = threadIdx.x & 63;
    const int m = gw >> 3, h = gw & 7, t = m % SEQ;
    const float scale = 0.08838834764831845f;
    const bf16* qp = z + (size_t)m * OD_INP + OZ_DQ + h * 128;
    const float q0 = bf2f(qp[lane]) * scale, q1 = bf2f(qp[lane + 64]) * scale;
    float mr = -INFINITY, l = 0.f, a0 = 0.f, a1 = 0.f;
    for (int br = 0; br < 3; ++br) { const int dil = (br == 0) ? 1 : (br == 1 ? 4 : 16);
        for (int j = 0; j <= 128; ++j) { const int tk = t - j * dil; if (tk < 0) break;
            const size_t mk = (size_t)(m - j * dil) * OD_INP;
            const bf16* kp = z + mk + OZ_DK + h * 128; const bf16* vp = z + mk + OZ_DV + h * 128;
            const float s = wave_sum(q0 * bf2f(kp[lane]) + q1 * bf2f(kp[lane + 64]));
            const float mn = fmaxf(mr, s); const float corr = __expf(mr - mn), p = __expf(s - mn);
            l = l * corr + p; a0 = a0 * corr + p * bf2f(vp[lane]); a1 = a1 * corr + p * bf2f(vp[lane + 64]); mr = mn; } }
    const float il = 1.0f / l;
    bf16* op = mix + (size_t)m * DM + 1024 + h * 128;
    op[lane] = (bf16)f2bf(a0 * il); op[lane + 64] = (bf16)f2bf(a1 * il);
}
template <int MODE> static void launch_gemm(hipStream_t st, int grid, const bf16* A, const bf16* Bt, bf16* O, const bf16* PP, float* X, int N, int K, int ldc) {
    GArgs a{}; a.A = A; a.Bt = Bt; a.O = O; a.PP = PP; a.X = X; a.Mr = M; a.N = N; a.K = K; a.ldc = ldc;
    k_gemm<MODE><<<grid, 512, 131072, st>>>(a);
}
static void conv_w(hipStream_t st, const float* W, int K, int N, int Npad, bf16* Wt) { k_wt<<<dim3(Npad / 64, K / 64), 256, 0, st>>>(W, K, N, Wt); }

extern "C" void kernel_launch(void* const* d_in, const int* in_sizes, int n_in, void* d_out, int out_size, void* d_ws, size_t ws_size, hipStream_t stream) {
    static int grid = 0;
    if (grid == 0) {
        if (n_in != 31 || out_size != M * DM || ws_size < WS_NEED) { fprintf(stderr, "kernel_launch: unexpected shapes n_in %d out %d ws %zu\n", n_in, out_size, ws_size); grid = -1; return; }
        int dev = 0, cus = 0; hipGetDevice(&dev); hipDeviceGetAttribute(&cus, hipDeviceAttributeMultiprocessorCount, dev);
        hipFuncSetAttribute((const void*)k_gemm<0>, hipFuncAttributeMaxDynamicSharedMemorySize, 131072);
        hipFuncSetAttribute((const void*)k_gemm<2>, hipFuncAttributeMaxDynamicSharedMemorySize, 131072);
        hipFuncSetAttribute((const void*)k_gemm<3>, hipFuncAttributeMaxDynamicSharedMemorySize, 131072);
        grid = cus > 0 ? cus : 256;
    }
    if (grid < 0) return;
    const float* const* in = (const float* const*)d_in;
    unsigned char* ws = (unsigned char*)d_ws; float* x = (float*)d_out;
    bf16 *WIN = (bf16*)(ws + WS_WIN), *WOUT = (bf16*)(ws + WS_WOUT), *WUP = (bf16*)(ws + WS_WUP), *WDN = (bf16*)(ws + WS_WDN), *WGT = (bf16*)(ws + WS_WGT), *WPJ = (bf16*)(ws + WS_WPJ);
    bf16 *H = (bf16*)(ws + WS_H), *Y = (bf16*)(ws + WS_Y), *MIX = (bf16*)(ws + WS_MIX), *PB = (bf16*)(ws + WS_PB), *Z = (bf16*)(ws + WS_Z), *HID = (bf16*)(ws + WS_HID);
    for (int i = 0; i < DEPTH; ++i) {
        const int j = i >> 1; const bool odd = i & 1;
        const int NZ = odd ? OD_INP : EV_INP;
        if (odd) conv_w(stream, in[13] + (size_t)j * DM * OD_IN, DM, OD_IN, OD_INP, WIN); else conv_w(stream, in[6] + (size_t)j * DM * EV_IN, DM, EV_IN, EV_INP, WIN);
        conv_w(stream, (odd ? in[14] : in[7]) + (size_t)j * DM * DM, DM, DM, DM, WOUT);
        conv_w(stream, in[26] + (size_t)i * DM * DFF, DM, DFF, DFF, WUP);
        conv_w(stream, in[27] + (size_t)i * DFF * DM, DFF, DM, DM, WDN);
        conv_w(stream, in[29] + (size_t)i * DM * DM, DM, DM, DM, WGT);
        conv_w(stream, in[28] + (size_t)i * PLE * DM, PLE, DM, DM, WPJ);
        k_cvt<<<(unsigned)(((size_t)M * PLE / 4 + 255) / 256), 256, 0, stream>>>(in[1] + (size_t)i * M * PLE, PB, (size_t)M * PLE / 4);
        k_norm0<<<M / 4, 256, 0, stream>>>(i == 0 ? in[0] : x, i == 0 ? x : nullptr, in[2] + (size_t)i * DM, H);
        launch_gemm<0>(stream, grid, H, WIN, Z, nullptr, nullptr, NZ, DM, NZ);
        if (!odd) {
            float* GK = (float*)(ws + WS_H); float* ORAW = (float*)(ws + WS_T_EV);
            k_pool<<<M, 512, 0, stream>>>(Z, in[8] + (size_t)j * 4 * 128 * 128, in[9] + (size_t)j * 512, MIX);
            k_gla_gate<<<M, 256, 0, stream>>>(Z, in[10] + (size_t)j * 16 * 768, in[11] + (size_t)j * 768, GK);
            k_gla_rec<<<48, 64, 0, stream>>>(Z, GK, ORAW);
            k_gla_fin<<<M, 256, 0, stream>>>(ORAW, Z, in[12] + (size_t)j * 384, MIX);
        } else {
            RwkvP P{}; P.mu = in[15] + (size_t)j * 3360; P.w0 = in[16] + (size_t)j * 1024; P.w2 = in[17] + (size_t)j * 64 * 1024; P.a0 = in[18] + (size_t)j * 1024; P.a2 = in[19] + (size_t)j * 64 * 1024;
            P.g2 = in[20] + (size_t)j * 160 * 1024; P.kk = in[21] + (size_t)j * 1024; P.ka = in[22] + (size_t)j * 1024; P.rk = in[23] + (size_t)j * 1024; P.lnw = in[24] + (size_t)j * 1024; P.lnb = in[25] + (size_t)j * 1024;
            bf16 *R = (bf16*)(ws + WS_H), *LD = (bf16*)(ws + WS_H + SLOT), *KM = (bf16*)(ws + WS_H + 2 * SLOT), *V = (bf16*)(ws + WS_H + 3 * SLOT);
            bf16 *KK = (bf16*)(ws + WS_T_OD), *BV = (bf16*)(ws + WS_T_OD + SLOT), *YB = (bf16*)(ws + WS_T_OD + 2 * SLOT);
            k_rwkv_prep<<<M, 256, 0, stream>>>(Z, P, R, LD, KM, V, KK, BV);
            k_rwkv_scan<<<32, 64, 0, stream>>>(R, LD, KM, V, KK, BV, YB);
            k_rwkv_fin<<<M, 256, 0, stream>>>(Z, P, R, KM, V, YB, MIX);
            k_rope<<<M, 256, 0, stream>>>(Z);
            k_dil<<<M * 8 / 4, 256, 0, stream>>>(Z, MIX);
        }
        launch_gemm<0>(stream, grid, MIX, WOUT, Y, nullptr, nullptr, DM, DM, DM);
        k_norm_res<<<M / 4, 256, 0, stream>>>(Y, x, in[3] + (size_t)i * DM, in[4] + (size_t)i * DM, H);
        launch_gemm<2>(stream, grid, H, WUP, HID, nullptr, nullptr, DFF, DM, DFF);
        launch_gemm<0>(stream, grid, HID, WDN, Y, nullptr, nullptr, DM, DFF, DM);
        k_norm_res<<<M / 4, 256, 0, stream>>>(Y, x, in[5] + (size_t)i * DM, in[30] + (size_t)i * DM, H);
        launch_gemm<0>(stream, grid, PB, WPJ, MIX, nullptr, nullptr, DM, PLE, DM);
        launch_gemm<3>(stream, grid, H, WGT, nullptr, MIX, x, DM, DM, DM);
    }
}
```

```cpp
#include <hip/hip_runtime.h>
#include <cstdio>
#include <cstdint>
namespace pg8 {
#define PG8_LAS __attribute__((address_space(3)))
typedef unsigned short bf16_t;
typedef short bf16x8 __attribute__((ext_vector_type(8)));
typedef float f32x4 __attribute__((ext_vector_type(4)));
typedef unsigned u32x4 __attribute__((ext_vector_type(4)));
constexpr int BM = 256, BK = 64, HALF = 128, HTB = HALF * BK * 2  , STAGE_BYTES = 8 * HTB, NXCD = 8, WGM = 8;

__host__ __device__ __forceinline__ int lds_byte(int r, int c) { const int st = (r >> 4) * 2 + (c >> 5), rr = r & 15, cc = c & 31, ob = rr * 64 + cc * 2; return st * 1024 + (ob ^ (((ob >> 9) & 1) << 5)); }
__host__ __device__ __forceinline__ void stage_rc(int b, int& R, int& C) { const int st = b / 1024, sb = b % 1024, swz = sb ^ (((sb >> 9) & 1) << 5); R = (st >> 1) * 16 + swz / 64; C = (st & 1) * 32 + (swz % 64) / 2; }
__host__ __device__ __forceinline__ int perm32(int rho) { const int n = rho >> 4, i = rho & 15; return 8 * (i >> 2) + 4 * n + (i & 3); }

struct Unit { int pm, pn; };
struct Gemm { const bf16_t* A; const bf16_t* Bt; int M, N, K; };

struct StaticOrder {
    int nM, nN, nwg, G, c;
    __host__ __device__ void init(int M, int N, int G_, int c_) { nM = M / BM; nN = N / BM; nwg = nM * nN; G = G_; c = c_; }
    __host__ __device__ bool next(int i, Unit& u) const {
        const long L = (long)i * G + c; if (L >= nwg) return false;
        int wgid = (int)L; { const int q = nwg / NXCD, r = nwg % NXCD, xcd = wgid % NXCD, off = wgid / NXCD; wgid = (xcd < r ? xcd * (q + 1) : r * (q + 1) + (xcd - r) * q) + off; }
        const int nig = WGM * nN, gid = wgid / nig, fm = gid * WGM, gsz = (nM - fm) < WGM ? (nM - fm) : WGM;
        u.pm = fm + ((wgid % nig) % gsz); u.pn = (wgid % nig) / gsz; return true;
    }
    __device__ __forceinline__ void a_ready(const Unit&) const {}
    __device__ __forceinline__ void done(const Unit&) const {}
};

__device__ __forceinline__ unsigned cvt_pk_bf16(float lo, float hi) { unsigned r; asm volatile("v_cvt_pk_bf16_f32 %0, %1, %2" : "=v"(r) : "v"(lo), "v"(hi)); return r; }
__device__ __forceinline__ float bflo(unsigned w) { return __uint_as_float(w << 16); }
__device__ __forceinline__ float bfhi(unsigned w) { return __uint_as_float(w & 0xffff0000u); }
template <int ACT  > struct EpiBf16 {
    static constexpr bool PERM = true, AFTER_DRAIN = false;
    bf16_t* O; int ldc;
    __device__ __forceinline__ void operator()(const f32x4 (&acc)[2][2][4][2], const Unit& u, int wr, int wc, int fr, int fq) const {
        const int row0 = u.pm * BM + wr * 64 + fr; const int col0 = u.pn * BM + wc * 32 + 8 * fq;
#pragma unroll
        for (int ai = 0; ai < 2; ++ai)
#pragma unroll
            for (int m = 0; m < 4; ++m) { bf16_t* rowp = O + (size_t)(row0 + ai * HALF + m * 16) * ldc + col0;
#pragma unroll
                for (int bj = 0; bj < 2; ++bj) { f32x4 v0 = acc[ai][bj][m][0], v1 = acc[ai][bj][m][1];
                    if (ACT == 2) {
#pragma unroll
                        for (int e = 0; e < 4; ++e) { float a = fmaxf(v0[e], 0.f), b = fmaxf(v1[e], 0.f); v0[e] = a * a; v1[e] = b * b; } }
                    u32x4 w; w.x = cvt_pk_bf16(v0[0], v0[1]); w.y = cvt_pk_bf16(v0[2], v0[3]); w.z = cvt_pk_bf16(v1[0], v1[1]); w.w = cvt_pk_bf16(v1[2], v1[3]);
                    *(u32x4*)(rowp + bj * HALF) = w; } }
    }
};
struct EpiGate {
    static constexpr bool PERM = true, AFTER_DRAIN = false;
    const bf16_t* PP; float* X; int ldc;
    __device__ __forceinline__ void operator()(const f32x4 (&acc)[2][2][4][2], const Unit& u, int wr, int wc, int fr, int fq) const {
        const int row0 = u.pm * BM + wr * 64 + fr; const int col0 = u.pn * BM + wc * 32 + 8 * fq;
#pragma unroll
        for (int ai = 0; ai < 2; ++ai)
#pragma unroll
            for (int m = 0; m < 4; ++m) { const size_t ro = (size_t)(row0 + ai * HALF + m * 16) * ldc + col0;
#pragma unroll
                for (int bj = 0; bj < 2; ++bj) { const size_t off = ro + bj * HALF;
                    const u32x4 pw = *(const u32x4*)(PP + off); f32x4 x0 = *(const f32x4*)(X + off), x1 = *(const f32x4*)(X + off + 4);
                    const f32x4 a0 = acc[ai][bj][m][0], a1 = acc[ai][bj][m][1];
                    x0[0] += bflo(pw.x) / (1.f + __expf(-a0[0])); x0[1] += bfhi(pw.x) / (1.f + __expf(-a0[1]));
                    x0[2] += bflo(pw.y) / (1.f + __expf(-a0[2])); x0[3] += bfhi(pw.y) / (1.f + __expf(-a0[3]));
                    x1[0] += bflo(pw.z) / (1.f + __expf(-a1[0])); x1[1] += bfhi(pw.z) / (1.f + __expf(-a1[1]));
                    x1[2] += bflo(pw.w) / (1.f + __expf(-a1[2])); x1[3] += bfhi(pw.w) / (1.f + __expf(-a1[3]));
                    *(f32x4*)(X + off) = x0; *(f32x4*)(X + off + 4) = x1; } }
    }
};

template <class Epi, class Sched, bool ALIGN_EPI = false, bool SP2 = false>
__device__ __forceinline__ void gemm_phase(PG8_LAS unsigned char* lds, const Gemm g, const Sched& S, const Epi& E) {
    const int tid = threadIdx.x, wid = __builtin_amdgcn_readfirstlane(tid >> 6), lane = tid & 63, wr = wid >> 2, wc = wid & 3, fr = lane & 15, fq = lane >> 4;
    const int K = g.K, nt = K / BK;
    unsigned voffA[2], voffB[2];
#pragma unroll
    for (int i = 0; i < 2; ++i) { int R, C; stage_rc(tid * 16 + i * 8192, R, C); const int Rb = Epi::PERM ? ((R & ~31) + perm32(R & 31)) : R;
        voffA[i] = (unsigned)(R * K + C) * 2u; voffB[i] = (unsigned)(Rb * K + C) * 2u; }
    const size_t kstep = (size_t)(BK * 2);
    const size_t hstep = (size_t)HALF * K * 2;
    const size_t tstep = 2 * hstep;
    const unsigned ldsw = (unsigned)wid * 1024u;
    const int aoff = lds_byte(wr * 64 + fr, fq * 8), boff = lds_byte(wc * 32 + fr, fq * 8);
#define PG8_SA(b, h) (((b) * 2 + (h)) * HTB)
#define PG8_SB(b, h) ((4 + (b) * 2 + (h)) * HTB)
#define PG8_STAGE(bufoff, gbase, voff) do { _Pragma("unroll") for (int _i = 0; _i < 2; ++_i) \
        __builtin_amdgcn_global_load_lds((const unsigned*)((const char*)(gbase) + (voff)[_i]), (PG8_LAS unsigned*)(lds + (bufoff) + ldsw + _i * 8192), 16, 0, 0); } while (0)
#define PG8_LDA(dst, b, h) do { _Pragma("unroll") for (int m = 0; m < 4; ++m) _Pragma("unroll") for (int k = 0; k < 2; ++k) dst[m][k] = *(const PG8_LAS bf16x8*)(lds + PG8_SA(b, h) + aoff + m * 2048 + k * 1024); } while (0)
#define PG8_LDB(dst, b, h) do { _Pragma("unroll") for (int n = 0; n < 2; ++n) _Pragma("unroll") for (int k = 0; k < 2; ++k) dst[n][k] = *(const PG8_LAS bf16x8*)(lds + PG8_SB(b, h) + boff + n * 2048 + k * 1024); } while (0)
#define PG8_MMA(ai, bj, At, Bt) do { __builtin_amdgcn_s_setprio(1); _Pragma("unroll") for (int m = 0; m < 4; ++m) _Pragma("unroll") for (int n = 0; n < 2; ++n) _Pragma("unroll") for (int k = 0; k < 2; ++k) \
        acc[ai][bj][m][n] = __builtin_amdgcn_mfma_f32_16x16x32_bf16(Bt[n][k], At[m][k], acc[ai][bj][m][n], 0, 0, 0); __builtin_amdgcn_s_setprio(0); } while (0)
#define PG8_WAIT_V(n) asm volatile("s_waitcnt vmcnt(" #n ")" ::: "memory")
#define PG8_WAIT_L(n) asm volatile("s_waitcnt lgkmcnt(" #n ")" ::: "memory")
#define PG8_BAR __builtin_amdgcn_s_barrier()
#define PG8_SCHED __builtin_amdgcn_sched_barrier(0)
    Unit cur, nxt; int ui = 0;
    if (!S.next(0, cur)) return;
    f32x4 acc[2][2][4][2];
#pragma unroll
    for (int a = 0; a < 2; ++a)
#pragma unroll
        for (int b = 0; b < 2; ++b)
#pragma unroll
            for (int m = 0; m < 4; ++m)
#pragma unroll
                for (int n = 0; n < 2; ++n) acc[a][b][m][n] = (f32x4){0.f, 0.f, 0.f, 0.f};
    bf16x8 At[4][2], B0[2][2], B1[2][2];
    const char* cA = (const char*)g.A + (size_t)cur.pm * tstep; const char* cB = (const char*)g.Bt + (size_t)cur.pn * tstep;
    S.a_ready(cur);
    if constexpr (SP2) {
        PG8_STAGE(PG8_SB(0, 0), cB, voffB); PG8_STAGE(PG8_SB(0, 1), cB + hstep, voffB); PG8_STAGE(PG8_SA(0, 0), cA, voffA); PG8_STAGE(PG8_SA(0, 1), cA + hstep, voffA);
        if (wr == 1) PG8_BAR;
        PG8_WAIT_V(2); PG8_BAR;
        PG8_STAGE(PG8_SB(1, 0), cB + kstep, voffB); PG8_STAGE(PG8_SA(1, 0), cA + kstep, voffA); PG8_STAGE(PG8_SB(1, 1), cB + hstep + kstep, voffB);
        PG8_WAIT_V(6); PG8_BAR;
    } else {
        PG8_STAGE(PG8_SB(0, 0), cB, voffB); PG8_STAGE(PG8_SA(0, 0), cA, voffA); PG8_STAGE(PG8_SB(0, 1), cB + hstep, voffB); PG8_STAGE(PG8_SA(0, 1), cA + hstep, voffA);
        if (wr == 1) PG8_BAR;
        PG8_WAIT_V(4); PG8_BAR;
        PG8_STAGE(PG8_SB(1, 0), cB + kstep, voffB); PG8_STAGE(PG8_SA(1, 0), cA + kstep, voffA); PG8_STAGE(PG8_SB(1, 1), cB + hstep + kstep, voffB);
        PG8_WAIT_V(6); PG8_BAR;
    }
    for (;;) {
        const bool has_next = S.next(ui + 1, nxt);
        const char* nA = has_next ? (const char*)g.A + (size_t)nxt.pm * tstep : cA; const char* nB = has_next ? (const char*)g.Bt + (size_t)nxt.pn * tstep : cB;
        for (int t = 0; t < nt; t += 2) {
            const bool last = (t == nt - 2);
            const char* a1 = cA + (size_t)(t + 1) * kstep;
            const char* a2 = last ? nA : cA + (size_t)(t + 2) * kstep; const char* b2 = last ? nB : cB + (size_t)(t + 2) * kstep;
            const char* a3 = a2 + kstep; const char* b3 = b2 + kstep;
            if (last && has_next) S.a_ready(nxt);
            if constexpr (SP2) {
            PG8_LDB(B0, 0, 0); PG8_LDB(B1, 0, 1); PG8_SCHED; PG8_LDA(At, 0, 0); PG8_STAGE(PG8_SA(1, 1), a1 + hstep, voffA);
            PG8_WAIT_V(8); PG8_WAIT_L(0); PG8_BAR; PG8_MMA(0, 0, At, B0); PG8_MMA(0, 1, At, B1); PG8_BAR; PG8_SCHED;
            PG8_LDA(At, 0, 1); PG8_STAGE(PG8_SB(0, 0), b2, voffB); PG8_STAGE(PG8_SB(0, 1), b2 + hstep, voffB); PG8_STAGE(PG8_SA(0, 0), a2, voffA);
            PG8_WAIT_V(8); PG8_WAIT_L(0); PG8_BAR; PG8_MMA(1, 0, At, B0); PG8_MMA(1, 1, At, B1); PG8_BAR; PG8_SCHED;
            PG8_LDB(B0, 1, 0); PG8_LDB(B1, 1, 1); PG8_SCHED; PG8_LDA(At, 1, 0); PG8_STAGE(PG8_SA(0, 1), a2 + hstep, voffA);
            PG8_WAIT_V(8); PG8_WAIT_L(0); PG8_BAR; PG8_MMA(0, 0, At, B0); PG8_MMA(0, 1, At, B1); PG8_BAR; PG8_SCHED;
            PG8_LDA(At, 1, 1); PG8_STAGE(PG8_SB(1, 0), b3, voffB); PG8_STAGE(PG8_SB(1, 1), b3 + hstep, voffB); PG8_STAGE(PG8_SA(1, 0), a3, voffA);
            PG8_WAIT_V(8); PG8_WAIT_L(0); PG8_BAR; PG8_MMA(1, 0, At, B0); PG8_MMA(1, 1, At, B1); PG8_BAR; PG8_SCHED;
            } else {
            PG8_LDB(B0, 0, 0); PG8_SCHED; PG8_LDA(At, 0, 0); PG8_STAGE(PG8_SA(1, 1), a1 + hstep, voffA);
            PG8_WAIT_L(8); PG8_BAR; PG8_WAIT_L(0); PG8_MMA(0, 0, At, B0); PG8_BAR; PG8_SCHED;
            PG8_LDB(B1, 0, 1); PG8_STAGE(PG8_SB(0, 0), b2, voffB);
            PG8_BAR; PG8_WAIT_L(0); PG8_MMA(0, 1, At, B1); PG8_BAR;
            PG8_LDA(At, 0, 1); PG8_STAGE(PG8_SA(0, 0), a2, voffA);
            PG8_BAR; PG8_WAIT_L(0); PG8_MMA(1, 0, At, B0); PG8_BAR; PG8_SCHED;
            PG8_STAGE(PG8_SB(0, 1), b2 + hstep, voffB);
            PG8_WAIT_V(6); PG8_BAR; PG8_MMA(1, 1, At, B1); PG8_BAR;
            PG8_LDB(B0, 1, 0); PG8_SCHED; PG8_LDA(At, 1, 0); PG8_STAGE(PG8_SA(0, 1), a2 + hstep, voffA);
            PG8_WAIT_L(8); PG8_BAR; PG8_WAIT_L(0); PG8_MMA(0, 0, At, B0); PG8_BAR; PG8_SCHED;
            PG8_LDB(B1, 1, 1); PG8_STAGE(PG8_SB(1, 0), b3, voffB);
            PG8_BAR; PG8_WAIT_L(0); PG8_MMA(0, 1, At, B1); PG8_BAR;
            PG8_LDA(At, 1, 1); PG8_STAGE(PG8_SA(1, 0), a3, voffA);
            PG8_BAR; PG8_WAIT_L(0); PG8_MMA(1, 0, At, B0); PG8_BAR; PG8_SCHED;
            PG8_STAGE(PG8_SB(1, 1), b3 + hstep, voffB);
            PG8_WAIT_V(6); PG8_BAR; PG8_MMA(1, 1, At, B1); PG8_BAR;
            }
        }
        if constexpr (ALIGN_EPI) { if (wr == 0) PG8_BAR; }
        if constexpr (!Epi::AFTER_DRAIN) { E(acc, cur, wr, wc, fr, fq); S.done(cur); }
        if (!has_next) break;
#pragma unroll
        for (int a = 0; a < 2; ++a)
#pragma unroll
            for (int b = 0; b < 2; ++b)
#pragma unroll
                for (int m = 0; m < 4; ++m)
#pragma unroll
                    for (int n = 0; n < 2; ++n) acc[a][b][m][n] = (f32x4){0.f, 0.f, 0.f, 0.f};
        cur = nxt; cA = nA; cB = nB; ++ui;
        if constexpr (ALIGN_EPI) { if (wr == 1) PG8_BAR; }
    }
    PG8_WAIT_V(0);
    if constexpr (!ALIGN_EPI) { if (wr == 0) PG8_BAR; }
    PG8_BAR;
    if constexpr (Epi::AFTER_DRAIN) { E.fused(acc, cur, wr, wc, fr, fq, lds, wid, lane); S.done(cur); }
#undef PG8_SA
#undef PG8_SB
#undef PG8_STAGE
#undef PG8_LDA
#undef PG8_LDB
#undef PG8_MMA
#undef PG8_WAIT_V
#undef PG8_WAIT_L
#undef PG8_BAR
#undef PG8_SCHED
}
}
typedef unsigned short bf16;
typedef float f32x4 __attribute__((ext_vector_type(4)));
typedef unsigned u32x4 __attribute__((ext_vector_type(4)));
typedef unsigned u32x2 __attribute__((ext_vector_type(2)));
constexpr int BATCH = 2, SEQ = 16384, DM = 2048, DEPTH = 4, M = BATCH * SEQ, DFF = 8192, PLE = 256;
constexpr int EV_IN = 5136, EV_INP = 5376, OD_IN = 6432, OD_INP = 6656;
constexpr int EZ_Q = 512, EZ_K = 1280, EZ_V = 2048, EZ_G = 3584, EZ_R = 5120;
constexpr int OZ_HW = 3072, OZ_HA = 3136, OZ_HG = 3200, OZ_DQ = 3360, OZ_DK = 4384, OZ_DV = 5408;
constexpr size_t MiB = 1u << 20;
constexpr size_t WS_CTL = 0, WS_WIN = 1 * MiB, WS_WOUT = 27 * MiB, WS_WUP = 35 * MiB, WS_WDN = 67 * MiB, WS_WGT = 99 * MiB, WS_WPJ = 107 * MiB;
constexpr size_t WS_H = 110 * MiB, WS_Y = 238 * MiB, WS_MIX = 366 * MiB, WS_PB = 494 * MiB, WS_Z = 510 * MiB, WS_HID = 510 * MiB;
constexpr size_t WS_DEC = 1136 * MiB, WS_T_EV = 846 * MiB, WS_T_OD = 926 * MiB, WS_NEED = 1200 * MiB;
constexpr size_t SLOT = 64 * MiB;

__device__ __forceinline__ unsigned f2bf(float f) { unsigned u = __builtin_bit_cast(unsigned, f); return (u + 0x7fffu + ((u >> 16) & 1u)) >> 16; }
__device__ __forceinline__ unsigned pk2(float lo, float hi) { return f2bf(lo) | (f2bf(hi) << 16); }
__device__ __forceinline__ float bf2f(bf16 h) { return __uint_as_float((unsigned)h << 16); }
__device__ __forceinline__ float bflo_(unsigned w) { return __uint_as_float(w << 16); }
__device__ __forceinline__ float bfhi_(unsigned w) { return __uint_as_float(w & 0xffff0000u); }
__device__ __forceinline__ float wave_sum(float v) {
#pragma unroll
    for (int o = 1; o < 64; o <<= 1) v += __shfl_xor(v, o);
    return v;
}
__device__ __forceinline__ float sigmoidf_(float x) { return 1.f / (1.f + __expf(-x)); }
__device__ __forceinline__ float softplusf_(float x) { return fmaxf(x, 0.f) + log1pf(__expf(-fabsf(x))); }

__global__ void __launch_bounds__(256) k_wt(const float* __restrict__ W, int K, int N, bf16* __restrict__ Wt) {
    __shared__ float tile[64][65];
    const int n0 = blockIdx.x * 64, k0 = blockIdx.y * 64, tid = threadIdx.x, r = tid >> 6, c = tid & 63;
#pragma unroll
    for (int i = 0; i < 16; ++i) { const int kk = r + 4 * i, n = n0 + c; tile[kk][c] = (n < N) ? W[(size_t)(k0 + kk) * N + n] : 0.f; }
    __syncthreads();
#pragma unroll
    for (int j = 0; j < 2; ++j) { const int q = tid + 256 * j, n = q >> 3, kc = q & 7;
        u32x4 o; o.x = pk2(tile[8 * kc + 0][n], tile[8 * kc + 1][n]); o.y = pk2(tile[8 * kc + 2][n], tile[8 * kc + 3][n]);
        o.z = pk2(tile[8 * kc + 4][n], tile[8 * kc + 5][n]); o.w = pk2(tile[8 * kc + 6][n], tile[8 * kc + 7][n]);
        *(u32x4*)(Wt + (size_t)(n0 + n) * K + k0 + 8 * kc) = o; }
}
__global__ void __launch_bounds__(256) k_cvt(const float* __restrict__ s, bf16* __restrict__ d, size_t n4) {
    const size_t i = (size_t)blockIdx.x * 256 + threadIdx.x; if (i >= n4) return;
    const f32x4 v = ((const f32x4*)s)[i]; u32x2 o; o.x = pk2(v[0], v[1]); o.y = pk2(v[2], v[3]); ((u32x2*)d)[i] = o;
}
__global__ void __launch_bounds__(256) k_norm0(const float* __restrict__ xin, float* xout, const float* __restrict__ g, bf16* __restrict__ h) {
    const int row = blockIdx.x * 4 + (threadIdx.x >> 6), lane = threadIdx.x & 63;
    const f32x4* xr = (const f32x4*)(xin + (size_t)row * DM) + lane;
    f32x4 v[8]; float s = 0.f;
#pragma unroll
    for (int j = 0; j < 8; ++j) { v[j] = xr[64 * j]; s += (v[j][0] * v[j][0] + v[j][1] * v[j][1]) + (v[j][2] * v[j][2] + v[j][3] * v[j][3]); }
    s = wave_sum(s); const float rstd = 1.0f / sqrtf(s * (1.0f / DM) + 1e-6f);
    if (xout) { f32x4* xo = (f32x4*)(xout + (size_t)row * DM) + lane;
#pragma unroll
        for (int j = 0; j < 8; ++j) xo[64 * j] = v[j]; }
    u32x2* ho = (u32x2*)(h + (size_t)row * DM) + lane;
#pragma unroll
    for (int j = 0; j < 8; ++j) { const f32x4 gg = ((const f32x4*)g)[lane + 64 * j]; u32x2 o; o.x = pk2(v[j][0] * rstd * gg[0], v[j][1] * rstd * gg[1]); o.y = pk2(v[j][2] * rstd * gg[2], v[j][3] * rstd * gg[3]); ho[64 * j] = o; }
}
__global__ void __launch_bounds__(256) k_norm_res(const bf16* __restrict__ y, float* x, const float* __restrict__ g1, const float* __restrict__ g2, bf16* __restrict__ h) {
    const int row = blockIdx.x * 4 + (threadIdx.x >> 6), lane = threadIdx.x & 63;
    const u32x2* yr = (const u32x2*)(y + (size_t)row * DM) + lane;
    f32x4* xr = (f32x4*)(x + (size_t)row * DM) + lane;
    f32x4 yv[8], xv[8]; float s = 0.f;
#pragma unroll
    for (int j = 0; j < 8; ++j) { const u32x2 w = yr[64 * j]; yv[j][0] = __uint_as_float(w.x << 16); yv[j][1] = __uint_as_float(w.x & 0xffff0000u); yv[j][2] = __uint_as_float(w.y << 16); yv[j][3] = __uint_as_float(w.y & 0xffff0000u);
        xv[j] = xr[64 * j]; s += (yv[j][0] * yv[j][0] + yv[j][1] * yv[j][1]) + (yv[j][2] * yv[j][2] + yv[j][3] * yv[j][3]); }
    s = wave_sum(s); const float rstd = 1.0f / sqrtf(s * (1.0f / DM) + 1e-6f);
    float s2 = 0.f;
#pragma unroll
    for (int j = 0; j < 8; ++j) { const f32x4 gg = ((const f32x4*)g1)[lane + 64 * j]; xv[j] = xv[j] + yv[j] * rstd * gg; xr[64 * j] = xv[j];
        s2 += (xv[j][0] * xv[j][0] + xv[j][1] * xv[j][1]) + (xv[j][2] * xv[j][2] + xv[j][3] * xv[j][3]); }
    s2 = wave_sum(s2); const float rstd2 = 1.0f / sqrtf(s2 * (1.0f / DM) + 1e-6f);
    u32x2* ho = (u32x2*)(h + (size_t)row * DM) + lane;
#pragma unroll
    for (int j = 0; j < 8; ++j) { const f32x4 gg = ((const f32x4*)g2)[lane + 64 * j]; u32x2 o; o.x = pk2(xv[j][0] * rstd2 * gg[0], xv[j][1] * rstd2 * gg[1]); o.y = pk2(xv[j][2] * rstd2 * gg[2], xv[j][3] * rstd2 * gg[3]); ho[64 * j] = o; }
}
struct GArgs { const bf16* A; const bf16* Bt; bf16* O; const bf16* PP; float* X; int Mr, N, K, ldc; };
template <int MODE> __global__ void __launch_bounds__(512, 2) k_gemm(GArgs a) {
    extern __shared__ __attribute__((aligned(16))) unsigned char lds[];
    pg8::Gemm g; g.A = a.A; g.Bt = a.Bt; g.M = a.Mr; g.N = a.N; g.K = a.K;
    pg8::StaticOrder S; S.init(a.Mr, a.N, (int)gridDim.x, (int)blockIdx.x);
    if constexpr (MODE == 0) { pg8::EpiBf16<0> E{a.O, a.ldc}; pg8::gemm_phase<pg8::EpiBf16<0>, pg8::StaticOrder, true, true>((PG8_LAS unsigned char*)lds, g, S, E); }
    else if constexpr (MODE == 2) { pg8::EpiBf16<2> E{a.O, a.ldc}; pg8::gemm_phase<pg8::EpiBf16<2>, pg8::StaticOrder, true, true>((PG8_LAS unsigned char*)lds, g, S, E); }
    else { pg8::EpiGate E{a.PP, a.X, a.ldc}; pg8::gemm_phase<pg8::EpiGate, pg8::StaticOrder, true, true>((PG8_LAS unsigned char*)lds, g, S, E); }
}
__global__ void __launch_bounds__(512) k_pool(const bf16* __restrict__ z, const float* __restrict__ pw, const float* __restrict__ ps, bf16* __restrict__ mix) {
    __shared__ float pooled[512];
    const int m = blockIdx.x, t = m % SEQ, c = threadIdx.x, g = c >> 7, w = 2 << g;
    const int cnt = (t + 1 < w) ? (t + 1) : w;
    float sum = 0.f;
    for (int j = 0; j < cnt; ++j) sum += bf2f(z[(size_t)(m - j) * EV_INP + c]);
    pooled[c] = sum / (float)cnt - bf2f(z[(size_t)m * EV_INP + c]);
    __syncthreads();
    const int d = c & 127; float acc = 0.f;
    const float* wg = pw + (size_t)g * 128 * 128;
    for (int cc = 0; cc < 128; ++cc) acc += pooled[g * 128 + cc] * wg[cc * 128 + d];
    mix[(size_t)m * DM + c] = (bf16)f2bf(acc * ps[c]);
}
__global__ void __launch_bounds__(256) k_gla_gate(const bf16* __restrict__ z, const float* __restrict__ w2, const float* __restrict__ gb, float* __restrict__ GK) {
    __shared__ float glr[16];
    const int m = blockIdx.x, tid = threadIdx.x;
    if (tid < 16) glr[tid] = bf2f(z[(size_t)m * EV_INP + EZ_R + tid]);
    __syncthreads();
#pragma unroll
    for (int i = 0; i < 3; ++i) { const int j = tid + 256 * i; float x = gb[j];
#pragma unroll
        for (int r = 0; r < 16; ++r) x += glr[r] * w2[r * 768 + j];
        GK[(size_t)m * 768 + j] = -softplusf_(-x) * (1.0f / 16.0f); }
}
__global__ void __launch_bounds__(64) k_gla_rec(const bf16* __restrict__ z, const float* __restrict__ GK, float* __restrict__ ORAW) {
    constexpr int TB = 16;
    __shared__ f32x4 qs[TB][48], ks[TB][48], es[TB][48];
    const int bh = blockIdx.x / 6, eb = blockIdx.x % 6, b = bh >> 2, h = bh & 3, lane = threadIdx.x, e = eb * 64 + lane;
    const float scale = 0.07216878364870323f;
    float S[192];
#pragma unroll
    for (int d = 0; d < 192; ++d) S[d] = 0.f;
    for (int t0 = 0; t0 < SEQ; t0 += TB) {
        const size_t m0 = (size_t)b * SEQ + t0;
        float vv[TB];
#pragma unroll
        for (int s = 0; s < TB; ++s) vv[s] = bf2f(z[(m0 + s) * EV_INP + EZ_V + h * 384 + e]);
        __syncthreads();
        for (int i = lane; i < TB * 192; i += 64) { const int s = i / 192, d = i % 192; const size_t m = m0 + s;
            ((float*)qs)[s * 192 + d] = bf2f(z[m * EV_INP + EZ_Q + h * 192 + d]) * scale;
            ((float*)ks)[s * 192 + d] = bf2f(z[m * EV_INP + EZ_K + h * 192 + d]);
            ((float*)es)[s * 192 + d] = __expf(GK[m * 768 + h * 192 + d]); }
        __syncthreads();
        for (int s = 0; s < TB; ++s) {
            float o = 0.f; const float v = vv[s];
#pragma unroll
            for (int d4 = 0; d4 < 48; ++d4) { const f32x4 q4 = qs[s][d4], k4 = ks[s][d4], e4 = es[s][d4];
#pragma unroll
                for (int c = 0; c < 4; ++c) { S[4 * d4 + c] = S[4 * d4 + c] * e4[c] + k4[c] * v; o += q4[c] * S[4 * d4 + c]; } }
            ORAW[(m0 + s) * 1536 + h * 384 + e] = o;
        }
    }
}
__global__ void __launch_bounds__(256) k_gla_fin(const float* __restrict__ ORAW, const bf16* __restrict__ z, const float* __restrict__ gn, bf16* __restrict__ mix) {
    const int m = blockIdx.x, h = threadIdx.x >> 6, lane = threadIdx.x & 63;
    float o[6]; float ss = 0.f;
#pragma unroll
    for (int i = 0; i < 6; ++i) { o[i] = ORAW[(size_t)m * 1536 + h * 384 + lane + 64 * i]; ss += o[i] * o[i]; }
    ss = wave_sum(ss); const float rstd = 1.0f / sqrtf(ss * (1.0f / 384.0f) + 1e-6f);
#pragma unroll
    for (int i = 0; i < 6; ++i) { const int e = lane + 64 * i; const float go = bf2f(z[(size_t)m * EV_INP + EZ_G + h * 384 + e]);
        const float r = o[i] * rstd * gn[e] * (go * sigmoidf_(go)); mix[(size_t)m * DM + 512 + h * 384 + e] = (bf16)f2bf(r); }
}
struct RwkvP { const float *mu, *w0, *w2, *a0, *a2, *g2, *kk, *ka, *rk, *lnw, *lnb; };
__device__ __forceinline__ float tshift(const bf16* __restrict__ z, int m, int t, int col, const float* __restrict__ mu) {
    const float hc = bf2f(z[(size_t)m * OD_INP + col]); const float pv = (t > 0) ? bf2f(z[(size_t)(m - 1) * OD_INP + col]) : 0.f;
    return hc + (pv - hc) * mu[col];
}
__global__ void __launch_bounds__(256) k_rwkv_prep(const bf16* __restrict__ z, RwkvP P, bf16* R, bf16* LD, bf16* KM, bf16* V, bf16* KK, bf16* BV) {
    __shared__ float sm[128];
    const int m = blockIdx.x, t = m % SEQ, tid = threadIdx.x;
    if (tid < 128) { const float v = tshift(z, m, t, OZ_HW + tid, P.mu); sm[tid] = (tid < 64) ? tanhf(v) : v; }
    __syncthreads();
#pragma unroll
    for (int i = 0; i < 4; ++i) { const int c = tid + 256 * i;
        const float r = tshift(z, m, t, c, P.mu), k = tshift(z, m, t, 1024 + c, P.mu), v = tshift(z, m, t, 2048 + c, P.mu);
        float dw = P.w0[c], ap = P.a0[c];
        for (int j = 0; j < 64; ++j) { dw += sm[j] * P.w2[j * 1024 + c]; ap += sm[64 + j] * P.a2[j * 1024 + c]; }
        const float a = sigmoidf_(ap);
        const float wlog = -softplusf_(-dw) - 0.5f; const float ld = -__expf(wlog);
        const float kk = k * P.kk[c]; const float ss = wave_sum(kk * kk); const float kkn = kk / fmaxf(sqrtf(ss), 1e-12f);
        const float km = k * (1.f + (a - 1.f) * P.ka[c]);
        const size_t o = (size_t)m * 1024 + c;
        R[o] = (bf16)f2bf(r); LD[o] = (bf16)f2bf(ld); KM[o] = (bf16)f2bf(km); V[o] = (bf16)f2bf(v); KK[o] = (bf16)f2bf(kkn); BV[o] = (bf16)f2bf(kkn * a); }
}
__global__ void __launch_bounds__(64) k_rwkv_scan(const bf16* __restrict__ R, const bf16* __restrict__ LD, const bf16* __restrict__ KM, const bf16* __restrict__ V, const bf16* __restrict__ KK, const bf16* __restrict__ BV, bf16* __restrict__ Y) {
    constexpr int TB = 8;
    __shared__ f32x4 sh[TB][5][16];
    const int b = blockIdx.x >> 4, h = blockIdx.x & 15, lane = threadIdx.x;
    float S[64];
#pragma unroll
    for (int k = 0; k < 64; ++k) S[k] = 0.f;
    for (int t0 = 0; t0 < SEQ; t0 += TB) {
        float vv[TB];
        __syncthreads();
#pragma unroll
        for (int s = 0; s < TB; ++s) { const size_t o = ((size_t)b * SEQ + t0 + s) * 1024 + h * 64 + lane;
            ((float*)sh[s][0])[lane] = bf2f(R[o]); ((float*)sh[s][1])[lane] = __expf(bf2f(LD[o])); ((float*)sh[s][2])[lane] = bf2f(KM[o]);
            ((float*)sh[s][3])[lane] = bf2f(KK[o]); ((float*)sh[s][4])[lane] = bf2f(BV[o]); vv[s] = bf2f(V[o]); }
        __syncthreads();
        for (int s = 0; s < TB; ++s) {
            float sa = 0.f;
#pragma unroll
            for (int k4 = 0; k4 < 16; ++k4) { const f32x4 a4 = sh[s][3][k4];
#pragma unroll
                for (int c = 0; c < 4; ++c) sa -= S[4 * k4 + c] * a4[c]; }
            const float v = vv[s]; float y = 0.f;
#pragma unroll
            for (int k4 = 0; k4 < 16; ++k4) { const f32x4 w4 = sh[s][1][k4], b4 = sh[s][4][k4], m4 = sh[s][2][k4], r4 = sh[s][0][k4];
#pragma unroll
                for (int c = 0; c < 4; ++c) { const float ns = S[4 * k4 + c] * w4[c] + sa * b4[c] + v * m4[c]; S[4 * k4 + c] = ns; y += ns * r4[c]; } }
            Y[((size_t)b * SEQ + t0 + s) * 1024 + h * 64 + lane] = (bf16)f2bf(y);
        }
    }
}
__global__ void __launch_bounds__(256) k_rwkv_fin(const bf16* __restrict__ z, RwkvP P, const bf16* __restrict__ R, const bf16* __restrict__ KM, const bf16* __restrict__ V, const bf16* __restrict__ Y, bf16* __restrict__ mix) {
    __shared__ float sm[160];
    const int m = blockIdx.x, t = m % SEQ, tid = threadIdx.x;
    if (tid < 160) sm[tid] = sigmoidf_(tshift(z, m, t, OZ_HG + tid, P.mu));
    __syncthreads();
#pragma unroll
    for (int i = 0; i < 4; ++i) { const int c = tid + 256 * i; const size_t o = (size_t)m * 1024 + c;
        float g = 0.f;
        for (int j = 0; j < 160; ++j) g += sm[j] * P.g2[j * 1024 + c];
        const float y = bf2f(Y[o]); const float mean = wave_sum(y) * (1.0f / 64.0f); const float dy = y - mean; const float var = wave_sum(dy * dy) * (1.0f / 64.0f);
        const float yn = dy * (1.0f / sqrtf(var + 64e-5f)) * P.lnw[c] + P.lnb[c];
        const float r = bf2f(R[o]), km = bf2f(KM[o]), v = bf2f(V[o]);
        const float bon = wave_sum(r * km * P.rk[c]) * v;
        mix[(size_t)m * DM + c] = (bf16)f2bf((yn + bon) * g); }
}
__global__ void __launch_bounds__(256) k_rope(bf16* z) {
    const int m = blockIdx.x, t = m % SEQ, tid = threadIdx.x;
#pragma unroll
    for (int i = 0; i < 4; ++i) { const int idx = tid + 256 * i, qk = idx >> 9, h = (idx >> 6) & 7, j = idx & 63;
        const float inv = powf(10000.0f, -(float)j * (1.0f / 64.0f)); const float ang = (float)t * inv;
        const double rev = (double)ang * 0.15915494309189535; const float fr = (float)(rev - rint(rev));
        const float sn = __builtin_amdgcn_sinf(fr), cs = __builtin_amdgcn_cosf(fr);
        bf16* p = z + (size_t)m * OD_INP + (qk ? OZ_DK : OZ_DQ) + h * 128 + j;
        const float x1 = bf2f(p[0]), x2 = bf2f(p[64]);
        p[0] = (bf16)f2bf(x1 * cs - x2 * sn); p[64] = (bf16)f2bf(x2 * cs + x1 * sn); }
}
__global__ void __launch_bounds__(256) k_dil(const bf16* __restrict__ z, bf16* __restrict__ mix) {
    const int gw = blockIdx.x * 4 + (threadIdx.x >> 6), lane = threadIdx.x & 63;
    const int m = gw >> 3, h = gw & 7, t = m % SEQ;
    const float scale = 0.08838834764831845f;
    const bf16* qp = z + (size_t)m * OD_INP + OZ_DQ + h * 128;
    const float q0 = bf2f(qp[lane]) * scale, q1 = bf2f(qp[lane + 64]) * scale;
    float mr = -INFINITY, l = 0.f, a0 = 0.f, a1 = 0.f;
    for (int br = 0; br < 3; ++br) { const int dil = (br == 0) ? 1 : (br == 1 ? 4 : 16);
        for (int j = 0; j <= 128; ++j) { const int tk = t - j * dil; if (tk < 0) break;
            const size_t mk = (size_t)(m - j * dil) * OD_INP;
            const bf16* kp = z + mk + OZ_DK + h * 128; const bf16* vp = z + mk + OZ_DV + h * 128;
            const float s = wave_sum(q0 * bf2f(kp[lane]) + q1 * bf2f(kp[lane + 64]));
            const float mn = fmaxf(mr, s); const float corr = __expf(mr - mn), p = __expf(s - mn);
            l = l * corr + p; a0 = a0 * corr + p * bf2f(vp[lane]); a1 = a1 * corr + p * bf2f(vp[lane + 64]); mr = mn; } }
    const float il = 1.0f / l;
    bf16* op = mix + (size_t)m * DM + 1024 + h * 128;
    op[lane] = (bf16)f2bf(a0 * il); op[lane + 64] = (bf16)f2bf(a1 * il);
}
#define LAS __attribute__((address_space(3)))
typedef LAS unsigned char lds_t;
typedef short bf16x8 __attribute__((ext_vector_type(8)));
typedef short s16x4 __attribute__((ext_vector_type(4)));
typedef short v4i16_t __attribute__((ext_vector_type(4)));
__device__ __forceinline__ s16x4 vtr(const lds_t* p) { return __builtin_bit_cast(s16x4, __builtin_amdgcn_ds_read_tr16_b64_v4i16((LAS v4i16_t*)p)); }
__device__ __forceinline__ bf16x8 cat8(s16x4 a, s16x4 b) { bf16x8 r; r[0] = a[0]; r[1] = a[1]; r[2] = a[2]; r[3] = a[3]; r[4] = b[0]; r[5] = b[1]; r[6] = b[2]; r[7] = b[3]; return r; }
__device__ __forceinline__ f32x4 mfma16(bf16x8 a, bf16x8 b, f32x4 c) { return __builtin_amdgcn_mfma_f32_16x16x32_bf16(a, b, c, 0, 0, 0); }
__device__ __forceinline__ u32x2 pack4(f32x4 v) { u32x2 o; o.x = pk2(v[0], v[1]); o.y = pk2(v[2], v[3]); return o; }
__device__ __forceinline__ f32x4 unpack4(u32x2 w) { f32x4 v; v[0] = __uint_as_float(w.x << 16); v[1] = __uint_as_float(w.x & 0xffff0000u); v[2] = __uint_as_float(w.y << 16); v[3] = __uint_as_float(w.y & 0xffff0000u); return v; }
constexpr int NCHUNK = SEQ / 64;
constexpr int GLA_UNITS = BATCH * 4 * NCHUNK;

__device__ __forceinline__ void ph_pool(lds_t* lds, int vcu, int G, const bf16* __restrict__ Z, const float* __restrict__ pw, const float* __restrict__ ps, bf16* __restrict__ MIX) {
    const int tid = threadIdx.x, wid = tid >> 6, lane = tid & 63, fr = lane & 15, fq = lane >> 4;
    constexpr int WST = 136;
    for (int u = vcu; u < M / 128; u += G) {
        const int m = u * 128 + wid * 16 + fr, t = m % SEQ;
        for (int g = 0; g < 4; ++g) {
            __syncthreads();
            for (int i = 0; i < 32; ++i) { const int idx = tid + 512 * i, c = idx >> 7, d = idx & 127; ((LAS bf16*)lds)[d * WST + c] = (bf16)f2bf(pw[(size_t)g * 16384 + idx]); }
            __syncthreads();
            const int w = 2 << g, cnt = (t + 1 < w) ? (t + 1) : w; const float icnt = 1.0f / (float)cnt;
            f32x4 acc[8];
#pragma unroll
            for (int dt = 0; dt < 8; ++dt) acc[dt] = (f32x4){0.f, 0.f, 0.f, 0.f};
#pragma unroll
            for (int ks = 0; ks < 4; ++ks) {
                const bf16* zp = Z + (size_t)m * EV_INP + g * 128 + 32 * ks + 8 * fq;
                float s[8], own[8];
                { const u32x4 r = *(const u32x4*)zp; own[0] = bflo_(r.x); own[1] = bfhi_(r.x); own[2] = bflo_(r.y); own[3] = bfhi_(r.y); own[4] = bflo_(r.z); own[5] = bfhi_(r.z); own[6] = bflo_(r.w); own[7] = bfhi_(r.w); }
#pragma unroll
                for (int e = 0; e < 8; ++e) s[e] = own[e];
                for (int j = 1; j < cnt; ++j) { const u32x4 r = *(const u32x4*)(zp - (size_t)j * EV_INP);
                    s[0] += bflo_(r.x); s[1] += bfhi_(r.x); s[2] += bflo_(r.y); s[3] += bfhi_(r.y); s[4] += bflo_(r.z); s[5] += bfhi_(r.z); s[6] += bflo_(r.w); s[7] += bfhi_(r.w); }
                u32x4 pk; pk.x = pk2(s[0] * icnt - own[0], s[1] * icnt - own[1]); pk.y = pk2(s[2] * icnt - own[2], s[3] * icnt - own[3]);
                pk.z = pk2(s[4] * icnt - own[4], s[5] * icnt - own[5]); pk.w = pk2(s[6] * icnt - own[6], s[7] * icnt - own[7]);
                const bf16x8 bfrag = __builtin_bit_cast(bf16x8, pk);
#pragma unroll
                for (int dt = 0; dt < 8; ++dt) { const bf16x8 afrag = *(const LAS bf16x8*)(lds + ((16 * dt + fr) * WST + 32 * ks + 8 * fq) * 2); acc[dt] = mfma16(afrag, bfrag, acc[dt]); }
            }
#pragma unroll
            for (int dt = 0; dt < 8; ++dt) { const int d = 16 * dt + 4 * fq; const f32x4 sc = *(const f32x4*)(ps + g * 128 + d);
                *(u32x2*)(MIX + (size_t)m * DM + g * 128 + d) = pack4(acc[dt] * sc); }
        }
    }
}
constexpr int G1_QT = 0, G1_KT = 25600, G1_KH = 51200, G1_VT = 76800, G1_SCR = 126976, G1_LDS = 145664;
constexpr int G1_W2 = G1_SCR, G1_BIAS = G1_SCR + 12288, G1_GLR = G1_BIAS + 768, G1_TOT = G1_GLR + 4096, G1_AT = G1_SCR;
constexpr int QST = 400, VST = 784, AST = 144;
__device__ __forceinline__ void ph_gla1(lds_t* lds, int vcu, int G, bf16* Z, const float* __restrict__ w2, const float* __restrict__ gb, bf16* __restrict__ MIX, bf16* __restrict__ ST, float* __restrict__ DEC) {
    const int tid = threadIdx.x, wid = tid >> 6, lane = tid & 63, fr = lane & 15, fq = lane >> 4, lq = fr >> 2, lp = fr & 3;
    const float scale = 0.07216878364870323f;
    for (int u = vcu; u < GLA_UNITS; u += G) {
        const int b = u / (4 * NCHUNK), h = (u / NCHUNK) & 3, n = u % NCHUNK; const size_t m0 = (size_t)b * SEQ + (size_t)n * 64;
        __syncthreads();
#pragma unroll
        for (int i = 0; i < 6; ++i) { const int q = tid + 512 * i, row = q / 48, cc = q % 48;
            *(LAS u32x4*)(lds + G1_VT + row * VST + cc * 16) = *(const u32x4*)(Z + (m0 + row) * EV_INP + EZ_V + h * 384 + cc * 8); }
#pragma unroll
        for (int i = 0; i < 6; ++i) { const int q = tid + 512 * i, r = q / 192, d = q % 192; ((LAS float*)(lds + G1_W2))[q] = w2[r * 768 + h * 192 + d]; }
        if (tid < 192) ((LAS float*)(lds + G1_BIAS))[tid] = gb[h * 192 + tid];
#pragma unroll
        for (int i = 0; i < 2; ++i) { const int q = tid + 512 * i, row = q >> 4, r = q & 15; ((LAS float*)(lds + G1_GLR))[q] = bf2f(Z[(m0 + row) * EV_INP + EZ_R + r]); }
        __syncthreads();
        const int d = tid % 192, seg = tid / 192;
        float wc[16]; float b0 = 0.f;
        if (tid < 384) {
#pragma unroll
            for (int r = 0; r < 16; ++r) wc[r] = ((LAS float*)(lds + G1_W2))[r * 192 + d];
            b0 = ((LAS float*)(lds + G1_BIAS))[d];
            float run = 0.f;
#pragma unroll 4
            for (int s = 0; s < 32; ++s) { const LAS f32x4* gp = (const LAS f32x4*)(lds + G1_GLR + (seg * 32 + s) * 64); float x = b0;
#pragma unroll
                for (int r4 = 0; r4 < 4; ++r4) { const f32x4 g4 = gp[r4]; x += g4[0] * wc[4 * r4] + g4[1] * wc[4 * r4 + 1] + g4[2] * wc[4 * r4 + 2] + g4[3] * wc[4 * r4 + 3]; }
                run += -softplusf_(-x) * (1.0f / 16.0f); }
            ((LAS float*)(lds + G1_TOT))[seg * 192 + d] = run;
        }
        __syncthreads();
        if (tid < 384) {
            const float t0 = ((LAS float*)(lds + G1_TOT))[d], t1 = ((LAS float*)(lds + G1_TOT))[192 + d];
            const float blast = t0 + t1; float run = seg ? t0 : 0.f;
            if (seg == 0) DEC[(size_t)u * 192 + d] = __expf(blast);
#pragma unroll 4
            for (int s = 0; s < 32; ++s) { const int t = seg * 32 + s;
                const LAS f32x4* gp = (const LAS f32x4*)(lds + G1_GLR + t * 64); float x = b0;
#pragma unroll
                for (int r4 = 0; r4 < 4; ++r4) { const f32x4 g4 = gp[r4]; x += g4[0] * wc[4 * r4] + g4[1] * wc[4 * r4 + 1] + g4[2] * wc[4 * r4 + 2] + g4[3] * wc[4 * r4 + 3]; }
                run += -softplusf_(-x) * (1.0f / 16.0f); const float bb = run;
                const float qv = bf2f(Z[(m0 + t) * EV_INP + EZ_Q + h * 192 + d]), kv = bf2f(Z[(m0 + t) * EV_INP + EZ_K + h * 192 + d]);
                *(LAS bf16*)(lds + G1_QT + t * QST + d * 2) = (bf16)f2bf(qv * scale * __expf(bb));
                *(LAS bf16*)(lds + G1_KT + t * QST + d * 2) = (bf16)f2bf(kv * __expf(-bb));
                *(LAS bf16*)(lds + G1_KH + t * QST + d * 2) = (bf16)f2bf(kv * __expf(blast - bb)); }
        }
        __syncthreads();
        { const int it = wid >> 1;
#pragma unroll
            for (int jj = 0; jj < 2; ++jj) { const int jt = 2 * (wid & 1) + jj; f32x4 acc = (f32x4){0.f, 0.f, 0.f, 0.f};
                if (jt <= it) {
#pragma unroll
                    for (int ks = 0; ks < 6; ++ks) { const bf16x8 a = *(const LAS bf16x8*)(lds + G1_QT + (16 * it + fr) * QST + (32 * ks + 8 * fq) * 2);
                        const bf16x8 bb = *(const LAS bf16x8*)(lds + G1_KT + (16 * jt + fr) * QST + (32 * ks + 8 * fq) * 2); acc = mfma16(a, bb, acc); } }
#pragma unroll
                for (int r = 0; r < 4; ++r) { const int i = 16 * it + 4 * fq + r, j = 16 * jt + fr; const float v = (j <= i) ? acc[r] : 0.f;
                    *(LAS bf16*)(lds + G1_AT + i * AST + j * 2) = (bf16)f2bf(v); } } }
        __syncthreads();
        bf16x8 vf[3][2];
#pragma unroll
        for (int el = 0; el < 3; ++el)
#pragma unroll
            for (int ks = 0; ks < 2; ++ks) { const lds_t* p = lds + G1_VT + (32 * ks + 8 * fq + lq) * VST + (16 * (3 * wid + el) + 4 * lp) * 2; vf[el][ks] = cat8(vtr(p), vtr(p + 4 * VST)); }
        { f32x4 acc[3][4];
#pragma unroll
            for (int el = 0; el < 3; ++el)
#pragma unroll
                for (int it = 0; it < 4; ++it) acc[el][it] = (f32x4){0.f, 0.f, 0.f, 0.f};
#pragma unroll
            for (int ks = 0; ks < 2; ++ks)
#pragma unroll
                for (int it = 0; it < 4; ++it) { const bf16x8 bb = *(const LAS bf16x8*)(lds + G1_AT + (16 * it + fr) * AST + (32 * ks + 8 * fq) * 2);
#pragma unroll
                    for (int el = 0; el < 3; ++el) acc[el][it] = mfma16(vf[el][ks], bb, acc[el][it]); }
#pragma unroll
            for (int el = 0; el < 3; ++el)
#pragma unroll
                for (int it = 0; it < 4; ++it) *(u32x2*)(MIX + (m0 + 16 * it + fr) * DM + 512 + h * 384 + 16 * (3 * wid + el) + 4 * fq) = pack4(acc[el][it]); }
#pragma unroll
        for (int half = 0; half < 2; ++half) { f32x4 acc[6][3];
#pragma unroll
            for (int dl = 0; dl < 6; ++dl)
#pragma unroll
                for (int el = 0; el < 3; ++el) acc[dl][el] = (f32x4){0.f, 0.f, 0.f, 0.f};
#pragma unroll
            for (int ks = 0; ks < 2; ++ks)
#pragma unroll
                for (int dl = 0; dl < 6; ++dl) { const lds_t* p = lds + G1_KH + (32 * ks + 8 * fq + lq) * QST + (16 * (6 * half + dl) + 4 * lp) * 2; const bf16x8 a = cat8(vtr(p), vtr(p + 4 * QST));
#pragma unroll
                    for (int el = 0; el < 3; ++el) acc[dl][el] = mfma16(a, vf[el][ks], acc[dl][el]); }
#pragma unroll
            for (int dl = 0; dl < 6; ++dl)
#pragma unroll
                for (int el = 0; el < 3; ++el) *(u32x2*)(ST + ((size_t)u * 384 + 16 * (3 * wid + el) + fr) * 192 + 16 * (6 * half + dl) + 4 * fq) = pack4(acc[dl][el]); }
#pragma unroll
        for (int i = 0; i < 3; ++i) { const int q = tid + 512 * i, row = q / 24, cc = q % 24;
            *(u32x4*)(Z + (m0 + row) * EV_INP + EZ_Q + h * 192 + cc * 8) = *(const LAS u32x4*)(lds + G1_QT + row * QST + cc * 16); }
    }
}
__device__ __forceinline__ void ph_gla2(int vcu, int G, bf16* ST, const float* __restrict__ DEC) {
    const int g = vcu * 512 + threadIdx.x;
    if (g >= 8 * 384 * 24) return;
    const int bh = g / 9216, rem = g % 9216, e = rem / 24, d8 = rem % 24;
    float S[8];
#pragma unroll
    for (int i = 0; i < 8; ++i) S[i] = 0.f;
    for (int n0 = 0; n0 < NCHUNK; n0 += 4) {
        u32x4 zin[4]; f32x4 dc[4][2];
#pragma unroll
        for (int k = 0; k < 4; ++k) { const size_t un = (size_t)bh * NCHUNK + n0 + k; zin[k] = *(const u32x4*)(ST + (un * 384 + e) * 192 + 8 * d8);
            dc[k][0] = *(const f32x4*)(DEC + un * 192 + 8 * d8); dc[k][1] = *(const f32x4*)(DEC + un * 192 + 8 * d8 + 4); }
#pragma unroll
        for (int k = 0; k < 4; ++k) { const size_t un = (size_t)bh * NCHUNK + n0 + k;
            u32x4 o; o.x = pk2(S[0], S[1]); o.y = pk2(S[2], S[3]); o.z = pk2(S[4], S[5]); o.w = pk2(S[6], S[7]);
            *(u32x4*)(ST + (un * 384 + e) * 192 + 8 * d8) = o;
            S[0] = S[0] * dc[k][0][0] + bflo_(zin[k].x); S[1] = S[1] * dc[k][0][1] + bfhi_(zin[k].x); S[2] = S[2] * dc[k][0][2] + bflo_(zin[k].y); S[3] = S[3] * dc[k][0][3] + bfhi_(zin[k].y);
            S[4] = S[4] * dc[k][1][0] + bflo_(zin[k].z); S[5] = S[5] * dc[k][1][1] + bfhi_(zin[k].z); S[6] = S[6] * dc[k][1][2] + bflo_(zin[k].w); S[7] = S[7] * dc[k][1][3] + bfhi_(zin[k].w); }
    }
}
__device__ __forceinline__ void ph_gla3(lds_t* lds, int vcu, int G, const bf16* __restrict__ Z, const bf16* __restrict__ ST, const float* __restrict__ gn, bf16* MIX) {
    const int tid = threadIdx.x, wid = tid >> 6, lane = tid & 63, fr = lane & 15, fq = lane >> 4;
    LAS float* red = (LAS float*)lds;
    for (int u = vcu; u < GLA_UNITS; u += G) {
        const int b = u / (4 * NCHUNK), h = (u / NCHUNK) & 3, n = u % NCHUNK; const size_t m0 = (size_t)b * SEQ + (size_t)n * 64;
        f32x4 acc[3][4];
#pragma unroll
        for (int el = 0; el < 3; ++el)
#pragma unroll
            for (int it = 0; it < 4; ++it) acc[el][it] = unpack4(*(const u32x2*)(MIX + (m0 + 16 * it + fr) * DM + 512 + h * 384 + 16 * (3 * wid + el) + 4 * fq));
#pragma unroll
        for (int ks = 0; ks < 6; ++ks) { bf16x8 a[3], bb[4];
#pragma unroll
            for (int el = 0; el < 3; ++el) a[el] = *(const bf16x8*)(ST + ((size_t)u * 384 + 16 * (3 * wid + el) + fr) * 192 + 32 * ks + 8 * fq);
#pragma unroll
            for (int it = 0; it < 4; ++it) bb[it] = *(const bf16x8*)(Z + (m0 + 16 * it + fr) * EV_INP + EZ_Q + h * 192 + 32 * ks + 8 * fq);
#pragma unroll
            for (int el = 0; el < 3; ++el)
#pragma unroll
                for (int it = 0; it < 4; ++it) acc[el][it] = mfma16(a[el], bb[it], acc[el][it]); }
        __syncthreads();
#pragma unroll
        for (int it = 0; it < 4; ++it) { float ss = 0.f;
#pragma unroll
            for (int el = 0; el < 3; ++el) ss += (acc[el][it][0] * acc[el][it][0] + acc[el][it][1] * acc[el][it][1]) + (acc[el][it][2] * acc[el][it][2] + acc[el][it][3] * acc[el][it][3]);
            ss += __shfl_xor(ss, 16); ss += __shfl_xor(ss, 32);
            if (fq == 0) red[wid * 64 + 16 * it + fr] = ss; }
        __syncthreads();
#pragma unroll
        for (int it = 0; it < 4; ++it) { float tot = 0.f;
#pragma unroll
            for (int w = 0; w < 8; ++w) tot += red[w * 64 + 16 * it + fr];
            const float rstd = 1.0f / sqrtf(tot * (1.0f / 384.0f) + 1e-6f);
#pragma unroll
            for (int el = 0; el < 3; ++el) { const int e = 16 * (3 * wid + el) + 4 * fq; const f32x4 g4 = *(const f32x4*)(gn + e);
                const f32x4 go = unpack4(*(const u32x2*)(Z + (m0 + 16 * it + fr) * EV_INP + EZ_G + h * 384 + e)); f32x4 o;
#pragma unroll
                for (int c = 0; c < 4; ++c) o[c] = acc[el][it][c] * rstd * g4[c] * (go[c] * sigmoidf_(go[c]));
                *(u32x2*)(MIX + (m0 + 16 * it + fr) * DM + 512 + h * 384 + e) = pack4(o); } }
    }
}

constexpr int DYN_LDS = 155648;
struct EvArgs { bf16* Z; const float *pw, *ps, *w2, *gb, *gn; bf16 *MIX, *ST; float* DEC; };
template <int PH> __global__ void __launch_bounds__(512, 2) k_even(EvArgs a) {
    extern __shared__ __attribute__((aligned(16))) unsigned char lds_raw[]; lds_t* lds = (lds_t*)lds_raw;
    const int vcu = blockIdx.x, G = gridDim.x;
    if constexpr (PH == 0) ph_pool(lds, vcu, G, a.Z, a.pw, a.ps, a.MIX);
    else if constexpr (PH == 1) ph_gla1(lds, vcu, G, a.Z, a.w2, a.gb, a.MIX, a.ST, a.DEC);
    else if constexpr (PH == 2) ph_gla2(vcu, G, a.ST, a.DEC);
    else ph_gla3(lds, vcu, G, a.Z, a.ST, a.gn, a.MIX);
}
template <int MODE> static void launch_gemm(hipStream_t st, int grid, const bf16* A, const bf16* Bt, bf16* O, const bf16* PP, float* X, int N, int K, int ldc) {
    GArgs a{}; a.A = A; a.Bt = Bt; a.O = O; a.PP = PP; a.X = X; a.Mr = M; a.N = N; a.K = K; a.ldc = ldc;
    k_gemm<MODE><<<grid, 512, 131072, st>>>(a);
}
static void conv_w(hipStream_t st, const float* W, int K, int N, int Npad, bf16* Wt) { k_wt<<<dim3(Npad / 64, K / 64), 256, 0, st>>>(W, K, N, Wt); }

extern "C" void kernel_launch(void* const* d_in, const int* in_sizes, int n_in, void* d_out, int out_size, void* d_ws, size_t ws_size, hipStream_t stream) {
    static int grid = 0;
    if (grid == 0) {
        if (n_in != 31 || out_size != M * DM || ws_size < WS_NEED) { fprintf(stderr, "kernel_launch: unexpected shapes n_in %d out %d ws %zu\n", n_in, out_size, ws_size); grid = -1; return; }
        int dev = 0, cus = 0; hipGetDevice(&dev); hipDeviceGetAttribute(&cus, hipDeviceAttributeMultiprocessorCount, dev);
        hipFuncSetAttribute((const void*)k_gemm<0>, hipFuncAttributeMaxDynamicSharedMemorySize, 131072);
        hipFuncSetAttribute((const void*)k_gemm<2>, hipFuncAttributeMaxDynamicSharedMemorySize, 131072);
        hipFuncSetAttribute((const void*)k_gemm<3>, hipFuncAttributeMaxDynamicSharedMemorySize, 131072);
        hipFuncSetAttribute((const void*)k_even<0>, hipFuncAttributeMaxDynamicSharedMemorySize, DYN_LDS); hipFuncSetAttribute((const void*)k_even<1>, hipFuncAttributeMaxDynamicSharedMemorySize, DYN_LDS);
        hipFuncSetAttribute((const void*)k_even<2>, hipFuncAttributeMaxDynamicSharedMemorySize, DYN_LDS); hipFuncSetAttribute((const void*)k_even<3>, hipFuncAttributeMaxDynamicSharedMemorySize, DYN_LDS);
        grid = cus > 0 ? cus : 256;
    }
    if (grid < 0) return;
    const float* const* in = (const float* const*)d_in;
    unsigned char* ws = (unsigned char*)d_ws; float* x = (float*)d_out;
    bf16 *WIN = (bf16*)(ws + WS_WIN), *WOUT = (bf16*)(ws + WS_WOUT), *WUP = (bf16*)(ws + WS_WUP), *WDN = (bf16*)(ws + WS_WDN), *WGT = (bf16*)(ws + WS_WGT), *WPJ = (bf16*)(ws + WS_WPJ);
    bf16 *H = (bf16*)(ws + WS_H), *Y = (bf16*)(ws + WS_Y), *MIX = (bf16*)(ws + WS_MIX), *PB = (bf16*)(ws + WS_PB), *Z = (bf16*)(ws + WS_Z), *HID = (bf16*)(ws + WS_HID);
    for (int i = 0; i < DEPTH; ++i) {
        const int j = i >> 1; const bool odd = i & 1;
        const int NZ = odd ? OD_INP : EV_INP;
        if (odd) conv_w(stream, in[13] + (size_t)j * DM * OD_IN, DM, OD_IN, OD_INP, WIN); else conv_w(stream, in[6] + (size_t)j * DM * EV_IN, DM, EV_IN, EV_INP, WIN);
        conv_w(stream, (odd ? in[14] : in[7]) + (size_t)j * DM * DM, DM, DM, DM, WOUT);
        conv_w(stream, in[26] + (size_t)i * DM * DFF, DM, DFF, DFF, WUP);
        conv_w(stream, in[27] + (size_t)i * DFF * DM, DFF, DM, DM, WDN);
        conv_w(stream, in[29] + (size_t)i * DM * DM, DM, DM, DM, WGT);
        conv_w(stream, in[28] + (size_t)i * PLE * DM, PLE, DM, DM, WPJ);
        k_cvt<<<(unsigned)(((size_t)M * PLE / 4 + 255) / 256), 256, 0, stream>>>(in[1] + (size_t)i * M * PLE, PB, (size_t)M * PLE / 4);
        k_norm0<<<M / 4, 256, 0, stream>>>(i == 0 ? in[0] : x, i == 0 ? x : nullptr, in[2] + (size_t)i * DM, H);
        launch_gemm<0>(stream, grid, H, WIN, Z, nullptr, nullptr, NZ, DM, NZ);
        if (!odd) {
            EvArgs e{}; e.Z = Z; e.pw = in[8] + (size_t)j * 4 * 128 * 128; e.ps = in[9] + (size_t)j * 512; e.w2 = in[10] + (size_t)j * 16 * 768; e.gb = in[11] + (size_t)j * 768; e.gn = in[12] + (size_t)j * 384;
            e.MIX = MIX; e.ST = (bf16*)(ws + WS_T_EV); e.DEC = (float*)(ws + WS_DEC);
            k_even<0><<<grid, 512, DYN_LDS, stream>>>(e);
            k_even<1><<<grid, 512, DYN_LDS, stream>>>(e);
            k_even<2><<<grid, 512, DYN_LDS, stream>>>(e);
            k_even<3><<<grid, 512, DYN_LDS, stream>>>(e);
        } else {
            RwkvP P{}; P.mu = in[15] + (size_t)j * 3360; P.w0 = in[16] + (size_t)j * 1024; P.w2 = in[17] + (size_t)j * 64 * 1024; P.a0 = in[18] + (size_t)j * 1024; P.a2 = in[19] + (size_t)j * 64 * 1024;
            P.g2 = in[20] + (size_t)j * 160 * 1024; P.kk = in[21] + (size_t)j * 1024; P.ka = in[22] + (size_t)j * 1024; P.rk = in[23] + (size_t)j * 1024; P.lnw = in[24] + (size_t)j * 1024; P.lnb = in[25] + (size_t)j * 1024;
            bf16 *R = (bf16*)(ws + WS_H), *LD = (bf16*)(ws + WS_H + SLOT), *KM = (bf16*)(ws + WS_H + 2 * SLOT), *V = (bf16*)(ws + WS_H + 3 * SLOT);
            bf16 *KK = (bf16*)(ws + WS_T_OD), *BV = (bf16*)(ws + WS_T_OD + SLOT), *YB = (bf16*)(ws + WS_T_OD + 2 * SLOT);
            k_rwkv_prep<<<M, 256, 0, stream>>>(Z, P, R, LD, KM, V, KK, BV);
            k_rwkv_scan<<<32, 64, 0, stream>>>(R, LD, KM, V, KK, BV, YB);
            k_rwkv_fin<<<M, 256, 0, stream>>>(Z, P, R, KM, V, YB, MIX);
            k_rope<<<M, 256, 0, stream>>>(Z);
            k_dil<<<M * 8 / 4, 256, 0, stream>>>(Z, MIX);
        }
        launch_gemm<0>(stream, grid, MIX, WOUT, Y, nullptr, nullptr, DM, DM, DM);
        k_norm_res<<<M / 4, 256, 0, stream>>>(Y, x, in[3] + (size_t)i * DM, in[4] + (size_t)i * DM, H);
        launch_gemm<2>(stream, grid, H, WUP, HID, nullptr, nullptr, DFF, DM, DFF);
        launch_gemm<0>(stream, grid, HID, WDN, Y, nullptr, nullptr, DM, DFF, DM);
        k_norm_res<<<M / 4, 256, 0, stream>>>(Y, x, in[5] + (size_t)i * DM, in[30] + (size_t)i * DM, H);
        launch_gemm<0>(stream, grid, PB, WPJ, MIX, nullptr, nullptr, DM, PLE, DM);
        launch_gemm<3>(stream, grid, H, WGT, nullptr, MIX, x, DM, DM, DM);
    }
}
```

```cpp
#include <hip/hip_runtime.h>
#include <cstdio>
#include <cstdint>
namespace pg8 {
#define PG8_LAS __attribute__((address_space(3)))
typedef unsigned short bf16_t;
typedef short bf16x8 __attribute__((ext_vector_type(8)));
typedef float f32x4 __attribute__((ext_vector_type(4)));
typedef unsigned u32x4 __attribute__((ext_vector_type(4)));
constexpr int BM = 256, BK = 64, HALF = 128, HTB = HALF * BK * 2  , STAGE_BYTES = 8 * HTB, NXCD = 8, WGM = 8;

__host__ __device__ __forceinline__ int lds_byte(int r, int c) { const int st = (r >> 4) * 2 + (c >> 5), rr = r & 15, cc = c & 31, ob = rr * 64 + cc * 2; return st * 1024 + (ob ^ (((ob >> 9) & 1) << 5)); }
__host__ __device__ __forceinline__ void stage_rc(int b, int& R, int& C) { const int st = b / 1024, sb = b % 1024, swz = sb ^ (((sb >> 9) & 1) << 5); R = (st >> 1) * 16 + swz / 64; C = (st & 1) * 32 + (swz % 64) / 2; }
__host__ __device__ __forceinline__ int perm32(int rho) { const int n = rho >> 4, i = rho & 15; return 8 * (i >> 2) + 4 * n + (i & 3); }

struct Unit { int pm, pn; };
struct Gemm { const bf16_t* A; const bf16_t* Bt; int M, N, K; };

struct StaticOrder {
    int nM, nN, nwg, G, c;
    __host__ __device__ void init(int M, int N, int G_, int c_) { nM = M / BM; nN = N / BM; nwg = nM * nN; G = G_; c = c_; }
    __host__ __device__ bool next(int i, Unit& u) const {
        const long L = (long)i * G + c; if (L >= nwg) return false;
        int wgid = (int)L; { const int q = nwg / NXCD, r = nwg % NXCD, xcd = wgid % NXCD, off = wgid / NXCD; wgid = (xcd < r ? xcd * (q + 1) : r * (q + 1) + (xcd - r) * q) + off; }
        const int nig = WGM * nN, gid = wgid / nig, fm = gid * WGM, gsz = (nM - fm) < WGM ? (nM - fm) : WGM;
        u.pm = fm + ((wgid % nig) % gsz); u.pn = (wgid % nig) / gsz; return true;
    }
    __device__ __forceinline__ void a_ready(const Unit&) const {}
    __device__ __forceinline__ void done(const Unit&) const {}
};

__device__ __forceinline__ unsigned cvt_pk_bf16(float lo, float hi) { unsigned r; asm volatile("v_cvt_pk_bf16_f32 %0, %1, %2" : "=v"(r) : "v"(lo), "v"(hi)); return r; }
__device__ __forceinline__ float bflo(unsigned w) { return __uint_as_float(w << 16); }
__device__ __forceinline__ float bfhi(unsigned w) { return __uint_as_float(w & 0xffff0000u); }
template <int ACT  > struct EpiBf16 {
    static constexpr bool PERM = true, AFTER_DRAIN = false;
    bf16_t* O; int ldc;
    __device__ __forceinline__ void operator()(const f32x4 (&acc)[2][2][4][2], const Unit& u, int wr, int wc, int fr, int fq) const {
        const int row0 = u.pm * BM + wr * 64 + fr; const int col0 = u.pn * BM + wc * 32 + 8 * fq;
#pragma unroll
        for (int ai = 0; ai < 2; ++ai)
#pragma unroll
            for (int m = 0; m < 4; ++m) { bf16_t* rowp = O + (size_t)(row0 + ai * HALF + m * 16) * ldc + col0;
#pragma unroll
                for (int bj = 0; bj < 2; ++bj) { f32x4 v0 = acc[ai][bj][m][0], v1 = acc[ai][bj][m][1];
                    if (ACT == 2) {
#pragma unroll
                        for (int e = 0; e < 4; ++e) { float a = fmaxf(v0[e], 0.f), b = fmaxf(v1[e], 0.f); v0[e] = a * a; v1[e] = b * b; } }
                    u32x4 w; w.x = cvt_pk_bf16(v0[0], v0[1]); w.y = cvt_pk_bf16(v0[2], v0[3]); w.z = cvt_pk_bf16(v1[0], v1[1]); w.w = cvt_pk_bf16(v1[2], v1[3]);
                    *(u32x4*)(rowp + bj * HALF) = w; } }
    }
};
struct EpiGate {
    static constexpr bool PERM = true, AFTER_DRAIN = false;
    const bf16_t* PP; float* X; int ldc;
    __device__ __forceinline__ void operator()(const f32x4 (&acc)[2][2][4][2], const Unit& u, int wr, int wc, int fr, int fq) const {
        const int row0 = u.pm * BM + wr * 64 + fr; const int col0 = u.pn * BM + wc * 32 + 8 * fq;
#pragma unroll
        for (int ai = 0; ai < 2; ++ai)
#pragma unroll
            for (int m = 0; m < 4; ++m) { const size_t ro = (size_t)(row0 + ai * HALF + m * 16) * ldc + col0;
#pragma unroll
                for (int bj = 0; bj < 2; ++bj) { const size_t off = ro + bj * HALF;
                    const u32x4 pw = *(const u32x4*)(PP + off); f32x4 x0 = *(const f32x4*)(X + off), x1 = *(const f32x4*)(X + off + 4);
                    const f32x4 a0 = acc[ai][bj][m][0], a1 = acc[ai][bj][m][1];
                    x0[0] += bflo(pw.x) / (1.f + __expf(-a0[0])); x0[1] += bfhi(pw.x) / (1.f + __expf(-a0[1]));
                    x0[2] += bflo(pw.y) / (1.f + __expf(-a0[2])); x0[3] += bfhi(pw.y) / (1.f + __expf(-a0[3]));
                    x1[0] += bflo(pw.z) / (1.f + __expf(-a1[0])); x1[1] += bfhi(pw.z) / (1.f + __expf(-a1[1]));
                    x1[2] += bflo(pw.w) / (1.f + __expf(-a1[2])); x1[3] += bfhi(pw.w) / (1.f + __expf(-a1[3]));
                    *(f32x4*)(X + off) = x0; *(f32x4*)(X + off + 4) = x1; } }
    }
};

template <class Epi, class Sched, bool ALIGN_EPI = false, bool SP2 = false>
__device__ __forceinline__ void gemm_phase(PG8_LAS unsigned char* lds, const Gemm g, const Sched& S, const Epi& E) {
    const int tid = threadIdx.x, wid = __builtin_amdgcn_readfirstlane(tid >> 6), lane = tid & 63, wr = wid >> 2, wc = wid & 3, fr = lane & 15, fq = lane >> 4;
    const int K = g.K, nt = K / BK;
    unsigned voffA[2], voffB[2];
#pragma unroll
    for (int i = 0; i < 2; ++i) { int R, C; stage_rc(tid * 16 + i * 8192, R, C); const int Rb = Epi::PERM ? ((R & ~31) + perm32(R & 31)) : R;
        voffA[i] = (unsigned)(R * K + C) * 2u; voffB[i] = (unsigned)(Rb * K + C) * 2u; }
    const size_t kstep = (size_t)(BK * 2);
    const size_t hstep = (size_t)HALF * K * 2;
    const size_t tstep = 2 * hstep;
    const unsigned ldsw = (unsigned)wid * 1024u;
    const int aoff = lds_byte(wr * 64 + fr, fq * 8), boff = lds_byte(wc * 32 + fr, fq * 8);
#define PG8_SA(b, h) (((b) * 2 + (h)) * HTB)
#define PG8_SB(b, h) ((4 + (b) * 2 + (h)) * HTB)
#define PG8_STAGE(bufoff, gbase, voff) do { _Pragma("unroll") for (int _i = 0; _i < 2; ++_i) \
        __builtin_amdgcn_global_load_lds((const unsigned*)((const char*)(gbase) + (voff)[_i]), (PG8_LAS unsigned*)(lds + (bufoff) + ldsw + _i * 8192), 16, 0, 0); } while (0)
#define PG8_LDA(dst, b, h) do { _Pragma("unroll") for (int m = 0; m < 4; ++m) _Pragma("unroll") for (int k = 0; k < 2; ++k) dst[m][k] = *(const PG8_LAS bf16x8*)(lds + PG8_SA(b, h) + aoff + m * 2048 + k * 1024); } while (0)
#define PG8_LDB(dst, b, h) do { _Pragma("unroll") for (int n = 0; n < 2; ++n) _Pragma("unroll") for (int k = 0; k < 2; ++k) dst[n][k] = *(const PG8_LAS bf16x8*)(lds + PG8_SB(b, h) + boff + n * 2048 + k * 1024); } while (0)
#define PG8_MMA(ai, bj, At, Bt) do { __builtin_amdgcn_s_setprio(1); _Pragma("unroll") for (int m = 0; m < 4; ++m) _Pragma("unroll") for (int n = 0; n < 2; ++n) _Pragma("unroll") for (int k = 0; k < 2; ++k) \
        acc[ai][bj][m][n] = __builtin_amdgcn_mfma_f32_16x16x32_bf16(Bt[n][k], At[m][k], acc[ai][bj][m][n], 0, 0, 0); __builtin_amdgcn_s_setprio(0); } while (0)
#define PG8_WAIT_V(n) asm volatile("s_waitcnt vmcnt(" #n ")" ::: "memory")
#define PG8_WAIT_L(n) asm volatile("s_waitcnt lgkmcnt(" #n ")" ::: "memory")
#define PG8_BAR __builtin_amdgcn_s_barrier()
#define PG8_SCHED __builtin_amdgcn_sched_barrier(0)
    Unit cur, nxt; int ui = 0;
    if (!S.next(0, cur)) return;
    f32x4 acc[2][2][4][2];
#pragma unroll
    for (int a = 0; a < 2; ++a)
#pragma unroll
        for (int b = 0; b < 2; ++b)
#pragma unroll
            for (int m = 0; m < 4; ++m)
#pragma unroll
                for (int n = 0; n < 2; ++n) acc[a][b][m][n] = (f32x4){0.f, 0.f, 0.f, 0.f};
    bf16x8 At[4][2], B0[2][2], B1[2][2];
    const char* cA = (const char*)g.A + (size_t)cur.pm * tstep; const char* cB = (const char*)g.Bt + (size_t)cur.pn * tstep;
    S.a_ready(cur);
    if constexpr (SP2) {
        PG8_STAGE(PG8_SB(0, 0), cB, voffB); PG8_STAGE(PG8_SB(0, 1), cB + hstep, voffB); PG8_STAGE(PG8_SA(0, 0), cA, voffA); PG8_STAGE(PG8_SA(0, 1), cA + hstep, voffA);
        if (wr == 1) PG8_BAR;
        PG8_WAIT_V(2); PG8_BAR;
        PG8_STAGE(PG8_SB(1, 0), cB + kstep, voffB); PG8_STAGE(PG8_SA(1, 0), cA + kstep, voffA); PG8_STAGE(PG8_SB(1, 1), cB + hstep + kstep, voffB);
        PG8_WAIT_V(6); PG8_BAR;
    } else {
        PG8_STAGE(PG8_SB(0, 0), cB, voffB); PG8_STAGE(PG8_SA(0, 0), cA, voffA); PG8_STAGE(PG8_SB(0, 1), cB + hstep, voffB); PG8_STAGE(PG8_SA(0, 1), cA + hstep, voffA);
        if (wr == 1) PG8_BAR;
        PG8_WAIT_V(4); PG8_BAR;
        PG8_STAGE(PG8_SB(1, 0), cB + kstep, voffB); PG8_STAGE(PG8_SA(1, 0), cA + kstep, voffA); PG8_STAGE(PG8_SB(1, 1), cB + hstep + kstep, voffB);
        PG8_WAIT_V(6); PG8_BAR;
    }
    for (;;) {
        const bool has_next = S.next(ui + 1, nxt);
        const char* nA = has_next ? (const char*)g.A + (size_t)nxt.pm * tstep : cA; const char* nB = has_next ? (const char*)g.Bt + (size_t)nxt.pn * tstep : cB;
        for (int t = 0; t < nt; t += 2) {
            const bool last = (t == nt - 2);
            const char* a1 = cA + (size_t)(t + 1) * kstep;
            const char* a2 = last ? nA : cA + (size_t)(t + 2) * kstep; const char* b2 = last ? nB : cB + (size_t)(t + 2) * kstep;
            const char* a3 = a2 + kstep; const char* b3 = b2 + kstep;
            if (last && has_next) S.a_ready(nxt);
            if constexpr (SP2) {
            PG8_LDB(B0, 0, 0); PG8_LDB(B1, 0, 1); PG8_SCHED; PG8_LDA(At, 0, 0); PG8_STAGE(PG8_SA(1, 1), a1 + hstep, voffA);
            PG8_WAIT_V(8); PG8_WAIT_L(0); PG8_BAR; PG8_MMA(0, 0, At, B0); PG8_MMA(0, 1, At, B1); PG8_BAR; PG8_SCHED;
            PG8_LDA(At, 0, 1); PG8_STAGE(PG8_SB(0, 0), b2, voffB); PG8_STAGE(PG8_SB(0, 1), b2 + hstep, voffB); PG8_STAGE(PG8_SA(0, 0), a2, voffA);
            PG8_WAIT_V(8); PG8_WAIT_L(0); PG8_BAR; PG8_MMA(1, 0, At, B0); PG8_MMA(1, 1, At, B1); PG8_BAR; PG8_SCHED;
            PG8_LDB(B0, 1, 0); PG8_LDB(B1, 1, 1); PG8_SCHED; PG8_LDA(At, 1, 0); PG8_STAGE(PG8_SA(0, 1), a2 + hstep, voffA);
            PG8_WAIT_V(8); PG8_WAIT_L(0); PG8_BAR; PG8_MMA(0, 0, At, B0); PG8_MMA(0, 1, At, B1); PG8_BAR; PG8_SCHED;
            PG8_LDA(At, 1, 1); PG8_STAGE(PG8_SB(1, 0), b3, voffB); PG8_STAGE(PG8_SB(1, 1), b3 + hstep, voffB); PG8_STAGE(PG8_SA(1, 0), a3, voffA);
            PG8_WAIT_V(8); PG8_WAIT_L(0); PG8_BAR; PG8_MMA(1, 0, At, B0); PG8_MMA(1, 1, At, B1); PG8_BAR; PG8_SCHED;
            } else {
            PG8_LDB(B0, 0, 0); PG8_SCHED; PG8_LDA(At, 0, 0); PG8_STAGE(PG8_SA(1, 1), a1 + hstep, voffA);
            PG8_WAIT_L(8); PG8_BAR; PG8_WAIT_L(0); PG8_MMA(0, 0, At, B0); PG8_BAR; PG8_SCHED;
            PG8_LDB(B1, 0, 1); PG8_STAGE(PG8_SB(0, 0), b2, voffB);
            PG8_BAR; PG8_WAIT_L(0); PG8_MMA(0, 1, At, B1); PG8_BAR;
            PG8_LDA(At, 0, 1); PG8_STAGE(PG8_SA(0, 0), a2, voffA);
            PG8_BAR; PG8_WAIT_L(0); PG8_MMA(1, 0, At, B0); PG8_BAR; PG8_SCHED;
            PG8_STAGE(PG8_SB(0, 1), b2 + hstep, voffB);
            PG8_WAIT_V(6); PG8_BAR; PG8_MMA(1, 1, At, B1); PG8_BAR;
            PG8_LDB(B0, 1, 0); PG8_SCHED; PG8_LDA(At, 1, 0); PG8_STAGE(PG8_SA(0, 1), a2 + hstep, voffA);
            PG8_WAIT_L(8); PG8_BAR; PG8_WAIT_L(0); PG8_MMA(0, 0, At, B0); PG8_BAR; PG8_SCHED;
            PG8_LDB(B1, 1, 1); PG8_STAGE(PG8_SB(1, 0), b3, voffB);
            PG8_BAR; PG8_WAIT_L(0); PG8_MMA(0, 1, At, B1); PG8_BAR;
            PG8_LDA(At, 1, 1); PG8_STAGE(PG8_SA(1, 0), a3, voffA);
            PG8_BAR; PG8_WAIT_L(0); PG8_MMA(1, 0, At, B0); PG8_BAR; PG8_SCHED;
            PG8_STAGE(PG8_SB(1, 1), b3 + hstep, voffB);
            PG8_WAIT_V(6); PG8_BAR; PG8_MMA(1, 1, At, B1); PG8_BAR;
            }
        }
        if constexpr (ALIGN_EPI) { if (wr == 0) PG8_BAR; }
        if constexpr (!Epi::AFTER_DRAIN) { E(acc, cur, wr, wc, fr, fq); S.done(cur); }
        if (!has_next) break;
#pragma unroll
        for (int a = 0; a < 2; ++a)
#pragma unroll
            for (int b = 0; b < 2; ++b)
#pragma unroll
                for (int m = 0; m < 4; ++m)
#pragma unroll
                    for (int n = 0; n < 2; ++n) acc[a][b][m][n] = (f32x4){0.f, 0.f, 0.f, 0.f};
        cur = nxt; cA = nA; cB = nB; ++ui;
        if constexpr (ALIGN_EPI) { if (wr == 1) PG8_BAR; }
    }
    PG8_WAIT_V(0);
    if constexpr (!ALIGN_EPI) { if (wr == 0) PG8_BAR; }
    PG8_BAR;
    if constexpr (Epi::AFTER_DRAIN) { E.fused(acc, cur, wr, wc, fr, fq, lds, wid, lane); S.done(cur); }
#undef PG8_SA
#undef PG8_SB
#undef PG8_STAGE
#undef PG8_LDA
#undef PG8_LDB
#undef PG8_MMA
#undef PG8_WAIT_V
#undef PG8_WAIT_L
#undef PG8_BAR
#undef PG8_SCHED
}
}
typedef unsigned short bf16;
typedef float f32x4 __attribute__((ext_vector_type(4)));
typedef unsigned u32x4 __attribute__((ext_vector_type(4)));
typedef unsigned u32x2 __attribute__((ext_vector_type(2)));
constexpr int BATCH = 2, SEQ = 16384, DM = 2048, DEPTH = 4, M = BATCH * SEQ, DFF = 8192, PLE = 256;
constexpr int EV_IN = 5136, EV_INP = 5376, OD_IN = 6432, OD_INP = 6656;
constexpr int EZ_Q = 512, EZ_K = 1280, EZ_V = 2048, EZ_G = 3584, EZ_R = 5120;
constexpr int OZ_HW = 3072, OZ_HA = 3136, OZ_HG = 3200, OZ_DQ = 3360, OZ_DK = 4384, OZ_DV = 5408;
constexpr size_t MiB = 1u << 20;
constexpr size_t WS_CTL = 0, WS_WIN = 1 * MiB, WS_WOUT = 27 * MiB, WS_WUP = 35 * MiB, WS_WDN = 67 * MiB, WS_WGT = 99 * MiB, WS_WPJ = 107 * MiB;
constexpr size_t WS_H = 110 * MiB, WS_Y = 238 * MiB, WS_MIX = 366 * MiB, WS_PB = 494 * MiB, WS_Z = 510 * MiB, WS_HID = 510 * MiB;
constexpr size_t WS_SMALL = 108 * MiB, WS_ML = 1184 * MiB, WS_DEC = 1136 * MiB, WS_T_EV = 846 * MiB, WS_T_OD = 926 * MiB, WS_NEED = 1200 * MiB;
constexpr size_t SLOT = 64 * MiB;

__device__ __forceinline__ unsigned f2bf(float f) { unsigned u = __builtin_bit_cast(unsigned, f); return (u + 0x7fffu + ((u >> 16) & 1u)) >> 16; }
__device__ __forceinline__ unsigned pk2(float lo, float hi) { return f2bf(lo) | (f2bf(hi) << 16); }
__device__ __forceinline__ float bf2f(bf16 h) { return __uint_as_float((unsigned)h << 16); }
__device__ __forceinline__ float bflo_(unsigned w) { return __uint_as_float(w << 16); }
__device__ __forceinline__ float bfhi_(unsigned w) { return __uint_as_float(w & 0xffff0000u); }
__device__ __forceinline__ float wave_sum(float v) {
#pragma unroll
    for (int o = 1; o < 64; o <<= 1) v += __shfl_xor(v, o);
    return v;
}
__device__ __forceinline__ float sigmoidf_(float x) { return 1.f / (1.f + __expf(-x)); }
__device__ __forceinline__ float softplusf_(float x) { return fmaxf(x, 0.f) + log1pf(__expf(-fabsf(x))); }

__global__ void __launch_bounds__(256) k_wt(const float* __restrict__ W, int K, int N, bf16* __restrict__ Wt, int Kpad) {
    __shared__ float tile[64][65];
    const int n0 = blockIdx.x * 64, k0 = blockIdx.y * 64, tid = threadIdx.x, r = tid >> 6, c = tid & 63;
#pragma unroll
    for (int i = 0; i < 16; ++i) { const int kk = r + 4 * i, n = n0 + c; tile[kk][c] = (n < N && k0 + kk < K) ? W[(size_t)(k0 + kk) * N + n] : 0.f; }
    __syncthreads();
#pragma unroll
    for (int j = 0; j < 2; ++j) { const int q = tid + 256 * j, n = q >> 3, kc = q & 7;
        u32x4 o; o.x = pk2(tile[8 * kc + 0][n], tile[8 * kc + 1][n]); o.y = pk2(tile[8 * kc + 2][n], tile[8 * kc + 3][n]);
        o.z = pk2(tile[8 * kc + 4][n], tile[8 * kc + 5][n]); o.w = pk2(tile[8 * kc + 6][n], tile[8 * kc + 7][n]);
        *(u32x4*)(Wt + (size_t)(n0 + n) * Kpad + k0 + 8 * kc) = o; }
}
__global__ void __launch_bounds__(256) k_cvt(const float* __restrict__ s, bf16* __restrict__ d, size_t n4) {
    const size_t i = (size_t)blockIdx.x * 256 + threadIdx.x; if (i >= n4) return;
    const f32x4 v = ((const f32x4*)s)[i]; u32x2 o; o.x = pk2(v[0], v[1]); o.y = pk2(v[2], v[3]); ((u32x2*)d)[i] = o;
}
__global__ void __launch_bounds__(256) k_norm0(const float* __restrict__ xin, float* xout, const float* __restrict__ g, bf16* __restrict__ h) {
    const int row = blockIdx.x * 4 + (threadIdx.x >> 6), lane = threadIdx.x & 63;
    const f32x4* xr = (const f32x4*)(xin + (size_t)row * DM) + lane;
    f32x4 v[8]; float s = 0.f;
#pragma unroll
    for (int j = 0; j < 8; ++j) { v[j] = xr[64 * j]; s += (v[j][0] * v[j][0] + v[j][1] * v[j][1]) + (v[j][2] * v[j][2] + v[j][3] * v[j][3]); }
    s = wave_sum(s); const float rstd = 1.0f / sqrtf(s * (1.0f / DM) + 1e-6f);
    if (xout) { f32x4* xo = (f32x4*)(xout + (size_t)row * DM) + lane;
#pragma unroll
        for (int j = 0; j < 8; ++j) xo[64 * j] = v[j]; }
    u32x2* ho = (u32x2*)(h + (size_t)row * DM) + lane;
#pragma unroll
    for (int j = 0; j < 8; ++j) { const f32x4 gg = ((const f32x4*)g)[lane + 64 * j]; u32x2 o; o.x = pk2(v[j][0] * rstd * gg[0], v[j][1] * rstd * gg[1]); o.y = pk2(v[j][2] * rstd * gg[2], v[j][3] * rstd * gg[3]); ho[64 * j] = o; }
}
__global__ void __launch_bounds__(256) k_norm_res(const bf16* __restrict__ y, float* x, const float* __restrict__ g1, const float* __restrict__ g2, bf16* __restrict__ h) {
    const int row = blockIdx.x * 4 + (threadIdx.x >> 6), lane = threadIdx.x & 63;
    const u32x2* yr = (const u32x2*)(y + (size_t)row * DM) + lane;
    f32x4* xr = (f32x4*)(x + (size_t)row * DM) + lane;
    f32x4 yv[8], xv[8]; float s = 0.f;
#pragma unroll
    for (int j = 0; j < 8; ++j) { const u32x2 w = yr[64 * j]; yv[j][0] = __uint_as_float(w.x << 16); yv[j][1] = __uint_as_float(w.x & 0xffff0000u); yv[j][2] = __uint_as_float(w.y << 16); yv[j][3] = __uint_as_float(w.y & 0xffff0000u);
        xv[j] = xr[64 * j]; s += (yv[j][0] * yv[j][0] + yv[j][1] * yv[j][1]) + (yv[j][2] * yv[j][2] + yv[j][3] * yv[j][3]); }
    s = wave_sum(s); const float rstd = 1.0f / sqrtf(s * (1.0f / DM) + 1e-6f);
    float s2 = 0.f;
#pragma unroll
    for (int j = 0; j < 8; ++j) { const f32x4 gg = ((const f32x4*)g1)[lane + 64 * j]; xv[j] = xv[j] + yv[j] * rstd * gg; xr[64 * j] = xv[j];
        s2 += (xv[j][0] * xv[j][0] + xv[j][1] * xv[j][1]) + (xv[j][2] * xv[j][2] + xv[j][3] * xv[j][3]); }
    s2 = wave_sum(s2); const float rstd2 = 1.0f / sqrtf(s2 * (1.0f / DM) + 1e-6f);
    u32x2* ho = (u32x2*)(h + (size_t)row * DM) + lane;
#pragma unroll
    for (int j = 0; j < 8; ++j) { const f32x4 gg = ((const f32x4*)g2)[lane + 64 * j]; u32x2 o; o.x = pk2(xv[j][0] * rstd2 * gg[0], xv[j][1] * rstd2 * gg[1]); o.y = pk2(xv[j][2] * rstd2 * gg[2], xv[j][3] * rstd2 * gg[3]); ho[64 * j] = o; }
}
struct GArgs { const bf16* A; const bf16* Bt; bf16* O; const bf16* PP; float* X; int Mr, N, K, ldc; };
template <int MODE> __global__ void __launch_bounds__(512, 2) k_gemm(GArgs a) {
    extern __shared__ __attribute__((aligned(16))) unsigned char lds[];
    pg8::Gemm g; g.A = a.A; g.Bt = a.Bt; g.M = a.Mr; g.N = a.N; g.K = a.K;
    pg8::StaticOrder S; S.init(a.Mr, a.N, (int)gridDim.x, (int)blockIdx.x);
    if constexpr (MODE == 0) { pg8::EpiBf16<0> E{a.O, a.ldc}; pg8::gemm_phase<pg8::EpiBf16<0>, pg8::StaticOrder, true, true>((PG8_LAS unsigned char*)lds, g, S, E); }
    else if constexpr (MODE == 2) { pg8::EpiBf16<2> E{a.O, a.ldc}; pg8::gemm_phase<pg8::EpiBf16<2>, pg8::StaticOrder, true, true>((PG8_LAS unsigned char*)lds, g, S, E); }
    else { pg8::EpiGate E{a.PP, a.X, a.ldc}; pg8::gemm_phase<pg8::EpiGate, pg8::StaticOrder, true, true>((PG8_LAS unsigned char*)lds, g, S, E); }
}
__global__ void __launch_bounds__(512) k_pool(const bf16* __restrict__ z, const float* __restrict__ pw, const float* __restrict__ ps, bf16* __restrict__ mix) {
    __shared__ float pooled[512];
    const int m = blockIdx.x, t = m % SEQ, c = threadIdx.x, g = c >> 7, w = 2 << g;
    const int cnt = (t + 1 < w) ? (t + 1) : w;
    float sum = 0.f;
    for (int j = 0; j < cnt; ++j) sum += bf2f(z[(size_t)(m - j) * EV_INP + c]);
    pooled[c] = sum / (float)cnt - bf2f(z[(size_t)m * EV_INP + c]);
    __syncthreads();
    const int d = c & 127; float acc = 0.f;
    const float* wg = pw + (size_t)g * 128 * 128;
    for (int cc = 0; cc < 128; ++cc) acc += pooled[g * 128 + cc] * wg[cc * 128 + d];
    mix[(size_t)m * DM + c] = (bf16)f2bf(acc * ps[c]);
}
__global__ void __launch_bounds__(256) k_gla_gate(const bf16* __restrict__ z, const float* __restrict__ w2, const float* __restrict__ gb, float* __restrict__ GK) {
    __shared__ float glr[16];
    const int m = blockIdx.x, tid = threadIdx.x;
    if (tid < 16) glr[tid] = bf2f(z[(size_t)m * EV_INP + EZ_R + tid]);
    __syncthreads();
#pragma unroll
    for (int i = 0; i < 3; ++i) { const int j = tid + 256 * i; float x = gb[j];
#pragma unroll
        for (int r = 0; r < 16; ++r) x += glr[r] * w2[r * 768 + j];
        GK[(size_t)m * 768 + j] = -softplusf_(-x) * (1.0f / 16.0f); }
}
__global__ void __launch_bounds__(64) k_gla_rec(const bf16* __restrict__ z, const float* __restrict__ GK, float* __restrict__ ORAW) {
    constexpr int TB = 16;
    __shared__ f32x4 qs[TB][48], ks[TB][48], es[TB][48];
    const int bh = blockIdx.x / 6, eb = blockIdx.x % 6, b = bh >> 2, h = bh & 3, lane = threadIdx.x, e = eb * 64 + lane;
    const float scale = 0.07216878364870323f;
    float S[192];
#pragma unroll
    for (int d = 0; d < 192; ++d) S[d] = 0.f;
    for (int t0 = 0; t0 < SEQ; t0 += TB) {
        const size_t m0 = (size_t)b * SEQ + t0;
        float vv[TB];
#pragma unroll
        for (int s = 0; s < TB; ++s) vv[s] = bf2f(z[(m0 + s) * EV_INP + EZ_V + h * 384 + e]);
        __syncthreads();
        for (int i = lane; i < TB * 192; i += 64) { const int s = i / 192, d = i % 192; const size_t m = m0 + s;
            ((float*)qs)[s * 192 + d] = bf2f(z[m * EV_INP + EZ_Q + h * 192 + d]) * scale;
            ((float*)ks)[s * 192 + d] = bf2f(z[m * EV_INP + EZ_K + h * 192 + d]);
            ((float*)es)[s * 192 + d] = __expf(GK[m * 768 + h * 192 + d]); }
        __syncthreads();
        for (int s = 0; s < TB; ++s) {
            float o = 0.f; const float v = vv[s];
#pragma unroll
            for (int d4 = 0; d4 < 48; ++d4) { const f32x4 q4 = qs[s][d4], k4 = ks[s][d4], e4 = es[s][d4];
#pragma unroll
                for (int c = 0; c < 4; ++c) { S[4 * d4 + c] = S[4 * d4 + c] * e4[c] + k4[c] * v; o += q4[c] * S[4 * d4 + c]; } }
            ORAW[(m0 + s) * 1536 + h * 384 + e] = o;
        }
    }
}
__global__ void __launch_bounds__(256) k_gla_fin(const float* __restrict__ ORAW, const bf16* __restrict__ z, const float* __restrict__ gn, bf16* __restrict__ mix) {
    const int m = blockIdx.x, h = threadIdx.x >> 6, lane = threadIdx.x & 63;
    float o[6]; float ss = 0.f;
#pragma unroll
    for (int i = 0; i < 6; ++i) { o[i] = ORAW[(size_t)m * 1536 + h * 384 + lane + 64 * i]; ss += o[i] * o[i]; }
    ss = wave_sum(ss); const float rstd = 1.0f / sqrtf(ss * (1.0f / 384.0f) + 1e-6f);
#pragma unroll
    for (int i = 0; i < 6; ++i) { const int e = lane + 64 * i; const float go = bf2f(z[(size_t)m * EV_INP + EZ_G + h * 384 + e]);
        const float r = o[i] * rstd * gn[e] * (go * sigmoidf_(go)); mix[(size_t)m * DM + 512 + h * 384 + e] = (bf16)f2bf(r); }
}
struct RwkvP { const float *mu, *w0, *w2, *a0, *a2, *g2, *kk, *ka, *rk, *lnw, *lnb; };
__device__ __forceinline__ float tshift(const bf16* __restrict__ z, int m, int t, int col, const float* __restrict__ mu) {
    const float hc = bf2f(z[(size_t)m * OD_INP + col]); const float pv = (t > 0) ? bf2f(z[(size_t)(m - 1) * OD_INP + col]) : 0.f;
    return hc + (pv - hc) * mu[col];
}
__global__ void __launch_bounds__(256) k_rwkv_prep(const bf16* __restrict__ z, RwkvP P, bf16* R, bf16* LD, bf16* KM, bf16* V, bf16* KK, bf16* BV) {
    __shared__ float sm[128];
    const int m = blockIdx.x, t = m % SEQ, tid = threadIdx.x;
    if (tid < 128) { const float v = tshift(z, m, t, OZ_HW + tid, P.mu); sm[tid] = (tid < 64) ? tanhf(v) : v; }
    __syncthreads();
#pragma unroll
    for (int i = 0; i < 4; ++i) { const int c = tid + 256 * i;
        const float r = tshift(z, m, t, c, P.mu), k = tshift(z, m, t, 1024 + c, P.mu), v = tshift(z, m, t, 2048 + c, P.mu);
        float dw = P.w0[c], ap = P.a0[c];
        for (int j = 0; j < 64; ++j) { dw += sm[j] * P.w2[j * 1024 + c]; ap += sm[64 + j] * P.a2[j * 1024 + c]; }
        const float a = sigmoidf_(ap);
        const float wlog = -softplusf_(-dw) - 0.5f; const float ld = -__expf(wlog);
        const float kk = k * P.kk[c]; const float ss = wave_sum(kk * kk); const float kkn = kk / fmaxf(sqrtf(ss), 1e-12f);
        const float km = k * (1.f + (a - 1.f) * P.ka[c]);
        const size_t o = (size_t)m * 1024 + c;
        R[o] = (bf16)f2bf(r); LD[o] = (bf16)f2bf(ld); KM[o] = (bf16)f2bf(km); V[o] = (bf16)f2bf(v); KK[o] = (bf16)f2bf(kkn); BV[o] = (bf16)f2bf(kkn * a); }
}
__global__ void __launch_bounds__(64) k_rwkv_scan(const bf16* __restrict__ R, const bf16* __restrict__ LD, const bf16* __restrict__ KM, const bf16* __restrict__ V, const bf16* __restrict__ KK, const bf16* __restrict__ BV, bf16* __restrict__ Y) {
    constexpr int TB = 8;
    __shared__ f32x4 sh[TB][5][16];
    const int b = blockIdx.x >> 4, h = blockIdx.x & 15, lane = threadIdx.x;
    float S[64];
#pragma unroll
    for (int k = 0; k < 64; ++k) S[k] = 0.f;
    for (int t0 = 0; t0 < SEQ; t0 += TB) {
        float vv[TB];
        __syncthreads();
#pragma unroll
        for (int s = 0; s < TB; ++s) { const size_t o = ((size_t)b * SEQ + t0 + s) * 1024 + h * 64 + lane;
            ((float*)sh[s][0])[lane] = bf2f(R[o]); ((float*)sh[s][1])[lane] = __expf(bf2f(LD[o])); ((float*)sh[s][2])[lane] = bf2f(KM[o]);
            ((float*)sh[s][3])[lane] = bf2f(KK[o]); ((float*)sh[s][4])[lane] = bf2f(BV[o]); vv[s] = bf2f(V[o]); }
        __syncthreads();
        for (int s = 0; s < TB; ++s) {
            float sa = 0.f;
#pragma unroll
            for (int k4 = 0; k4 < 16; ++k4) { const f32x4 a4 = sh[s][3][k4];
#pragma unroll
                for (int c = 0; c < 4; ++c) sa -= S[4 * k4 + c] * a4[c]; }
            const float v = vv[s]; float y = 0.f;
#pragma unroll
            for (int k4 = 0; k4 < 16; ++k4) { const f32x4 w4 = sh[s][1][k4], b4 = sh[s][4][k4], m4 = sh[s][2][k4], r4 = sh[s][0][k4];
#pragma unroll
                for (int c = 0; c < 4; ++c) { const float ns = S[4 * k4 + c] * w4[c] + sa * b4[c] + v * m4[c]; S[4 * k4 + c] = ns; y += ns * r4[c]; } }
            Y[((size_t)b * SEQ + t0 + s) * 1024 + h * 64 + lane] = (bf16)f2bf(y);
        }
    }
}
__global__ void __launch_bounds__(256) k_rwkv_fin(const bf16* __restrict__ z, RwkvP P, const bf16* __restrict__ R, const bf16* __restrict__ KM, const bf16* __restrict__ V, const bf16* __restrict__ Y, bf16* __restrict__ mix) {
    __shared__ float sm[160];
    const int m = blockIdx.x, t = m % SEQ, tid = threadIdx.x;
    if (tid < 160) sm[tid] = sigmoidf_(tshift(z, m, t, OZ_HG + tid, P.mu));
    __syncthreads();
#pragma unroll
    for (int i = 0; i < 4; ++i) { const int c = tid + 256 * i; const size_t o = (size_t)m * 1024 + c;
        float g = 0.f;
        for (int j = 0; j < 160; ++j) g += sm[j] * P.g2[j * 1024 + c];
        const float y = bf2f(Y[o]); const float mean = wave_sum(y) * (1.0f / 64.0f); const float dy = y - mean; const float var = wave_sum(dy * dy) * (1.0f / 64.0f);
        const float yn = dy * (1.0f / sqrtf(var + 64e-5f)) * P.lnw[c] + P.lnb[c];
        const float r = bf2f(R[o]), km = bf2f(KM[o]), v = bf2f(V[o]);
        const float bon = wave_sum(r * km * P.rk[c]) * v;
        mix[(size_t)m * DM + c] = (bf16)f2bf((yn + bon) * g); }
}
__global__ void __launch_bounds__(256) k_rope(bf16* z) {
    const int m = blockIdx.x, t = m % SEQ, tid = threadIdx.x;
#pragma unroll
    for (int i = 0; i < 4; ++i) { const int idx = tid + 256 * i, qk = idx >> 9, h = (idx >> 6) & 7, j = idx & 63;
        const float inv = powf(10000.0f, -(float)j * (1.0f / 64.0f)); const float ang = (float)t * inv;
        const double rev = (double)ang * 0.15915494309189535; const float fr = (float)(rev - rint(rev));
        const float sn = __builtin_amdgcn_sinf(fr), cs = __builtin_amdgcn_cosf(fr);
        bf16* p = z + (size_t)m * OD_INP + (qk ? OZ_DK : OZ_DQ) + h * 128 + j;
        const float x1 = bf2f(p[0]), x2 = bf2f(p[64]);
        p[0] = (bf16)f2bf(x1 * cs - x2 * sn); p[64] = (bf16)f2bf(x2 * cs + x1 * sn); }
}
__global__ void __launch_bounds__(256) k_dil(const bf16* __restrict__ z, bf16* __restrict__ mix) {
    const int gw = blockIdx.x * 4 + (threadIdx.x >> 6), lane = threadIdx.x & 63;
    const int m = gw >> 3, h = gw & 7, t = m % SEQ;
    const float scale = 0.08838834764831845f;
    const bf16* qp = z + (size_t)m * OD_INP + OZ_DQ + h * 128;
    const float q0 = bf2f(qp[lane]) * scale, q1 = bf2f(qp[lane + 64]) * scale;
    float mr = -INFINITY, l = 0.f, a0 = 0.f, a1 = 0.f;
    for (int br = 0; br < 3; ++br) { const int dil = (br == 0) ? 1 : (br == 1 ? 4 : 16);
        for (int j = 0; j <= 128; ++j) { const int tk = t - j * dil; if (tk < 0) break;
            const size_t mk = (size_t)(m - j * dil) * OD_INP;
            const bf16* kp = z + mk + OZ_DK + h * 128; const bf16* vp = z + mk + OZ_DV + h * 128;
            const float s = wave_sum(q0 * bf2f(kp[lane]) + q1 * bf2f(kp[lane + 64]));
            const float mn = fmaxf(mr, s); const float corr = __expf(mr - mn), p = __expf(s - mn);
            l = l * corr + p; a0 = a0 * corr + p * bf2f(vp[lane]); a1 = a1 * corr + p * bf2f(vp[lane + 64]); mr = mn; } }
    const float il = 1.0f / l;
    bf16* op = mix + (size_t)m * DM + 1024 + h * 128;
    op[lane] = (bf16)f2bf(a0 * il); op[lane + 64] = (bf16)f2bf(a1 * il);
}
#define LAS __attribute__((address_space(3)))
typedef LAS unsigned char lds_t;
typedef short bf16x8 __attribute__((ext_vector_type(8)));
typedef short s16x4 __attribute__((ext_vector_type(4)));
typedef short v4i16_t __attribute__((ext_vector_type(4)));
__device__ __forceinline__ s16x4 vtr(const lds_t* p) { return __builtin_bit_cast(s16x4, __builtin_amdgcn_ds_read_tr16_b64_v4i16((LAS v4i16_t*)p)); }
__device__ __forceinline__ bf16x8 cat8(s16x4 a, s16x4 b) { bf16x8 r; r[0] = a[0]; r[1] = a[1]; r[2] = a[2]; r[3] = a[3]; r[4] = b[0]; r[5] = b[1]; r[6] = b[2]; r[7] = b[3]; return r; }
__device__ __forceinline__ f32x4 mfma16(bf16x8 a, bf16x8 b, f32x4 c) { return __builtin_amdgcn_mfma_f32_16x16x32_bf16(a, b, c, 0, 0, 0); }
__device__ __forceinline__ u32x2 pack4(f32x4 v) { u32x2 o; o.x = pk2(v[0], v[1]); o.y = pk2(v[2], v[3]); return o; }
__device__ __forceinline__ f32x4 unpack4(u32x2 w) { f32x4 v; v[0] = __uint_as_float(w.x << 16); v[1] = __uint_as_float(w.x & 0xffff0000u); v[2] = __uint_as_float(w.y << 16); v[3] = __uint_as_float(w.y & 0xffff0000u); return v; }
constexpr int NCHUNK = SEQ / 64;
constexpr int GLA_UNITS = BATCH * 4 * NCHUNK;

__device__ __forceinline__ void ph_pool(lds_t* lds, int vcu, int G, const bf16* __restrict__ Z, const float* __restrict__ pw, const float* __restrict__ ps, bf16* __restrict__ MIX) {
    const int tid = threadIdx.x, wid = tid >> 6, lane = tid & 63, fr = lane & 15, fq = lane >> 4;
    constexpr int WST = 136;
    for (int u = vcu; u < M / 128; u += G) {
        const int m = u * 128 + wid * 16 + fr, t = m % SEQ;
        for (int g = 0; g < 4; ++g) {
            __syncthreads();
            for (int i = 0; i < 32; ++i) { const int idx = tid + 512 * i, c = idx >> 7, d = idx & 127; ((LAS bf16*)lds)[d * WST + c] = (bf16)f2bf(pw[(size_t)g * 16384 + idx]); }
            __syncthreads();
            const int w = 2 << g, cnt = (t + 1 < w) ? (t + 1) : w; const float icnt = 1.0f / (float)cnt;
            f32x4 acc[8];
#pragma unroll
            for (int dt = 0; dt < 8; ++dt) acc[dt] = (f32x4){0.f, 0.f, 0.f, 0.f};
#pragma unroll
            for (int ks = 0; ks < 4; ++ks) {
                const bf16* zp = Z + (size_t)m * EV_INP + g * 128 + 32 * ks + 8 * fq;
                float s[8], own[8];
                { const u32x4 r = *(const u32x4*)zp; own[0] = bflo_(r.x); own[1] = bfhi_(r.x); own[2] = bflo_(r.y); own[3] = bfhi_(r.y); own[4] = bflo_(r.z); own[5] = bfhi_(r.z); own[6] = bflo_(r.w); own[7] = bfhi_(r.w); }
#pragma unroll
                for (int e = 0; e < 8; ++e) s[e] = own[e];
                for (int j = 1; j < cnt; ++j) { const u32x4 r = *(const u32x4*)(zp - (size_t)j * EV_INP);
                    s[0] += bflo_(r.x); s[1] += bfhi_(r.x); s[2] += bflo_(r.y); s[3] += bfhi_(r.y); s[4] += bflo_(r.z); s[5] += bfhi_(r.z); s[6] += bflo_(r.w); s[7] += bfhi_(r.w); }
                u32x4 pk; pk.x = pk2(s[0] * icnt - own[0], s[1] * icnt - own[1]); pk.y = pk2(s[2] * icnt - own[2], s[3] * icnt - own[3]);
                pk.z = pk2(s[4] * icnt - own[4], s[5] * icnt - own[5]); pk.w = pk2(s[6] * icnt - own[6], s[7] * icnt - own[7]);
                const bf16x8 bfrag = __builtin_bit_cast(bf16x8, pk);
#pragma unroll
                for (int dt = 0; dt < 8; ++dt) { const bf16x8 afrag = *(const LAS bf16x8*)(lds + ((16 * dt + fr) * WST + 32 * ks + 8 * fq) * 2); acc[dt] = mfma16(afrag, bfrag, acc[dt]); }
            }
#pragma unroll
            for (int dt = 0; dt < 8; ++dt) { const int d = 16 * dt + 4 * fq; const f32x4 sc = *(const f32x4*)(ps + g * 128 + d);
                *(u32x2*)(MIX + (size_t)m * DM + g * 128 + d) = pack4(acc[dt] * sc); }
        }
    }
}
constexpr int G1_QT = 0, G1_KT = 25600, G1_KH = 51200, G1_VT = 76800, G1_SCR = 126976, G1_LDS = 145664;
constexpr int G1_W2 = G1_SCR, G1_BIAS = G1_SCR + 12288, G1_GLR = G1_BIAS + 768, G1_TOT = G1_GLR + 4096, G1_AT = G1_SCR;
constexpr int QST = 400, VST = 784, AST = 144;
__device__ __forceinline__ void ph_gla1(lds_t* lds, int vcu, int G, bf16* Z, const float* __restrict__ w2, const float* __restrict__ gb, bf16* __restrict__ MIX, bf16* __restrict__ ST, float* __restrict__ DEC) {
    const int tid = threadIdx.x, wid = tid >> 6, lane = tid & 63, fr = lane & 15, fq = lane >> 4, lq = fr >> 2, lp = fr & 3;
    const float scale = 0.07216878364870323f;
    for (int u = vcu; u < GLA_UNITS; u += G) {
        const int b = u / (4 * NCHUNK), h = (u / NCHUNK) & 3, n = u % NCHUNK; const size_t m0 = (size_t)b * SEQ + (size_t)n * 64;
        __syncthreads();
#pragma unroll
        for (int i = 0; i < 6; ++i) { const int q = tid + 512 * i, row = q / 48, cc = q % 48;
            *(LAS u32x4*)(lds + G1_VT + row * VST + cc * 16) = *(const u32x4*)(Z + (m0 + row) * EV_INP + EZ_V + h * 384 + cc * 8); }
#pragma unroll
        for (int i = 0; i < 6; ++i) { const int q = tid + 512 * i, r = q / 192, d = q % 192; ((LAS float*)(lds + G1_W2))[q] = w2[r * 768 + h * 192 + d]; }
        if (tid < 192) ((LAS float*)(lds + G1_BIAS))[tid] = gb[h * 192 + tid];
#pragma unroll
        for (int i = 0; i < 2; ++i) { const int q = tid + 512 * i, row = q >> 4, r = q & 15; ((LAS float*)(lds + G1_GLR))[q] = bf2f(Z[(m0 + row) * EV_INP + EZ_R + r]); }
        __syncthreads();
        const int d = tid % 192, seg = tid / 192;
        float wc[16]; float b0 = 0.f;
        if (tid < 384) {
#pragma unroll
            for (int r = 0; r < 16; ++r) wc[r] = ((LAS float*)(lds + G1_W2))[r * 192 + d];
            b0 = ((LAS float*)(lds + G1_BIAS))[d];
            float run = 0.f;
#pragma unroll 4
            for (int s = 0; s < 32; ++s) { const LAS f32x4* gp = (const LAS f32x4*)(lds + G1_GLR + (seg * 32 + s) * 64); float x = b0;
#pragma unroll
                for (int r4 = 0; r4 < 4; ++r4) { const f32x4 g4 = gp[r4]; x += g4[0] * wc[4 * r4] + g4[1] * wc[4 * r4 + 1] + g4[2] * wc[4 * r4 + 2] + g4[3] * wc[4 * r4 + 3]; }
                run += -softplusf_(-x) * (1.0f / 16.0f); }
            ((LAS float*)(lds + G1_TOT))[seg * 192 + d] = run;
        }
        __syncthreads();
        if (tid < 384) {
            const float t0 = ((LAS float*)(lds + G1_TOT))[d], t1 = ((LAS float*)(lds + G1_TOT))[192 + d];
            const float blast = t0 + t1; float run = seg ? t0 : 0.f;
            if (seg == 0) DEC[(size_t)u * 192 + d] = __expf(blast);
#pragma unroll 4
            for (int s = 0; s < 32; ++s) { const int t = seg * 32 + s;
                const LAS f32x4* gp = (const LAS f32x4*)(lds + G1_GLR + t * 64); float x = b0;
#pragma unroll
                for (int r4 = 0; r4 < 4; ++r4) { const f32x4 g4 = gp[r4]; x += g4[0] * wc[4 * r4] + g4[1] * wc[4 * r4 + 1] + g4[2] * wc[4 * r4 + 2] + g4[3] * wc[4 * r4 + 3]; }
                run += -softplusf_(-x) * (1.0f / 16.0f); const float bb = run;
                const float qv = bf2f(Z[(m0 + t) * EV_INP + EZ_Q + h * 192 + d]), kv = bf2f(Z[(m0 + t) * EV_INP + EZ_K + h * 192 + d]);
                *(LAS bf16*)(lds + G1_QT + t * QST + d * 2) = (bf16)f2bf(qv * scale * __expf(bb));
                *(LAS bf16*)(lds + G1_KT + t * QST + d * 2) = (bf16)f2bf(kv * __expf(-bb));
                *(LAS bf16*)(lds + G1_KH + t * QST + d * 2) = (bf16)f2bf(kv * __expf(blast - bb)); }
        }
        __syncthreads();
        { const int it = wid >> 1;
#pragma unroll
            for (int jj = 0; jj < 2; ++jj) { const int jt = 2 * (wid & 1) + jj; f32x4 acc = (f32x4){0.f, 0.f, 0.f, 0.f};
                if (jt <= it) {
#pragma unroll
                    for (int ks = 0; ks < 6; ++ks) { const bf16x8 a = *(const LAS bf16x8*)(lds + G1_QT + (16 * it + fr) * QST + (32 * ks + 8 * fq) * 2);
                        const bf16x8 bb = *(const LAS bf16x8*)(lds + G1_KT + (16 * jt + fr) * QST + (32 * ks + 8 * fq) * 2); acc = mfma16(a, bb, acc); } }
#pragma unroll
                for (int r = 0; r < 4; ++r) { const int i = 16 * it + 4 * fq + r, j = 16 * jt + fr; const float v = (j <= i) ? acc[r] : 0.f;
                    *(LAS bf16*)(lds + G1_AT + i * AST + j * 2) = (bf16)f2bf(v); } } }
        __syncthreads();
        bf16x8 vf[3][2];
#pragma unroll
        for (int el = 0; el < 3; ++el)
#pragma unroll
            for (int ks = 0; ks < 2; ++ks) { const lds_t* p = lds + G1_VT + (32 * ks + 8 * fq + lq) * VST + (16 * (3 * wid + el) + 4 * lp) * 2; vf[el][ks] = cat8(vtr(p), vtr(p + 4 * VST)); }
        { f32x4 acc[3][4];
#pragma unroll
            for (int el = 0; el < 3; ++el)
#pragma unroll
                for (int it = 0; it < 4; ++it) acc[el][it] = (f32x4){0.f, 0.f, 0.f, 0.f};
#pragma unroll
            for (int ks = 0; ks < 2; ++ks)
#pragma unroll
                for (int it = 0; it < 4; ++it) { const bf16x8 bb = *(const LAS bf16x8*)(lds + G1_AT + (16 * it + fr) * AST + (32 * ks + 8 * fq) * 2);
#pragma unroll
                    for (int el = 0; el < 3; ++el) acc[el][it] = mfma16(vf[el][ks], bb, acc[el][it]); }
#pragma unroll
            for (int el = 0; el < 3; ++el)
#pragma unroll
                for (int it = 0; it < 4; ++it) *(u32x2*)(MIX + (m0 + 16 * it + fr) * DM + 512 + h * 384 + 16 * (3 * wid + el) + 4 * fq) = pack4(acc[el][it]); }
#pragma unroll
        for (int half = 0; half < 2; ++half) { f32x4 acc[6][3];
#pragma unroll
            for (int dl = 0; dl < 6; ++dl)
#pragma unroll
                for (int el = 0; el < 3; ++el) acc[dl][el] = (f32x4){0.f, 0.f, 0.f, 0.f};
#pragma unroll
            for (int ks = 0; ks < 2; ++ks)
#pragma unroll
                for (int dl = 0; dl < 6; ++dl) { const lds_t* p = lds + G1_KH + (32 * ks + 8 * fq + lq) * QST + (16 * (6 * half + dl) + 4 * lp) * 2; const bf16x8 a = cat8(vtr(p), vtr(p + 4 * QST));
#pragma unroll
                    for (int el = 0; el < 3; ++el) acc[dl][el] = mfma16(a, vf[el][ks], acc[dl][el]); }
#pragma unroll
            for (int dl = 0; dl < 6; ++dl)
#pragma unroll
                for (int el = 0; el < 3; ++el) *(u32x2*)(ST + ((size_t)u * 384 + 16 * (3 * wid + el) + fr) * 192 + 16 * (6 * half + dl) + 4 * fq) = pack4(acc[dl][el]); }
#pragma unroll
        for (int i = 0; i < 3; ++i) { const int q = tid + 512 * i, row = q / 24, cc = q % 24;
            *(u32x4*)(Z + (m0 + row) * EV_INP + EZ_Q + h * 192 + cc * 8) = *(const LAS u32x4*)(lds + G1_QT + row * QST + cc * 16); }
    }
}
__device__ __forceinline__ void ph_gla2(int vcu, int G, bf16* ST, const float* __restrict__ DEC) {
    const int g = vcu * 512 + threadIdx.x;
    if (g >= 8 * 384 * 24) return;
    const int bh = g / 9216, rem = g % 9216, e = rem / 24, d8 = rem % 24;
    float S[8];
#pragma unroll
    for (int i = 0; i < 8; ++i) S[i] = 0.f;
    for (int n0 = 0; n0 < NCHUNK; n0 += 4) {
        u32x4 zin[4]; f32x4 dc[4][2];
#pragma unroll
        for (int k = 0; k < 4; ++k) { const size_t un = (size_t)bh * NCHUNK + n0 + k; zin[k] = *(const u32x4*)(ST + (un * 384 + e) * 192 + 8 * d8);
            dc[k][0] = *(const f32x4*)(DEC + un * 192 + 8 * d8); dc[k][1] = *(const f32x4*)(DEC + un * 192 + 8 * d8 + 4); }
#pragma unroll
        for (int k = 0; k < 4; ++k) { const size_t un = (size_t)bh * NCHUNK + n0 + k;
            u32x4 o; o.x = pk2(S[0], S[1]); o.y = pk2(S[2], S[3]); o.z = pk2(S[4], S[5]); o.w = pk2(S[6], S[7]);
            *(u32x4*)(ST + (un * 384 + e) * 192 + 8 * d8) = o;
            S[0] = S[0] * dc[k][0][0] + bflo_(zin[k].x); S[1] = S[1] * dc[k][0][1] + bfhi_(zin[k].x); S[2] = S[2] * dc[k][0][2] + bflo_(zin[k].y); S[3] = S[3] * dc[k][0][3] + bfhi_(zin[k].y);
            S[4] = S[4] * dc[k][1][0] + bflo_(zin[k].z); S[5] = S[5] * dc[k][1][1] + bfhi_(zin[k].z); S[6] = S[6] * dc[k][1][2] + bflo_(zin[k].w); S[7] = S[7] * dc[k][1][3] + bfhi_(zin[k].w); }
    }
}
__device__ __forceinline__ void ph_gla3(lds_t* lds, int vcu, int G, const bf16* __restrict__ Z, const bf16* __restrict__ ST, const float* __restrict__ gn, bf16* MIX) {
    const int tid = threadIdx.x, wid = tid >> 6, lane = tid & 63, fr = lane & 15, fq = lane >> 4;
    LAS float* red = (LAS float*)lds;
    for (int u = vcu; u < GLA_UNITS; u += G) {
        const int b = u / (4 * NCHUNK), h = (u / NCHUNK) & 3, n = u % NCHUNK; const size_t m0 = (size_t)b * SEQ + (size_t)n * 64;
        f32x4 acc[3][4];
#pragma unroll
        for (int el = 0; el < 3; ++el)
#pragma unroll
            for (int it = 0; it < 4; ++it) acc[el][it] = unpack4(*(const u32x2*)(MIX + (m0 + 16 * it + fr) * DM + 512 + h * 384 + 16 * (3 * wid + el) + 4 * fq));
#pragma unroll
        for (int ks = 0; ks < 6; ++ks) { bf16x8 a[3], bb[4];
#pragma unroll
            for (int el = 0; el < 3; ++el) a[el] = *(const bf16x8*)(ST + ((size_t)u * 384 + 16 * (3 * wid + el) + fr) * 192 + 32 * ks + 8 * fq);
#pragma unroll
            for (int it = 0; it < 4; ++it) bb[it] = *(const bf16x8*)(Z + (m0 + 16 * it + fr) * EV_INP + EZ_Q + h * 192 + 32 * ks + 8 * fq);
#pragma unroll
            for (int el = 0; el < 3; ++el)
#pragma unroll
                for (int it = 0; it < 4; ++it) acc[el][it] = mfma16(a[el], bb[it], acc[el][it]); }
        __syncthreads();
#pragma unroll
        for (int it = 0; it < 4; ++it) { float ss = 0.f;
#pragma unroll
            for (int el = 0; el < 3; ++el) ss += (acc[el][it][0] * acc[el][it][0] + acc[el][it][1] * acc[el][it][1]) + (acc[el][it][2] * acc[el][it][2] + acc[el][it][3] * acc[el][it][3]);
            ss += __shfl_xor(ss, 16); ss += __shfl_xor(ss, 32);
            if (fq == 0) red[wid * 64 + 16 * it + fr] = ss; }
        __syncthreads();
#pragma unroll
        for (int it = 0; it < 4; ++it) { float tot = 0.f;
#pragma unroll
            for (int w = 0; w < 8; ++w) tot += red[w * 64 + 16 * it + fr];
            const float rstd = 1.0f / sqrtf(tot * (1.0f / 384.0f) + 1e-6f);
#pragma unroll
            for (int el = 0; el < 3; ++el) { const int e = 16 * (3 * wid + el) + 4 * fq; const f32x4 g4 = *(const f32x4*)(gn + e);
                const f32x4 go = unpack4(*(const u32x2*)(Z + (m0 + 16 * it + fr) * EV_INP + EZ_G + h * 384 + e)); f32x4 o;
#pragma unroll
                for (int c = 0; c < 4; ++c) o[c] = acc[el][it][c] * rstd * g4[c] * (go[c] * sigmoidf_(go[c]));
                *(u32x2*)(MIX + (m0 + 16 * it + fr) * DM + 512 + h * 384 + e) = pack4(o); } }
    }
}

constexpr int DYN_LDS = 155648;
struct EvArgs { bf16* Z; const float *pw, *ps, *w2, *gb, *gn; bf16 *MIX, *ST; float* DEC; };
template <int PH> __global__ void __launch_bounds__(512, 2) k_even(EvArgs a) {
    extern __shared__ __attribute__((aligned(16))) unsigned char lds_raw[]; lds_t* lds = (lds_t*)lds_raw;
    const int vcu = blockIdx.x, G = gridDim.x;
    if constexpr (PH == 0) ph_pool(lds, vcu, G, a.Z, a.pw, a.ps, a.MIX);
    else if constexpr (PH == 1) ph_gla1(lds, vcu, G, a.Z, a.w2, a.gb, a.MIX, a.ST, a.DEC);
    else if constexpr (PH == 2) ph_gla2(vcu, G, a.ST, a.DEC);
    else ph_gla3(lds, vcu, G, a.Z, a.ST, a.gn, a.MIX);
}
struct RwkvW { const bf16 *W2T, *A2T, *G2T; };
struct RwkvB { bf16 *R, *LD, *KM, *V, *KK, *BV, *G, *Y; };
constexpr int ACT_ST = 656;
__device__ __forceinline__ f32x4 tsh4(const bf16* zc, bool hasprev, int col, const float* __restrict__ mu) {
    const f32x4 c = unpack4(*(const u32x2*)(zc + col)); f32x4 p = (f32x4){0.f, 0.f, 0.f, 0.f};
    if (hasprev) p = unpack4(*(const u32x2*)(zc - OD_INP + col));
    const f32x4 m4 = *(const f32x4*)(mu + col); return c + (p - c) * m4;
}
template <int PASS> __device__ __forceinline__ void rwkv_prep_pass(lds_t* lds, size_t m0, const bf16* __restrict__ Z, const RwkvP& P, const RwkvW& W, const RwkvB& B) {
    const int tid = threadIdx.x, wid = tid >> 6, lane = tid & 63, fr = lane & 15, fq = lane >> 4;
    constexpr int NKS = (PASS == 2) ? 6 : 2; constexpr int WST = (PASS == 2) ? 192 : 64; constexpr int COFF = (PASS == 0) ? 0 : (PASS == 1 ? 64 : 128);
    const bf16* Wt = (PASS == 0) ? W.W2T : (PASS == 1 ? W.A2T : W.G2T);
#pragma unroll 1
    for (int hh = 0; hh < 2; ++hh) {
        const int cb = 128 * wid + 64 * hh;
        f32x4 acc[4][4];
#pragma unroll
        for (int ct = 0; ct < 4; ++ct)
#pragma unroll
            for (int tt = 0; tt < 4; ++tt) acc[ct][tt] = (f32x4){0.f, 0.f, 0.f, 0.f};
#pragma unroll
        for (int ks = 0; ks < NKS; ++ks) { bf16x8 bb[4];
#pragma unroll
            for (int tt = 0; tt < 4; ++tt) bb[tt] = *(const LAS bf16x8*)(lds + (16 * tt + fr) * ACT_ST + (COFF + 32 * ks + 8 * fq) * 2);
#pragma unroll
            for (int ct = 0; ct < 4; ++ct) { const bf16x8 a = *(const bf16x8*)(Wt + (size_t)(cb + 16 * ct + fr) * WST + 32 * ks + 8 * fq);
#pragma unroll
                for (int tt = 0; tt < 4; ++tt) acc[ct][tt] = mfma16(a, bb[tt], acc[ct][tt]); } }
        if constexpr (PASS == 0) {
#pragma unroll
            for (int ct = 0; ct < 4; ++ct) { const int c = cb + 16 * ct + 4 * fq; const f32x4 w0 = *(const f32x4*)(P.w0 + c);
#pragma unroll
                for (int tt = 0; tt < 4; ++tt) { f32x4 o;
#pragma unroll
                    for (int e = 0; e < 4; ++e) { const float dw = acc[ct][tt][e] + w0[e]; o[e] = -__expf(-softplusf_(-dw) - 0.5f); }
                    *(u32x2*)(B.LD + (m0 + 16 * tt + fr) * 1024 + c) = pack4(o); } }
        } else if constexpr (PASS == 2) {
#pragma unroll
            for (int ct = 0; ct < 4; ++ct)
#pragma unroll
                for (int tt = 0; tt < 4; ++tt) *(u32x2*)(B.G + (m0 + 16 * tt + fr) * 1024 + cb + 16 * ct + 4 * fq) = pack4(acc[ct][tt]);
        } else {
#pragma unroll
            for (int tt = 0; tt < 4; ++tt) { const size_t m = m0 + 16 * tt + fr; const bool hp = (m % SEQ) != 0; const bf16* zc = Z + m * OD_INP;
                f32x4 kv[4], kk[4]; float ss = 0.f;
#pragma unroll
                for (int c4 = 0; c4 < 4; ++c4) { const int c = cb + 16 * c4 + 4 * fq; kv[c4] = tsh4(zc, hp, 1024 + c, P.mu); kk[c4] = kv[c4] * *(const f32x4*)(P.kk + c);
                    ss += (kk[c4][0] * kk[c4][0] + kk[c4][1] * kk[c4][1]) + (kk[c4][2] * kk[c4][2] + kk[c4][3] * kk[c4][3]); }
                ss += __shfl_xor(ss, 16); ss += __shfl_xor(ss, 32);
                const float inv = 1.0f / fmaxf(sqrtf(ss), 1e-12f);
#pragma unroll
                for (int c4 = 0; c4 < 4; ++c4) { const int c = cb + 16 * c4 + 4 * fq; const f32x4 a0 = *(const f32x4*)(P.a0 + c), ka = *(const f32x4*)(P.ka + c);
                    f32x4 a, km, kn, bv;
#pragma unroll
                    for (int e = 0; e < 4; ++e) { a[e] = sigmoidf_(acc[c4][tt][e] + a0[e]); kn[e] = kk[c4][e] * inv; km[e] = kv[c4][e] * (1.f + (a[e] - 1.f) * ka[e]); bv[e] = kn[e] * a[e]; }
                    const size_t o = m * 1024 + c;
                    *(u32x2*)(B.R + o) = pack4(tsh4(zc, hp, c, P.mu)); *(u32x2*)(B.V + o) = pack4(tsh4(zc, hp, 2048 + c, P.mu));
                    *(u32x2*)(B.KM + o) = pack4(km); *(u32x2*)(B.KK + o) = pack4(kn); *(u32x2*)(B.BV + o) = pack4(bv); }
                asm volatile("" ::: "memory"); }
        }
    }
}
__device__ __forceinline__ void ph_rwkv_prep(lds_t* lds, int vcu, int G, bf16* Z, const RwkvP& P, const RwkvW& W, const RwkvB& B) {
    const int tid = threadIdx.x;
    for (int u = vcu; u < M / 64; u += G) { const size_t m0 = (size_t)u * 64;
        __syncthreads();
#pragma unroll 2
        for (int i = 0; i < 40; ++i) { const int idx = tid + 512 * i, tok = idx / 320, col = idx % 320; float f = 0.f;
            if (col < 288) { const size_t m = m0 + tok; const int zc = OZ_HW + col; const float hc = bf2f(Z[m * OD_INP + zc]); const float pv = (m % SEQ) ? bf2f(Z[(m - 1) * OD_INP + zc]) : 0.f;
                const float v = hc + (pv - hc) * P.mu[zc]; f = (col < 64) ? tanhf(v) : (col < 128 ? v : sigmoidf_(v)); }
            *(LAS bf16*)(lds + tok * ACT_ST + col * 2) = (bf16)f2bf(f); }
        __syncthreads();
        rwkv_prep_pass<0>(lds, m0, Z, P, W, B);
        rwkv_prep_pass<1>(lds, m0, Z, P, W, B);
        rwkv_prep_pass<2>(lds, m0, Z, P, W, B);
    }
    for (int m = vcu; m < M; m += G) { const int t = m % SEQ, j = tid & 63;
        const float inv = powf(10000.0f, -(float)j * (1.0f / 64.0f)); const float ang = (float)t * inv;
        const double rev = (double)ang * 0.15915494309189535; const float frc = (float)(rev - rint(rev));
        const float sn = __builtin_amdgcn_sinf(frc), cs = __builtin_amdgcn_cosf(frc);
#pragma unroll
        for (int i = 0; i < 2; ++i) { const int qh = (tid >> 6) + 8 * i;
            bf16* p = Z + (size_t)m * OD_INP + OZ_DQ + qh * 128 + j;
            const float x1 = bf2f(p[0]), x2 = bf2f(p[64]); p[0] = (bf16)f2bf(x1 * cs - x2 * sn); p[64] = (bf16)f2bf(x2 * cs + x1 * sn); } }
}
template <int CTRL> __device__ __forceinline__ float dpp_f(float v) { return __int_as_float(__builtin_amdgcn_update_dpp(0, __float_as_int(v), CTRL, 0xF, 0xF, false)); }
__device__ __forceinline__ float red16(float v) { v += dpp_f<0x128>(v); v += dpp_f<0x124>(v); v += dpp_f<0x122>(v); v += dpp_f<0x121>(v); return v; }
constexpr int SC_TB = 32, SC_BUF = SC_TB * 5 * 64 * 4, SC_VOFF = 2 * SC_BUF, SC_VBUF = SC_TB * 32 * 4, SC_YOFF = SC_VOFF + 2 * SC_VBUF, SC_LDS = SC_YOFF + SC_TB * 32 * 4;
__device__ __forceinline__ void ph_rwkv_scan(lds_t* lds, int sidx, const RwkvB& B) {
    const int tid = threadIdx.x, wid = tid >> 6, lane = tid & 63, rloc = wid * 4 + (lane >> 4), ks = lane & 15;
    const int b = sidx >> 5, h = (sidx >> 1) & 15, half = sidx & 1;
    const size_t rowbase = (size_t)b * SEQ * 1024 + h * 64;
    u32x4 pre[3]; u32x4 prev = (u32x4){0u, 0u, 0u, 0u};
#define SC_ISSUE(t0_) do { const int t0__ = (t0_); \
        _Pragma("unroll") for (int i = 0; i < 3; ++i) { const int q = tid + 512 * i; if (q < 1280) { const int a = q >> 8, rem = q & 255, s = rem >> 3, c8 = rem & 7; \
            const bf16* src = (a == 0) ? B.R : (a == 1) ? B.LD : (a == 2) ? B.KM : (a == 3) ? B.KK : B.BV; \
            pre[i] = *(const u32x4*)(src + rowbase + (size_t)(t0__ + s) * 1024 + 8 * c8); } } \
        if (tid < 128) { const int s = tid >> 2, c8 = tid & 3; prev = *(const u32x4*)(B.V + rowbase + (size_t)(t0__ + s) * 1024 + half * 32 + 8 * c8); } } while (0)
#define SC_COMMIT(bufi_) do { const int bufi__ = (bufi_); \
        _Pragma("unroll") for (int i = 0; i < 3; ++i) { const int q = tid + 512 * i; if (q < 1280) { const int a = q >> 8, rem = q & 255, s = rem >> 3, c8 = rem & 7; \
            f32x4 lo, hi; lo[0] = bflo_(pre[i].x); lo[1] = bfhi_(pre[i].x); lo[2] = bflo_(pre[i].y); lo[3] = bfhi_(pre[i].y); hi[0] = bflo_(pre[i].z); hi[1] = bfhi_(pre[i].z); hi[2] = bflo_(pre[i].w); hi[3] = bfhi_(pre[i].w); \
            if (a == 1) { _Pragma("unroll") for (int e = 0; e < 4; ++e) { lo[e] = __expf(lo[e]); hi[e] = __expf(hi[e]); } } \
            LAS f32x4* dst = (LAS f32x4*)(lds + bufi__ * SC_BUF + ((s * 5 + a) * 64 + 8 * c8) * 4); dst[0] = lo; dst[1] = hi; } } \
        if (tid < 128) { const int s = tid >> 2, c8 = tid & 3; f32x4 lo, hi; lo[0] = bflo_(prev.x); lo[1] = bfhi_(prev.x); lo[2] = bflo_(prev.y); lo[3] = bfhi_(prev.y); hi[0] = bflo_(prev.z); hi[1] = bfhi_(prev.z); hi[2] = bflo_(prev.w); hi[3] = bfhi_(prev.w); \
            LAS f32x4* dst = (LAS f32x4*)(lds + SC_VOFF + bufi__ * SC_VBUF + (s * 32 + 8 * c8) * 4); dst[0] = lo; dst[1] = hi; } } while (0)
    float S0 = 0.f, S1 = 0.f, S2 = 0.f, S3 = 0.f;
    __syncthreads();
    SC_ISSUE(0); SC_COMMIT(0);
    __syncthreads();
    for (int blk = 0; blk < SEQ / SC_TB; ++blk) { const int bufi = blk & 1;
        if (blk + 1 < SEQ / SC_TB) SC_ISSUE((blk + 1) * SC_TB);
        const lds_t* bp = lds + bufi * SC_BUF; const lds_t* vp = lds + SC_VOFF + bufi * SC_VBUF;
#pragma unroll 4
        for (int s = 0; s < SC_TB; ++s) { const LAS f32x4* sp = (const LAS f32x4*)(bp + s * 5 * 64 * 4) + ks;
            const f32x4 r4 = sp[0], w4 = sp[16], m4 = sp[32], k4 = sp[48], b4 = sp[64]; const float vv = ((const LAS float*)vp)[s * 32 + rloc];
            const float sa = -red16((S0 * k4[0] + S1 * k4[1]) + (S2 * k4[2] + S3 * k4[3]));
            S0 = S0 * w4[0] + (sa * b4[0] + vv * m4[0]); S1 = S1 * w4[1] + (sa * b4[1] + vv * m4[1]); S2 = S2 * w4[2] + (sa * b4[2] + vv * m4[2]); S3 = S3 * w4[3] + (sa * b4[3] + vv * m4[3]);
            const float y = red16((S0 * r4[0] + S1 * r4[1]) + (S2 * r4[2] + S3 * r4[3]));
            if (ks == 0) ((LAS float*)(lds + SC_YOFF))[s * 32 + rloc] = y; }
        __syncthreads();
        if (tid < 128) { const int s = tid >> 2, c8 = tid & 3; const LAS f32x4* yp = (const LAS f32x4*)(lds + SC_YOFF + (s * 32 + 8 * c8) * 4); const f32x4 a = yp[0], c = yp[1];
            u32x4 o; o.x = pk2(a[0], a[1]); o.y = pk2(a[2], a[3]); o.z = pk2(c[0], c[1]); o.w = pk2(c[2], c[3]);
            *(u32x4*)(B.Y + rowbase + (size_t)(blk * SC_TB + s) * 1024 + half * 32 + 8 * c8) = o; }
        if (blk + 1 < SEQ / SC_TB) SC_COMMIT(bufi ^ 1);
        __syncthreads();
    }
}
__device__ __forceinline__ float red16x(float v) { v += __shfl_xor(v, 1); v += __shfl_xor(v, 2); v += __shfl_xor(v, 4); v += __shfl_xor(v, 8); return v; }
__device__ __forceinline__ void ph_rwkv_fin(int vcu, int G, const RwkvP& P, const RwkvB& B, bf16* __restrict__ MIX) {
    const int wid = threadIdx.x >> 6, lane = threadIdx.x & 63;
    for (int task = vcu * 8 + wid; task < M * 4; task += G * 8) { const size_t m = task >> 2; const int c = (task & 3) * 256 + 4 * lane; const size_t o = m * 1024 + c;
        const f32x4 y = unpack4(*(const u32x2*)(B.Y + o)), r = unpack4(*(const u32x2*)(B.R + o)), km = unpack4(*(const u32x2*)(B.KM + o)), v = unpack4(*(const u32x2*)(B.V + o)), g = unpack4(*(const u32x2*)(B.G + o));
        const f32x4 rk = *(const f32x4*)(P.rk + c), lw = *(const f32x4*)(P.lnw + c), lb = *(const f32x4*)(P.lnb + c);
        const float mean = red16x((y[0] + y[1]) + (y[2] + y[3])) * (1.0f / 64.0f); const f32x4 dy = y - mean;
        const float var = red16x((dy[0] * dy[0] + dy[1] * dy[1]) + (dy[2] * dy[2] + dy[3] * dy[3])) * (1.0f / 64.0f); const float rs = 1.0f / sqrtf(var + 64e-5f);
        const float bon = red16x((r[0] * km[0] * rk[0] + r[1] * km[1] * rk[1]) + (r[2] * km[2] * rk[2] + r[3] * km[3] * rk[3]));
        f32x4 out;
#pragma unroll
        for (int e = 0; e < 4; ++e) out[e] = (dy[e] * rs * lw[e] + lb[e] + bon * v[e]) * g[e];
        *(u32x2*)(MIX + m * DM + c) = pack4(out); }
}
constexpr int DA_ST = 272, DA_K = 0, DA_V = 272 * DA_ST, DA_LDS = 2 * 272 * DA_ST;
__device__ __forceinline__ void ph_dil(lds_t* lds, int aidx, int NA, const bf16* __restrict__ Z, bf16* MIX, float* ML) {
    const int tid = threadIdx.x, wid = tid >> 6, lane = tid & 63, fr = lane & 15, fq = lane >> 4, lq = fr >> 2, lp = fr & 3;
    const float scale = 0.08838834764831845f;
    for (int u = aidx; u < BATCH * 8 * 8; u += NA) { const int b = u >> 6, h = (u >> 3) & 7, W = u & 7;
        const size_t mb = (size_t)b * SEQ;
        for (int stage = 0; stage < 3; ++stage) { const int dil = (stage == 0) ? 1 : (stage == 1 ? 4 : 16);
            for (int sb = 0; sb < 16; ++sb) {
                int r, qs0;
                if (stage == 0) { r = 0; qs0 = 2048 * W + 128 * sb; } else if (stage == 1) { r = sb >> 2; qs0 = 512 * W + 128 * (sb & 3); } else { r = sb; qs0 = 128 * W; }
                asm volatile("s_waitcnt vmcnt(0)" ::: "memory");
                __syncthreads();
#pragma unroll 4
                for (int i = 0; i < 16; ++i) { const int q = tid + 512 * i, kv = q >> 12, rem = q & 4095, j = rem >> 4, cc = rem & 15; const int sp = qs0 - 128 + j;
                    u32x4 val = (u32x4){0u, 0u, 0u, 0u};
                    if (sp >= 0) val = *(const u32x4*)(Z + (mb + (size_t)sp * dil + r) * OD_INP + (kv ? OZ_DV : OZ_DK) + h * 128 + cc * 8);
                    *(LAS u32x4*)(lds + (kv ? DA_V : DA_K) + j * DA_ST + cc * 16) = val; }
                { const int kv = tid >> 8, rem = tid & 255, j = 256 + (rem >> 4), cc = rem & 15; *(LAS u32x4*)(lds + (kv ? DA_V : DA_K) + j * DA_ST + cc * 16) = (u32x4){0u, 0u, 0u, 0u}; }
                __syncthreads();
                const size_t mq = mb + (size_t)(qs0 + 16 * wid + fr) * dil + r;
                bf16x8 qf[4];
#pragma unroll
                for (int ks = 0; ks < 4; ++ks) qf[ks] = *(const bf16x8*)(Z + mq * OD_INP + OZ_DQ + h * 128 + 32 * ks + 8 * fq);
                f32x4 sc[10];
#pragma unroll
                for (int kt = 0; kt < 9; ++kt) { f32x4 a = (f32x4){0.f, 0.f, 0.f, 0.f};
#pragma unroll
                    for (int ks = 0; ks < 4; ++ks) { const bf16x8 kf = *(const LAS bf16x8*)(lds + DA_K + (16 * wid + 16 * kt + fr) * DA_ST + (32 * ks + 8 * fq) * 2); a = mfma16(kf, qf[ks], a); }
                    sc[kt] = a; }
                sc[9] = (f32x4){0.f, 0.f, 0.f, 0.f};
                float mx = -INFINITY;
#pragma unroll
                for (int kt = 0; kt < 9; ++kt)
#pragma unroll
                    for (int e = 0; e < 4; ++e) { const int dist = 128 + fr - 16 * kt - 4 * fq - e; const int j = 16 * wid + 16 * kt + 4 * fq + e;
                        const bool ok = (dist >= 0) && (dist <= 128) && (qs0 - 128 + j >= 0);
                        const float s = ok ? sc[kt][e] * scale : -INFINITY; sc[kt][e] = s; mx = fmaxf(mx, s); }
                mx = fmaxf(mx, __shfl_xor(mx, 16)); mx = fmaxf(mx, __shfl_xor(mx, 32));
                float mrun = -INFINITY, lrun = 0.f;
                float* mlp = ML + (mq * 8 + h) * 2;
                if (stage > 0) { mrun = mlp[0]; lrun = mlp[1]; }
                const float mt = fmaxf(mrun, mx); const float alpha = (stage > 0) ? __expf(mrun - mt) : 0.f;
                float ls = 0.f;
#pragma unroll
                for (int kt = 0; kt < 9; ++kt)
#pragma unroll
                    for (int e = 0; e < 4; ++e) { const float p = __expf(sc[kt][e] - mt); sc[kt][e] = p; ls += p; }
                ls += __shfl_xor(ls, 16); ls += __shfl_xor(ls, 32);
                const float lt = lrun * alpha + ls;
                f32x4 oacc[8];
                bf16* op = MIX + mq * DM + 1024 + h * 128 + 4 * fq;
#pragma unroll
                for (int dt = 0; dt < 8; ++dt) { if (stage > 0) oacc[dt] = unpack4(*(const u32x2*)(op + 16 * dt)) * (lrun * alpha); else oacc[dt] = (f32x4){0.f, 0.f, 0.f, 0.f}; }
#pragma unroll
                for (int k2 = 0; k2 < 5; ++k2) { u32x4 pw; pw.x = pk2(sc[2 * k2][0], sc[2 * k2][1]); pw.y = pk2(sc[2 * k2][2], sc[2 * k2][3]); pw.z = pk2(sc[2 * k2 + 1][0], sc[2 * k2 + 1][1]); pw.w = pk2(sc[2 * k2 + 1][2], sc[2 * k2 + 1][3]);
                    const bf16x8 pf = __builtin_bit_cast(bf16x8, pw);
#pragma unroll
                    for (int dt = 0; dt < 8; ++dt) { const lds_t* p0 = lds + DA_V + (16 * wid + 32 * k2 + 4 * fq + lq) * DA_ST + (16 * dt + 4 * lp) * 2;
                        const bf16x8 vf = cat8(vtr(p0), vtr(p0 + 16 * DA_ST)); oacc[dt] = mfma16(vf, pf, oacc[dt]); } }
                const float il = 1.0f / lt;
#pragma unroll
                for (int dt = 0; dt < 8; ++dt) *(u32x2*)(op + 16 * dt) = pack4(oacc[dt] * il);
                if (fq == 0 && stage < 2) { mlp[0] = mt; mlp[1] = lt; }
            }
        }
    }
}

struct OdArgs { bf16* Z; RwkvP P; RwkvW W; RwkvB B; bf16* MIX; float* ML; };
template <int PH> __global__ void __launch_bounds__(512, 2) k_odd(OdArgs a) {
    extern __shared__ __attribute__((aligned(16))) unsigned char lds_raw[]; lds_t* lds = (lds_t*)lds_raw;
    const int vcu = blockIdx.x, G = gridDim.x;
    if constexpr (PH == 0) ph_rwkv_prep(lds, vcu, G, a.Z, a.P, a.W, a.B);
    else if constexpr (PH == 1) { if (vcu < 64) ph_rwkv_scan(lds, vcu, a.B); else ph_dil(lds, vcu - 64, G - 64, a.Z, a.MIX, a.ML); }
    else ph_rwkv_fin(vcu, G, a.P, a.B, a.MIX);
}
template <int MODE> static void launch_gemm(hipStream_t st, int grid, const bf16* A, const bf16* Bt, bf16* O, const bf16* PP, float* X, int N, int K, int ldc) {
    GArgs a{}; a.A = A; a.Bt = Bt; a.O = O; a.PP = PP; a.X = X; a.Mr = M; a.N = N; a.K = K; a.ldc = ldc;
    k_gemm<MODE><<<grid, 512, 131072, st>>>(a);
}
static void conv_w(hipStream_t st, const float* W, int K, int N, int Npad, bf16* Wt, int Kpad = 0) { if (!Kpad) Kpad = K; k_wt<<<dim3(Npad / 64, Kpad / 64), 256, 0, st>>>(W, K, N, Wt, Kpad); }

extern "C" void kernel_launch(void* const* d_in, const int* in_sizes, int n_in, void* d_out, int out_size, void* d_ws, size_t ws_size, hipStream_t stream) {
    static int grid = 0;
    if (grid == 0) {
        if (n_in != 31 || out_size != M * DM || ws_size < WS_NEED) { fprintf(stderr, "kernel_launch: unexpected shapes n_in %d out %d ws %zu\n", n_in, out_size, ws_size); grid = -1; return; }
        int dev = 0, cus = 0; hipGetDevice(&dev); hipDeviceGetAttribute(&cus, hipDeviceAttributeMultiprocessorCount, dev);
        hipFuncSetAttribute((const void*)k_gemm<0>, hipFuncAttributeMaxDynamicSharedMemorySize, 131072);
        hipFuncSetAttribute((const void*)k_gemm<2>, hipFuncAttributeMaxDynamicSharedMemorySize, 131072);
        hipFuncSetAttribute((const void*)k_gemm<3>, hipFuncAttributeMaxDynamicSharedMemorySize, 131072);
        hipFuncSetAttribute((const void*)k_even<0>, hipFuncAttributeMaxDynamicSharedMemorySize, DYN_LDS); hipFuncSetAttribute((const void*)k_even<1>, hipFuncAttributeMaxDynamicSharedMemorySize, DYN_LDS);
        hipFuncSetAttribute((const void*)k_even<2>, hipFuncAttributeMaxDynamicSharedMemorySize, DYN_LDS); hipFuncSetAttribute((const void*)k_even<3>, hipFuncAttributeMaxDynamicSharedMemorySize, DYN_LDS);
        hipFuncSetAttribute((const void*)k_odd<0>, hipFuncAttributeMaxDynamicSharedMemorySize, DYN_LDS); hipFuncSetAttribute((const void*)k_odd<1>, hipFuncAttributeMaxDynamicSharedMemorySize, DYN_LDS);
        hipFuncSetAttribute((const void*)k_odd<2>, hipFuncAttributeMaxDynamicSharedMemorySize, DYN_LDS);
        grid = cus > 0 ? cus : 256;
    }
    if (grid < 0) return;
    const float* const* in = (const float* const*)d_in;
    unsigned char* ws = (unsigned char*)d_ws; float* x = (float*)d_out;
    bf16 *WIN = (bf16*)(ws + WS_WIN), *WOUT = (bf16*)(ws + WS_WOUT), *WUP = (bf16*)(ws + WS_WUP), *WDN = (bf16*)(ws + WS_WDN), *WGT = (bf16*)(ws + WS_WGT), *WPJ = (bf16*)(ws + WS_WPJ);
    bf16 *H = (bf16*)(ws + WS_H), *Y = (bf16*)(ws + WS_Y), *MIX = (bf16*)(ws + WS_MIX), *PB = (bf16*)(ws + WS_PB), *Z = (bf16*)(ws + WS_Z), *HID = (bf16*)(ws + WS_HID);
    for (int i = 0; i < DEPTH; ++i) {
        const int j = i >> 1; const bool odd = i & 1;
        const int NZ = odd ? OD_INP : EV_INP;
        if (odd) conv_w(stream, in[13] + (size_t)j * DM * OD_IN, DM, OD_IN, OD_INP, WIN); else conv_w(stream, in[6] + (size_t)j * DM * EV_IN, DM, EV_IN, EV_INP, WIN);
        conv_w(stream, (odd ? in[14] : in[7]) + (size_t)j * DM * DM, DM, DM, DM, WOUT);
        conv_w(stream, in[26] + (size_t)i * DM * DFF, DM, DFF, DFF, WUP);
        conv_w(stream, in[27] + (size_t)i * DFF * DM, DFF, DM, DM, WDN);
        conv_w(stream, in[29] + (size_t)i * DM * DM, DM, DM, DM, WGT);
        conv_w(stream, in[28] + (size_t)i * PLE * DM, PLE, DM, DM, WPJ);
        k_cvt<<<(unsigned)(((size_t)M * PLE / 4 + 255) / 256), 256, 0, stream>>>(in[1] + (size_t)i * M * PLE, PB, (size_t)M * PLE / 4);
        k_norm0<<<M / 4, 256, 0, stream>>>(i == 0 ? in[0] : x, i == 0 ? x : nullptr, in[2] + (size_t)i * DM, H);
        launch_gemm<0>(stream, grid, H, WIN, Z, nullptr, nullptr, NZ, DM, NZ);
        if (!odd) {
            EvArgs e{}; e.Z = Z; e.pw = in[8] + (size_t)j * 4 * 128 * 128; e.ps = in[9] + (size_t)j * 512; e.w2 = in[10] + (size_t)j * 16 * 768; e.gb = in[11] + (size_t)j * 768; e.gn = in[12] + (size_t)j * 384;
            e.MIX = MIX; e.ST = (bf16*)(ws + WS_T_EV); e.DEC = (float*)(ws + WS_DEC);
            k_even<0><<<grid, 512, DYN_LDS, stream>>>(e);
            k_even<1><<<grid, 512, DYN_LDS, stream>>>(e);
            k_even<2><<<grid, 512, DYN_LDS, stream>>>(e);
            k_even<3><<<grid, 512, DYN_LDS, stream>>>(e);
        } else {
            RwkvP P{}; P.mu = in[15] + (size_t)j * 3360; P.w0 = in[16] + (size_t)j * 1024; P.w2 = in[17] + (size_t)j * 64 * 1024; P.a0 = in[18] + (size_t)j * 1024; P.a2 = in[19] + (size_t)j * 64 * 1024;
            P.g2 = in[20] + (size_t)j * 160 * 1024; P.kk = in[21] + (size_t)j * 1024; P.ka = in[22] + (size_t)j * 1024; P.rk = in[23] + (size_t)j * 1024; P.lnw = in[24] + (size_t)j * 1024; P.lnb = in[25] + (size_t)j * 1024;
            bf16* W2T = (bf16*)(ws + WS_SMALL); bf16* A2T = W2T + 1024 * 64; bf16* G2T = A2T + 1024 * 64;
            conv_w(stream, P.w2, 64, 1024, 1024, W2T); conv_w(stream, P.a2, 64, 1024, 1024, A2T); conv_w(stream, P.g2, 160, 1024, 1024, G2T, 192);
            OdArgs o{}; o.Z = Z; o.P = P; o.W.W2T = W2T; o.W.A2T = A2T; o.W.G2T = G2T; o.MIX = MIX; o.ML = (float*)(ws + WS_ML);
            o.B.R = (bf16*)(ws + WS_H); o.B.LD = (bf16*)(ws + WS_H + SLOT); o.B.KM = (bf16*)(ws + WS_H + 2 * SLOT); o.B.KK = (bf16*)(ws + WS_H + 3 * SLOT);
            o.B.BV = (bf16*)(ws + WS_T_OD); o.B.V = (bf16*)(ws + WS_T_OD + SLOT); o.B.G = (bf16*)(ws + WS_T_OD + 2 * SLOT); o.B.Y = (bf16*)(ws + WS_T_OD + 3 * SLOT);
            k_odd<0><<<grid, 512, DYN_LDS, stream>>>(o);
            k_odd<1><<<grid, 512, DYN_LDS, stream>>>(o);
            k_odd<2><<<grid, 512, DYN_LDS, stream>>>(o);
        }
        launch_gemm<0>(stream, grid, MIX, WOUT, Y, nullptr, nullptr, DM, DM, DM);
        k_norm_res<<<M / 4, 256, 0, stream>>>(Y, x, in[3] + (size_t)i * DM, in[4] + (size_t)i * DM, H);
        launch_gemm<2>(stream, grid, H, WUP, HID, nullptr, nullptr, DFF, DM, DFF);
        launch_gemm<0>(stream, grid, HID, WDN, Y, nullptr, nullptr, DM, DFF, DM);
        k_norm_res<<<M / 4, 256, 0, stream>>>(Y, x, in[5] + (size_t)i * DM, in[30] + (size_t)i * DM, H);
        launch_gemm<0>(stream, grid, PB, WPJ, MIX, nullptr, nullptr, DM, PLE, DM);
        launch_gemm<3>(stream, grid, H, WGT, nullptr, MIX, x, DM, DM, DM);
    }
}
```

```cpp
#include <hip/hip_runtime.h>
#include <cstdio>
#include <cstdint>
#ifndef FSPL
#define FSPL 4
#endif
#ifndef RBAR
#define RBAR 1
#endif
#ifndef RR1
#define RR1 1
#endif
#ifndef RE1
#define RE1 1
#endif
#ifndef RE3
#define RE3 1
#endif
#ifndef REP
#define REP 1
#endif
#ifndef RPR
#define RPR 1
#endif
#ifndef RSC
#define RSC 1
#endif
#ifndef RAT
#define RAT 1
#endif
#ifndef RG
#define RG 1
#endif
#ifndef R0
#define R0 1
#endif
#ifndef RS
#define RS 1
#endif
#ifndef RF
#define RF 1
#endif
__device__ __forceinline__ int opqs_(int v) { asm volatile("" : "+s"(v)); return v; }
__device__ __forceinline__ int opq_(int v) { asm volatile("" : "+v"(v)); return v; }
namespace pg8 {
#define PG8_LAS __attribute__((address_space(3)))
typedef unsigned short bf16_t;
typedef short bf16x8 __attribute__((ext_vector_type(8)));
typedef float f32x4 __attribute__((ext_vector_type(4)));
typedef unsigned u32x4 __attribute__((ext_vector_type(4)));
constexpr int BM = 256, BK = 64, HALF = 128, HTB = HALF * BK * 2  , STAGE_BYTES = 8 * HTB, NXCD = 8, WGM = 8;

__host__ __device__ __forceinline__ int lds_byte(int r, int c) { const int st = (r >> 4) * 2 + (c >> 5), rr = r & 15, cc = c & 31, ob = rr * 64 + cc * 2; return st * 1024 + (ob ^ (((ob >> 9) & 1) << 5)); }
__host__ __device__ __forceinline__ void stage_rc(int b, int& R, int& C) { const int st = b / 1024, sb = b % 1024, swz = sb ^ (((sb >> 9) & 1) << 5); R = (st >> 1) * 16 + swz / 64; C = (st & 1) * 32 + (swz % 64) / 2; }
__host__ __device__ __forceinline__ int perm32(int rho) { const int n = rho >> 4, i = rho & 15; return 8 * (i >> 2) + 4 * n + (i & 3); }

struct Unit { int pm, pn; };
struct Gemm { const bf16_t* A; const bf16_t* Bt; int M, N, K; };

struct StaticOrder {
    int nM, nN, nwg, G, c;
    __host__ __device__ void init(int M, int N, int G_, int c_) { nM = M / BM; nN = N / BM; nwg = nM * nN; G = G_; c = c_; }
    __host__ __device__ bool next(int i, Unit& u) const {
        const long L = (long)i * G + c; if (L >= nwg) return false;
        int wgid = (int)L; { const int q = nwg / NXCD, r = nwg % NXCD, xcd = wgid % NXCD, off = wgid / NXCD; wgid = (xcd < r ? xcd * (q + 1) : r * (q + 1) + (xcd - r) * q) + off; }
        const int nig = WGM * nN, gid = wgid / nig, fm = gid * WGM, gsz = (nM - fm) < WGM ? (nM - fm) : WGM;
        u.pm = fm + ((wgid % nig) % gsz); u.pn = (wgid % nig) / gsz; return true;
    }
    __device__ __forceinline__ void a_ready(const Unit&) const {}
    __device__ __forceinline__ void done(const Unit&) const {}
};

__device__ __forceinline__ unsigned cvt_pk_bf16(float lo, float hi) { unsigned r; asm volatile("v_cvt_pk_bf16_f32 %0, %1, %2" : "=v"(r) : "v"(lo), "v"(hi)); return r; }
__device__ __forceinline__ float bflo(unsigned w) { return __uint_as_float(w << 16); }
__device__ __forceinline__ float bfhi(unsigned w) { return __uint_as_float(w & 0xffff0000u); }
template <int ACT  > struct EpiBf16 {
    static constexpr bool PERM = true, AFTER_DRAIN = false;
    bf16_t* O; int ldc; const float* rowsc; int rsmode;
    __device__ __forceinline__ void pre(float (&rv)[8], const Unit& u, int wr, int fr) const {
        const int row0 = u.pm * BM + wr * 64 + fr;
#pragma unroll
        for (int q = 0; q < 8; ++q) rv[q] = rsmode ? rowsc[row0 + (q >> 2) * HALF + (q & 3) * 16] : 1.f;
    }
    __device__ __forceinline__ void operator()(const f32x4 (&acc)[2][2][4][2], const float (&rv)[8], const Unit& u, int wr, int wc, int fr, int fq) const {
        const int row0 = u.pm * BM + wr * 64 + fr; const int col0 = u.pn * BM + wc * 32 + 8 * fq;
        float rsv[2][4];
#pragma unroll
        for (int ai = 0; ai < 2; ++ai)
#pragma unroll
            for (int m = 0; m < 4; ++m) { float sc = 1.f; if (rsmode) { const float r_ = rv[ai * 4 + m]; sc = (rsmode == 1) ? r_ : 1.0f / sqrtf(r_ * (1.0f / 2048.0f) + 1e-6f); } rsv[ai][m] = sc; }
#pragma unroll
        for (int ai = 0; ai < 2; ++ai)
#pragma unroll
            for (int m = 0; m < 4; ++m) { bf16_t* rowp = O + (size_t)(row0 + ai * HALF + m * 16) * ldc + col0; const float sc = rsv[ai][m];
#pragma unroll
                for (int bj = 0; bj < 2; ++bj) { f32x4 v0 = acc[ai][bj][m][0] * sc, v1 = acc[ai][bj][m][1] * sc;
                    if (ACT == 2) {
#pragma unroll
                        for (int e = 0; e < 4; ++e) { float a = fmaxf(v0[e], 0.f), b = fmaxf(v1[e], 0.f); v0[e] = a * a; v1[e] = b * b; } }
                    u32x4 w; w.x = cvt_pk_bf16(v0[0], v0[1]); w.y = cvt_pk_bf16(v0[2], v0[3]); w.z = cvt_pk_bf16(v1[0], v1[1]); w.w = cvt_pk_bf16(v1[2], v1[3]);
                    *(u32x4*)(rowp + bj * HALF) = w; } }
    }
};
struct EpiGate {
    static constexpr bool PERM = true, AFTER_DRAIN = false;
    const bf16_t* PP; const bf16_t* XI; bf16_t* XO; float* FO; const float* rowsc; float* SSN; int ldc;
    __device__ __forceinline__ void pre(float (&rv)[8], const Unit& u, int wr, int fr) const {
        const int row0 = u.pm * BM + wr * 64 + fr;
#pragma unroll
        for (int q = 0; q < 8; ++q) rv[q] = rowsc[row0 + (q >> 2) * HALF + (q & 3) * 16];
    }
    __device__ __forceinline__ void operator()(const f32x4 (&acc)[2][2][4][2], const float (&rv)[8], const Unit& u, int wr, int wc, int fr, int fq) const {
        const int row0 = u.pm * BM + wr * 64 + fr; const int col0 = u.pn * BM + wc * 32 + 8 * fq;
        u32x4 pwn[2], xwn[2];
#pragma unroll
        for (int bj = 0; bj < 2; ++bj) { const size_t ro0 = (size_t)row0 * ldc + col0; pwn[bj] = *(const u32x4*)(PP + ro0 + bj * HALF); xwn[bj] = *(const u32x4*)(XI + ro0 + bj * HALF); }
#pragma unroll
        for (int ai = 0; ai < 2; ++ai)
#pragma unroll
            for (int m = 0; m < 4; ++m) { const int row = row0 + ai * HALF + m * 16; const size_t ro = (size_t)row * ldc + col0; const float sc = rv[ai * 4 + m];
                u32x4 pw[2], xw[2]; float ss = 0.f;
#pragma unroll
                for (int bj = 0; bj < 2; ++bj) { pw[bj] = pwn[bj]; xw[bj] = xwn[bj]; }
                if (ai * 4 + m < 7) { const int qn = ai * 4 + m + 1; const size_t ron = (size_t)(row0 + (qn >> 2) * HALF + (qn & 3) * 16) * ldc + col0;
#pragma unroll
                    for (int bj = 0; bj < 2; ++bj) { pwn[bj] = *(const u32x4*)(PP + ron + bj * HALF); xwn[bj] = *(const u32x4*)(XI + ron + bj * HALF); } }
#pragma unroll
                for (int bj = 0; bj < 2; ++bj) { const size_t off = ro + bj * HALF;
                    const f32x4 a0 = acc[ai][bj][m][0] * sc, a1 = acc[ai][bj][m][1] * sc; f32x4 x0, x1;
                    x0[0] = bflo(xw[bj].x) + bflo(pw[bj].x) / (1.f + __expf(-a0[0])); x0[1] = bfhi(xw[bj].x) + bfhi(pw[bj].x) / (1.f + __expf(-a0[1]));
                    x0[2] = bflo(xw[bj].y) + bflo(pw[bj].y) / (1.f + __expf(-a0[2])); x0[3] = bfhi(xw[bj].y) + bfhi(pw[bj].y) / (1.f + __expf(-a0[3]));
                    x1[0] = bflo(xw[bj].z) + bflo(pw[bj].z) / (1.f + __expf(-a1[0])); x1[1] = bfhi(xw[bj].z) + bfhi(pw[bj].z) / (1.f + __expf(-a1[1]));
                    x1[2] = bflo(xw[bj].w) + bflo(pw[bj].w) / (1.f + __expf(-a1[2])); x1[3] = bfhi(xw[bj].w) + bfhi(pw[bj].w) / (1.f + __expf(-a1[3]));
                    if (FO) { *(f32x4*)(FO + off) = x0; *(f32x4*)(FO + off + 4) = x1; }
                    else { u32x4 w; w.x = cvt_pk_bf16(x0[0], x0[1]); w.y = cvt_pk_bf16(x0[2], x0[3]); w.z = cvt_pk_bf16(x1[0], x1[1]); w.w = cvt_pk_bf16(x1[2], x1[3]); *(u32x4*)(XO + off) = w;
                        const float q0 = bflo(w.x), q1 = bfhi(w.x), q2 = bflo(w.y), q3 = bfhi(w.y), q4 = bflo(w.z), q5 = bfhi(w.z), q6 = bflo(w.w), q7 = bfhi(w.w);
                        ss += (q0 * q0 + q1 * q1) + (q2 * q2 + q3 * q3) + (q4 * q4 + q5 * q5) + (q6 * q6 + q7 * q7); } }
                if (SSN) { ss += __shfl_xor(ss, 16); ss += __shfl_xor(ss, 32); if (fq == 0) SSN[(size_t)row * 32 + u.pn * 4 + wc] = ss; } }
    }
};

template <class Epi, class Sched, bool ALIGN_EPI = false, bool SP2 = false>
__device__ __forceinline__ void gemm_phase(PG8_LAS unsigned char* lds, const Gemm g, const Sched& S, const Epi& E) {
    const int tid = opq_((int)threadIdx.x), wid = __builtin_amdgcn_readfirstlane(tid >> 6), lane = tid & 63, wr = wid >> 2, wc = wid & 3, fr = lane & 15, fq = lane >> 4;
    const int K = g.K, nt = K / BK;
    unsigned voffA[2], voffB[2];
#pragma unroll
    for (int i = 0; i < 2; ++i) { int R, C; stage_rc(tid * 16 + i * 8192, R, C); const int Rb = Epi::PERM ? ((R & ~31) + perm32(R & 31)) : R;
        voffA[i] = (unsigned)(R * K + C) * 2u; voffB[i] = (unsigned)(Rb * K + C) * 2u; }
    const size_t kstep = (size_t)(BK * 2);
    const size_t hstep = (size_t)HALF * K * 2;
    const size_t tstep = 2 * hstep;
    const unsigned ldsw = (unsigned)wid * 1024u;
    const int aoff = lds_byte(wr * 64 + fr, fq * 8), boff = lds_byte(wc * 32 + fr, fq * 8);
#define PG8_SA(b, h) (((b) * 2 + (h)) * HTB)
#define PG8_SB(b, h) ((4 + (b) * 2 + (h)) * HTB)
#define PG8_STAGE(bufoff, gbase, voff) do { _Pragma("unroll") for (int _i = 0; _i < 2; ++_i) \
        __builtin_amdgcn_global_load_lds((const unsigned*)((const char*)(gbase) + (voff)[_i]), (PG8_LAS unsigned*)(lds + (bufoff) + ldsw + _i * 8192), 16, 0, 0); } while (0)
#define PG8_LDA(dst, b, h) do { _Pragma("unroll") for (int m = 0; m < 4; ++m) _Pragma("unroll") for (int k = 0; k < 2; ++k) dst[m][k] = *(const PG8_LAS bf16x8*)(lds + PG8_SA(b, h) + aoff + m * 2048 + k * 1024); } while (0)
#define PG8_LDB(dst, b, h) do { _Pragma("unroll") for (int n = 0; n < 2; ++n) _Pragma("unroll") for (int k = 0; k < 2; ++k) dst[n][k] = *(const PG8_LAS bf16x8*)(lds + PG8_SB(b, h) + boff + n * 2048 + k * 1024); } while (0)
#define PG8_MMA(ai, bj, At, Bt) do { __builtin_amdgcn_s_setprio(1); _Pragma("unroll") for (int m = 0; m < 4; ++m) _Pragma("unroll") for (int n = 0; n < 2; ++n) _Pragma("unroll") for (int k = 0; k < 2; ++k) \
        acc[ai][bj][m][n] = __builtin_amdgcn_mfma_f32_16x16x32_bf16(Bt[n][k], At[m][k], acc[ai][bj][m][n], 0, 0, 0); __builtin_amdgcn_s_setprio(0); } while (0)
#define PG8_WAIT_V(n) asm volatile("s_waitcnt vmcnt(" #n ")" ::: "memory")
#define PG8_WAIT_L(n) asm volatile("s_waitcnt lgkmcnt(" #n ")" ::: "memory")
#define PG8_BAR __builtin_amdgcn_s_barrier()
#define PG8_SCHED __builtin_amdgcn_sched_barrier(0)
    Unit cur, nxt; int ui = 0;
    if (!S.next(0, cur)) return;
    f32x4 acc[2][2][4][2];
#pragma unroll
    for (int a = 0; a < 2; ++a)
#pragma unroll
        for (int b = 0; b < 2; ++b)
#pragma unroll
            for (int m = 0; m < 4; ++m)
#pragma unroll
                for (int n = 0; n < 2; ++n) acc[a][b][m][n] = (f32x4){0.f, 0.f, 0.f, 0.f};
    bf16x8 At[4][2], B0[2][2], B1[2][2];
    const char* cA = (const char*)g.A + (size_t)cur.pm * tstep; const char* cB = (const char*)g.Bt + (size_t)cur.pn * tstep;
    S.a_ready(cur);
    float rv[8]; E.pre(rv, cur, wr, fr);
    if constexpr (SP2) {
        PG8_STAGE(PG8_SB(0, 0), cB, voffB); PG8_STAGE(PG8_SB(0, 1), cB + hstep, voffB); PG8_STAGE(PG8_SA(0, 0), cA, voffA); PG8_STAGE(PG8_SA(0, 1), cA + hstep, voffA);
        if (wr == 1) PG8_BAR;
        PG8_WAIT_V(2); PG8_BAR;
        PG8_STAGE(PG8_SB(1, 0), cB + kstep, voffB); PG8_STAGE(PG8_SA(1, 0), cA + kstep, voffA); PG8_STAGE(PG8_SB(1, 1), cB + hstep + kstep, voffB);
        PG8_WAIT_V(6); PG8_BAR;
    } else {
        PG8_STAGE(PG8_SB(0, 0), cB, voffB); PG8_STAGE(PG8_SA(0, 0), cA, voffA); PG8_STAGE(PG8_SB(0, 1), cB + hstep, voffB); PG8_STAGE(PG8_SA(0, 1), cA + hstep, voffA);
        if (wr == 1) PG8_BAR;
        PG8_WAIT_V(4); PG8_BAR;
        PG8_STAGE(PG8_SB(1, 0), cB + kstep, voffB); PG8_STAGE(PG8_SA(1, 0), cA + kstep, voffA); PG8_STAGE(PG8_SB(1, 1), cB + hstep + kstep, voffB);
        PG8_WAIT_V(6); PG8_BAR;
    }
    for (;;) {
        const bool has_next = S.next(ui + 1, nxt);
        const char* nA = has_next ? (const char*)g.A + (size_t)nxt.pm * tstep : cA; const char* nB = has_next ? (const char*)g.Bt + (size_t)nxt.pn * tstep : cB;
        for (int t = 0; t < nt; t += 2) {
            const bool last = (t == nt - 2);
            const char* a1 = cA + (size_t)(t + 1) * kstep;
            const char* a2 = last ? nA : cA + (size_t)(t + 2) * kstep; const char* b2 = last ? nB : cB + (size_t)(t + 2) * kstep;
            const char* a3 = a2 + kstep; const char* b3 = b2 + kstep;
            if (last && has_next) S.a_ready(nxt);
            if constexpr (SP2) {
            PG8_LDB(B0, 0, 0); PG8_LDB(B1, 0, 1); PG8_SCHED; PG8_LDA(At, 0, 0); PG8_STAGE(PG8_SA(1, 1), a1 + hstep, voffA);
            PG8_WAIT_V(8); PG8_WAIT_L(0); PG8_BAR; PG8_MMA(0, 0, At, B0); PG8_MMA(0, 1, At, B1); PG8_BAR; PG8_SCHED;
            PG8_LDA(At, 0, 1); PG8_STAGE(PG8_SB(0, 0), b2, voffB); PG8_STAGE(PG8_SB(0, 1), b2 + hstep, voffB); PG8_STAGE(PG8_SA(0, 0), a2, voffA);
            PG8_WAIT_V(8); PG8_WAIT_L(0); PG8_BAR; PG8_MMA(1, 0, At, B0); PG8_MMA(1, 1, At, B1); PG8_BAR; PG8_SCHED;
            PG8_LDB(B0, 1, 0); PG8_LDB(B1, 1, 1); PG8_SCHED; PG8_LDA(At, 1, 0); PG8_STAGE(PG8_SA(0, 1), a2 + hstep, voffA);
            PG8_WAIT_V(8); PG8_WAIT_L(0); PG8_BAR; PG8_MMA(0, 0, At, B0); PG8_MMA(0, 1, At, B1); PG8_BAR; PG8_SCHED;
            PG8_LDA(At, 1, 1); PG8_STAGE(PG8_SB(1, 0), b3, voffB); PG8_STAGE(PG8_SB(1, 1), b3 + hstep, voffB); PG8_STAGE(PG8_SA(1, 0), a3, voffA);
            PG8_WAIT_V(8); PG8_WAIT_L(0); PG8_BAR; PG8_MMA(1, 0, At, B0); PG8_MMA(1, 1, At, B1); PG8_BAR; PG8_SCHED;
            } else {
            PG8_LDB(B0, 0, 0); PG8_SCHED; PG8_LDA(At, 0, 0); PG8_STAGE(PG8_SA(1, 1), a1 + hstep, voffA);
            PG8_WAIT_L(8); PG8_BAR; PG8_WAIT_L(0); PG8_MMA(0, 0, At, B0); PG8_BAR; PG8_SCHED;
            PG8_LDB(B1, 0, 1); PG8_STAGE(PG8_SB(0, 0), b2, voffB);
            PG8_BAR; PG8_WAIT_L(0); PG8_MMA(0, 1, At, B1); PG8_BAR;
            PG8_LDA(At, 0, 1); PG8_STAGE(PG8_SA(0, 0), a2, voffA);
            PG8_BAR; PG8_WAIT_L(0); PG8_MMA(1, 0, At, B0); PG8_BAR; PG8_SCHED;
            PG8_STAGE(PG8_SB(0, 1), b2 + hstep, voffB);
            PG8_WAIT_V(6); PG8_BAR; PG8_MMA(1, 1, At, B1); PG8_BAR;
            PG8_LDB(B0, 1, 0); PG8_SCHED; PG8_LDA(At, 1, 0); PG8_STAGE(PG8_SA(0, 1), a2 + hstep, voffA);
            PG8_WAIT_L(8); PG8_BAR; PG8_WAIT_L(0); PG8_MMA(0, 0, At, B0); PG8_BAR; PG8_SCHED;
            PG8_LDB(B1, 1, 1); PG8_STAGE(PG8_SB(1, 0), b3, voffB);
            PG8_BAR; PG8_WAIT_L(0); PG8_MMA(0, 1, At, B1); PG8_BAR;
            PG8_LDA(At, 1, 1); PG8_STAGE(PG8_SA(1, 0), a3, voffA);
            PG8_BAR; PG8_WAIT_L(0); PG8_MMA(1, 0, At, B0); PG8_BAR; PG8_SCHED;
            PG8_STAGE(PG8_SB(1, 1), b3 + hstep, voffB);
            PG8_WAIT_V(6); PG8_BAR; PG8_MMA(1, 1, At, B1); PG8_BAR;
            }
        }
        if constexpr (ALIGN_EPI) { if (wr == 0) PG8_BAR; }
        if constexpr (!Epi::AFTER_DRAIN) { E(acc, rv, cur, wr, wc, fr, fq); S.done(cur); }
        if (!has_next) break;
#pragma unroll
        for (int a = 0; a < 2; ++a)
#pragma unroll
            for (int b = 0; b < 2; ++b)
#pragma unroll
                for (int m = 0; m < 4; ++m)
#pragma unroll
                    for (int n = 0; n < 2; ++n) acc[a][b][m][n] = (f32x4){0.f, 0.f, 0.f, 0.f};
        cur = nxt; cA = nA; cB = nB; ++ui;
        E.pre(rv, cur, wr, fr);
        if constexpr (ALIGN_EPI) { if (wr == 1) PG8_BAR; }
    }
    PG8_WAIT_V(0);
    if constexpr (!ALIGN_EPI) { if (wr == 0) PG8_BAR; }
    PG8_BAR;
    if constexpr (Epi::AFTER_DRAIN) { E.fused(acc, cur, wr, wc, fr, fq, lds, wid, lane); S.done(cur); }
#undef PG8_SA
#undef PG8_SB
#undef PG8_STAGE
#undef PG8_LDA
#undef PG8_LDB
#undef PG8_MMA
#undef PG8_WAIT_V
#undef PG8_WAIT_L
#undef PG8_BAR
#undef PG8_SCHED
}
}
typedef unsigned short bf16;
typedef float f32x4 __attribute__((ext_vector_type(4)));
typedef unsigned u32x4 __attribute__((ext_vector_type(4)));
typedef unsigned u32x2 __attribute__((ext_vector_type(2)));
constexpr int BATCH = 2, SEQ = 16384, DM = 2048, DEPTH = 4, M = BATCH * SEQ, DFF = 8192, PLE = 256;
constexpr int EV_IN = 5136, EV_INP = 5376, OD_IN = 6432, OD_INP = 6656;
constexpr int EZ_Q = 512, EZ_K = 1280, EZ_V = 2048, EZ_G = 3584, EZ_R = 5120;
constexpr int OZ_HW = 3072, OZ_HA = 3136, OZ_HG = 3200, OZ_DQ = 3360, OZ_DK = 4384, OZ_DV = 5408;
constexpr size_t MiB = 1u << 20;
constexpr size_t WS_CTL = 0, WS_WIN = 1 * MiB, WS_WOUT = 27 * MiB, WS_WUP = 35 * MiB, WS_WDN = 67 * MiB, WS_WGT = 99 * MiB, WS_WPJ = 107 * MiB;
constexpr size_t WS_H = 110 * MiB, WS_XB = 238 * MiB  , WS_MIX = 366 * MiB, WS_PB = 494 * MiB, WS_Z = 510 * MiB, WS_HID = 510 * MiB;
constexpr size_t WS_SMALL = 108 * MiB, WS_ML = 1184 * MiB, WS_DEC = 1136 * MiB, WS_T_EV = 846 * MiB, WS_T_OD = 926 * MiB, WS_NEED = 1200 * MiB;
constexpr size_t SLOT = 64 * MiB;

typedef float f32x2_t_ __attribute__((ext_vector_type(2))); typedef __bf16 bf16x2_t_ __attribute__((ext_vector_type(2)));
__device__ __forceinline__ unsigned f2bf(float f) { return (unsigned)__builtin_bit_cast(unsigned short, (__bf16)f); }
__device__ __forceinline__ unsigned pk2(float lo, float hi) { const f32x2_t_ v = {lo, hi}; return __builtin_bit_cast(unsigned, __builtin_convertvector(v, bf16x2_t_)); }
__device__ __forceinline__ float bf2f(bf16 h) { return __uint_as_float((unsigned)h << 16); }
__device__ __forceinline__ float bflo_(unsigned w) { return __uint_as_float(w << 16); }
__device__ __forceinline__ float bfhi_(unsigned w) { return __uint_as_float(w & 0xffff0000u); }
__device__ __forceinline__ float wave_sum(float v) {
#pragma unroll
    for (int o = 1; o < 64; o <<= 1) v += __shfl_xor(v, o);
    return v;
}
__device__ __forceinline__ float sigmoidf_(float x) { return 1.f / (1.f + __expf(-x)); }
__device__ __forceinline__ float softplusf_(float x) { return fmaxf(x, 0.f) + __logf(1.f + __expf(-fabsf(x))); }

#ifndef LAS
#define LAS __attribute__((address_space(3)))
#endif
typedef LAS unsigned char lds_t;
typedef short bf16x8 __attribute__((ext_vector_type(8)));
typedef short s16x4 __attribute__((ext_vector_type(4)));
typedef short v4i16_t __attribute__((ext_vector_type(4)));
__device__ __forceinline__ s16x4 vtr(const lds_t* p) { return __builtin_bit_cast(s16x4, __builtin_amdgcn_ds_read_tr16_b64_v4i16((LAS v4i16_t*)p)); }
__device__ __forceinline__ bf16x8 cat8(s16x4 a, s16x4 b) { bf16x8 r; r[0] = a[0]; r[1] = a[1]; r[2] = a[2]; r[3] = a[3]; r[4] = b[0]; r[5] = b[1]; r[6] = b[2]; r[7] = b[3]; return r; }
#define LBAR() do { asm volatile("s_waitcnt lgkmcnt(0)" ::: "memory"); __builtin_amdgcn_s_barrier(); asm volatile("" ::: "memory"); } while (0)
__device__ __forceinline__ f32x4 mfma16(bf16x8 a, bf16x8 b, f32x4 c) { return __builtin_amdgcn_mfma_f32_16x16x32_bf16(a, b, c, 0, 0, 0); }
__device__ __forceinline__ u32x2 pack4(f32x4 v) { u32x2 o; o.x = pk2(v[0], v[1]); o.y = pk2(v[2], v[3]); return o; }
__device__ __forceinline__ f32x4 unpack4(u32x2 w) { f32x4 v; v[0] = __uint_as_float(w.x << 16); v[1] = __uint_as_float(w.x & 0xffff0000u); v[2] = __uint_as_float(w.y << 16); v[3] = __uint_as_float(w.y & 0xffff0000u); return v; }
constexpr int NCHUNK = SEQ / 64;
constexpr int GLA_UNITS = BATCH * 4 * NCHUNK;

__device__ __forceinline__ void ph_pool(lds_t* lds, int vcu, int G, const bf16* __restrict__ Z, const float* __restrict__ pw, const float* __restrict__ ps, bf16* __restrict__ MIX) {
    const int tid = opq_((int)threadIdx.x), wid = tid >> 6, lane = tid & 63, fr = lane & 15, fq = lane >> 4;
    constexpr int WST = 136;
    for (int u = vcu; u < M / 128; u += G) {
        const int m = u * 128 + wid * 16 + fr, t = m % SEQ;
        for (int g = 0; g < 4; ++g) {
            __syncthreads();
            { float sw[32];
#pragma unroll
              for (int i = 0; i < 32; ++i) sw[i] = pw[(size_t)g * 16384 + tid + 512 * i];
#pragma unroll
              for (int i = 0; i < 32; ++i) { const int idx = tid + 512 * i, c = idx >> 7, d = idx & 127; ((LAS bf16*)lds)[d * WST + c] = (bf16)f2bf(sw[i]); } }
            __syncthreads();
            const int w = 2 << g, cnt = (t + 1 < w) ? (t + 1) : w; const float icnt = 1.0f / (float)cnt;
            f32x4 acc[8];
#pragma unroll
            for (int dt = 0; dt < 8; ++dt) acc[dt] = (f32x4){0.f, 0.f, 0.f, 0.f};
#pragma unroll
            for (int ks = 0; ks < 4; ++ks) {
                const bf16* zp = Z + (size_t)m * EV_INP + g * 128 + 32 * ks + 8 * fq;
                float s[8], own[8];
                { const u32x4 r = *(const u32x4*)zp; own[0] = bflo_(r.x); own[1] = bfhi_(r.x); own[2] = bflo_(r.y); own[3] = bfhi_(r.y); own[4] = bflo_(r.z); own[5] = bfhi_(r.z); own[6] = bflo_(r.w); own[7] = bfhi_(r.w); }
#pragma unroll
                for (int e = 0; e < 8; ++e) s[e] = own[e];
#pragma unroll 7
                for (int j = 1; j < w; ++j) { const float mk = (j < cnt) ? 1.f : 0.f; const u32x4 r = *(const u32x4*)(zp - (size_t)(j < cnt ? j : 0) * EV_INP);
                    s[0] += mk * bflo_(r.x); s[1] += mk * bfhi_(r.x); s[2] += mk * bflo_(r.y); s[3] += mk * bfhi_(r.y); s[4] += mk * bflo_(r.z); s[5] += mk * bfhi_(r.z); s[6] += mk * bflo_(r.w); s[7] += mk * bfhi_(r.w); }
                u32x4 pk; pk.x = pk2(s[0] * icnt - own[0], s[1] * icnt - own[1]); pk.y = pk2(s[2] * icnt - own[2], s[3] * icnt - own[3]);
                pk.z = pk2(s[4] * icnt - own[4], s[5] * icnt - own[5]); pk.w = pk2(s[6] * icnt - own[6], s[7] * icnt - own[7]);
                const bf16x8 bfrag = __builtin_bit_cast(bf16x8, pk);
#pragma unroll
                for (int dt = 0; dt < 8; ++dt) { const bf16x8 afrag = *(const LAS bf16x8*)(lds + ((16 * dt + fr) * WST + 32 * ks + 8 * fq) * 2); acc[dt] = mfma16(afrag, bfrag, acc[dt]); }
            }
#pragma unroll
            for (int dt = 0; dt < 8; ++dt) { const int d = 16 * dt + 4 * fq; const f32x4 sc = *(const f32x4*)(ps + g * 128 + d);
                *(u32x2*)(MIX + (size_t)m * DM + g * 128 + d) = pack4(acc[dt] * sc); }
        }
    }
}
constexpr int G1_QT = 0, G1_KT = 25600, G1_KH = 51200, G1_VT = 76800, G1_SCR = 126976, G1_LDS = 145664;
constexpr int G1_W2 = G1_SCR, G1_BIAS = G1_SCR + 12288, G1_GLR = G1_BIAS + 768, G1_TOT = G1_GLR + 4096, G1_AT = G1_SCR;
constexpr int QST = 400, VST = 784, AST = 144;
template <bool FRONT> __device__ __forceinline__ void ph_gla1(lds_t* lds, int vcu, int G, const bf16* __restrict__ Z, const float* __restrict__ w2, const float* __restrict__ gb, bf16* __restrict__ OI, bf16* __restrict__ QG, bf16* __restrict__ ST, float* __restrict__ DEC) {
    const float scale = 0.07216878364870323f;
    for (int u = vcu; u < GLA_UNITS; u += G) {
        const int tid = opq_((int)threadIdx.x), wid = tid >> 6, lane = tid & 63, fr = lane & 15, fq = lane >> 4, lq = fr >> 2, lp = fr & 3;
        const int b = u / (4 * NCHUNK), h = (u / NCHUNK) & 3, n = u % NCHUNK; const size_t m0 = (size_t)b * SEQ + (size_t)n * 64;
        __syncthreads();
        { u32x4 sv[6], sq[3], sk[3]; float sw[6]; bf16 sg[2]; float sb = 0.f;
#pragma unroll
          for (int i = 0; i < 3; ++i) { const int q = tid + 512 * i, row = q / 24, cc = q % 24; sq[i] = *(const u32x4*)(Z + (m0 + row) * EV_INP + EZ_Q + h * 192 + cc * 8); sk[i] = *(const u32x4*)(Z + (m0 + row) * EV_INP + EZ_K + h * 192 + cc * 8); }
#pragma unroll
          for (int i = 0; i < 6; ++i) { const int q = tid + 512 * i, row = q / 48, cc = q % 48; sv[i] = *(const u32x4*)(Z + (m0 + row) * EV_INP + EZ_V + h * 384 + cc * 8); }
#pragma unroll
          for (int i = 0; i < 6; ++i) { const int q = tid + 512 * i, r = q / 192, d = q % 192; sw[i] = w2[r * 768 + h * 192 + d]; }
          if (tid < 192) sb = gb[h * 192 + tid];
#pragma unroll
          for (int i = 0; i < 2; ++i) { const int q = tid + 512 * i, row = q >> 4, r = q & 15; sg[i] = Z[(m0 + row) * EV_INP + EZ_R + r]; }
#pragma unroll
          for (int i = 0; i < 6; ++i) { const int q = tid + 512 * i, row = q / 48, cc = q % 48; *(LAS u32x4*)(lds + G1_VT + row * VST + cc * 16) = sv[i]; }
#pragma unroll
          for (int i = 0; i < 3; ++i) { const int q = tid + 512 * i, row = q / 24, cc = q % 24; *(LAS u32x4*)(lds + G1_QT + row * QST + cc * 16) = sq[i]; *(LAS u32x4*)(lds + G1_KT + row * QST + cc * 16) = sk[i]; }
#pragma unroll
          for (int i = 0; i < 6; ++i) ((LAS float*)(lds + G1_W2))[tid + 512 * i] = sw[i];
          if (tid < 192) ((LAS float*)(lds + G1_BIAS))[tid] = sb;
#pragma unroll
          for (int i = 0; i < 2; ++i) ((LAS float*)(lds + G1_GLR))[tid + 512 * i] = bf2f(sg[i]); }
        __syncthreads();
        float lg[3][8];
#pragma unroll
        for (int k = 0; k < 3; ++k) { const int task = tid + 512 * k, d = task % 192, seg = task / 192;
            float wc[16];
#pragma unroll
            for (int r = 0; r < 16; ++r) wc[r] = ((LAS float*)(lds + G1_W2))[r * 192 + d];
            const float b0 = ((LAS float*)(lds + G1_BIAS))[d]; float run = 0.f;
#pragma unroll
            for (int s = 0; s < 8; ++s) { const LAS f32x4* gp = (const LAS f32x4*)(lds + G1_GLR + (seg * 8 + s) * 64); float x = b0;
#pragma unroll
                for (int r4 = 0; r4 < 4; ++r4) { const f32x4 g4 = gp[r4]; x += g4[0] * wc[4 * r4] + g4[1] * wc[4 * r4 + 1] + g4[2] * wc[4 * r4 + 2] + g4[3] * wc[4 * r4 + 3]; }
                lg[k][s] = -softplusf_(-x) * (1.0f / 16.0f); run += lg[k][s]; }
            ((LAS float*)(lds + G1_TOT))[seg * 192 + d] = run; }
        __syncthreads();
#pragma unroll
        for (int k = 0; k < 3; ++k) { const int task = tid + 512 * k, d = task % 192, seg = task / 192;
            float run = 0.f, blast = 0.f;
#pragma unroll
            for (int j = 0; j < 8; ++j) { const float tj = ((LAS float*)(lds + G1_TOT))[j * 192 + d]; blast += tj; run += (j < seg) ? tj : 0.f; }
            const float eb = __expf(blast);
            if (seg == 0) DEC[(size_t)u * 192 + d] = eb;
#pragma unroll
            for (int s = 0; s < 8; ++s) { const int t = seg * 8 + s;
                run += lg[k][s]; const float bb = run; const float en = __expf(-bb);
                const float qv = bf2f(*(const LAS bf16*)(lds + G1_QT + t * QST + d * 2)), kv = bf2f(*(const LAS bf16*)(lds + G1_KT + t * QST + d * 2));
                *(LAS bf16*)(lds + G1_QT + t * QST + d * 2) = (bf16)f2bf(qv * scale * __expf(bb));
                *(LAS bf16*)(lds + G1_KT + t * QST + d * 2) = (bf16)f2bf(kv * en);
                *(LAS bf16*)(lds + G1_KH + t * QST + d * 2) = (bf16)f2bf(kv * (eb * en)); } }
        __syncthreads();
        if (FRONT) continue;
        { const int it = wid >> 1;
#pragma unroll
            for (int jj = 0; jj < 2; ++jj) { const int jt = 2 * (wid & 1) + jj; f32x4 acc = (f32x4){0.f, 0.f, 0.f, 0.f};
                if (jt <= it) {
#pragma unroll
                    for (int ks = 0; ks < 6; ++ks) { const bf16x8 a = *(const LAS bf16x8*)(lds + G1_QT + (16 * it + fr) * QST + (32 * ks + 8 * fq) * 2);
                        const bf16x8 bb = *(const LAS bf16x8*)(lds + G1_KT + (16 * jt + fr) * QST + (32 * ks + 8 * fq) * 2); acc = mfma16(a, bb, acc); } }
#pragma unroll
                for (int r = 0; r < 4; ++r) { const int i = 16 * it + 4 * fq + r, j = 16 * jt + fr; const float v = (j <= i) ? acc[r] : 0.f;
                    *(LAS bf16*)(lds + G1_AT + i * AST + j * 2) = (bf16)f2bf(v); } } }
        __syncthreads();
#pragma unroll
        for (int i = 0; i < 3; ++i) { const int q = tid + 512 * i, row = q / 24, cc = q % 24;
            *(u32x4*)(QG + (m0 + row) * 768 + h * 192 + cc * 8) = *(const LAS u32x4*)(lds + G1_QT + row * QST + cc * 16); }
        bf16x8 vf[3][2];
#pragma unroll
        for (int el = 0; el < 3; ++el)
#pragma unroll
            for (int ks = 0; ks < 2; ++ks) { const lds_t* p = lds + G1_VT + (32 * ks + 8 * fq + lq) * VST + (16 * (3 * wid + el) + 4 * lp) * 2; vf[el][ks] = cat8(vtr(p), vtr(p + 4 * VST)); }
        { f32x4 acc[3][4];
#pragma unroll
            for (int el = 0; el < 3; ++el)
#pragma unroll
                for (int it = 0; it < 4; ++it) acc[el][it] = (f32x4){0.f, 0.f, 0.f, 0.f};
#pragma unroll
            for (int ks = 0; ks < 2; ++ks)
#pragma unroll
                for (int it = 0; it < 4; ++it) { const bf16x8 bb = *(const LAS bf16x8*)(lds + G1_AT + (16 * it + fr) * AST + (32 * ks + 8 * fq) * 2);
#pragma unroll
                    for (int el = 0; el < 3; ++el) acc[el][it] = mfma16(vf[el][ks], bb, acc[el][it]); }
#pragma unroll
            for (int el = 0; el < 3; ++el)
#pragma unroll
                for (int it = 0; it < 4; ++it) *(u32x2*)(OI + (m0 + 16 * it + fr) * 1536 + h * 384 + 16 * (3 * wid + el) + 4 * fq) = pack4(acc[el][it]); }
        asm volatile("s_waitcnt lgkmcnt(0)" ::: "memory"); __builtin_amdgcn_s_barrier(); asm volatile("" ::: "memory");
        { lds_t* zt = lds + G1_QT + wid * 6144;
#pragma unroll 1
          for (int part = 0; part < 3; ++part) { f32x4 acc[4][3];
#pragma unroll
            for (int dl = 0; dl < 4; ++dl)
#pragma unroll
                for (int el = 0; el < 3; ++el) acc[dl][el] = (f32x4){0.f, 0.f, 0.f, 0.f};
#pragma unroll
            for (int ks = 0; ks < 2; ++ks)
#pragma unroll
                for (int dl = 0; dl < 4; ++dl) { const lds_t* p = lds + G1_KH + (32 * ks + 8 * fq + lq) * QST + (16 * (4 * part + dl) + 4 * lp) * 2; const bf16x8 a = cat8(vtr(p), vtr(p + 4 * QST));
#pragma unroll
                    for (int el = 0; el < 3; ++el) acc[dl][el] = mfma16(a, vf[el][ks], acc[dl][el]); }
#pragma unroll
            for (int dl = 0; dl < 4; ++dl)
#pragma unroll
                for (int el = 0; el < 3; ++el) { const int e = 16 * el + fr, c = 2 * dl + (fq >> 1); *(LAS u32x2*)(zt + e * 128 + ((c ^ (e & 7)) << 4) + (fq & 1) * 8) = pack4(acc[dl][el]); }
            asm volatile("s_waitcnt lgkmcnt(0)" ::: "memory");
#pragma unroll
            for (int i = 0; i < 6; ++i) { const int idx = lane + 64 * i, e = idx >> 3, c = idx & 7;
                *(u32x4*)(ST + ((size_t)u * 384 + 48 * wid + e) * 192 + 64 * part + 8 * c) = *(const LAS u32x4*)(zt + e * 128 + ((c ^ (e & 7)) << 4)); }
            asm volatile("s_waitcnt lgkmcnt(0)" ::: "memory"); } }
    }
}
__device__ __forceinline__ void ph_gla2(int vcu, int G, bf16* ST, const float* __restrict__ DEC) {
    const int g = vcu * 512 + opq_((int)threadIdx.x);
    if (g < 8 * 384 * 24) {
    const int bh = g / 9216, rem = g % 9216, e = rem / 24, d8 = rem % 24;
    float S[8];
#pragma unroll
    for (int i = 0; i < 8; ++i) S[i] = 0.f;
    for (int n0 = 0; n0 < NCHUNK; n0 += 8) {
        u32x4 zin[8]; f32x4 dc[8][2];
#pragma unroll
        for (int k = 0; k < 8; ++k) { const size_t un = (size_t)bh * NCHUNK + n0 + k; zin[k] = *(const u32x4*)(ST + (un * 384 + e) * 192 + 8 * d8);
            dc[k][0] = *(const f32x4*)(DEC + un * 192 + 8 * d8); dc[k][1] = *(const f32x4*)(DEC + un * 192 + 8 * d8 + 4); }
#pragma unroll
        for (int k = 0; k < 8; ++k) { const size_t un = (size_t)bh * NCHUNK + n0 + k;
            u32x4 o; o.x = pk2(S[0], S[1]); o.y = pk2(S[2], S[3]); o.z = pk2(S[4], S[5]); o.w = pk2(S[6], S[7]);
            *(u32x4*)(ST + (un * 384 + e) * 192 + 8 * d8) = o;
            S[0] = S[0] * dc[k][0][0] + bflo_(zin[k].x); S[1] = S[1] * dc[k][0][1] + bfhi_(zin[k].x); S[2] = S[2] * dc[k][0][2] + bflo_(zin[k].y); S[3] = S[3] * dc[k][0][3] + bfhi_(zin[k].y);
            S[4] = S[4] * dc[k][1][0] + bflo_(zin[k].z); S[5] = S[5] * dc[k][1][1] + bfhi_(zin[k].z); S[6] = S[6] * dc[k][1][2] + bflo_(zin[k].w); S[7] = S[7] * dc[k][1][3] + bfhi_(zin[k].w); }
    }
    }
}
__device__ __forceinline__ void ph_gla3(lds_t* lds, int vcu, int G, const bf16* __restrict__ Z, const bf16* __restrict__ ST, const float* __restrict__ gn, const bf16* __restrict__ OI, const bf16* __restrict__ QG, bf16* __restrict__ MIX) {
    constexpr int OST = 1568;
    constexpr int QL_OFF = 64 * OST, QL_ST = 400;
    bf16x8 afr[6][3]; u32x4 sq[3];
#define GLA3_PF(uu) do { const int t_ = opq_((int)threadIdx.x), w_ = t_ >> 6, l_ = t_ & 63; const int hq_ = ((uu) / NCHUNK) & 3; const size_t mq_ = (size_t)((uu) / (4 * NCHUNK)) * SEQ + (size_t)((uu) % NCHUNK) * 64; \
        _Pragma("unroll") for (int ks = 0; ks < 6; ++ks) _Pragma("unroll") for (int el = 0; el < 3; ++el) afr[ks][el] = *(const bf16x8*)(ST + ((size_t)(uu) * 384 + 16 * (3 * w_ + el) + (l_ & 15)) * 192 + 32 * ks + 8 * (l_ >> 4)); \
        _Pragma("unroll") for (int i = 0; i < 3; ++i) { const int q = t_ + 512 * i, row = q / 24, cc = q % 24; sq[i] = *(const u32x4*)(QG + (mq_ + row) * 768 + hq_ * 192 + cc * 8); } } while (0)
    if (vcu < GLA_UNITS) GLA3_PF(vcu);
    for (int u = vcu; u < GLA_UNITS; u += G) {
        const int tid = opq_((int)threadIdx.x), wid = tid >> 6, lane = tid & 63, fr = lane & 15, fq = lane >> 4;
        const int b = u / (4 * NCHUNK), h = (u / NCHUNK) & 3, n = u % NCHUNK; const size_t m0 = (size_t)b * SEQ + (size_t)n * 64;
        const int le = lane < 48 ? lane : 47; const bool act = lane < 48; const int e0 = 8 * le;
        u32x4 oiw[8], gow[8];
#pragma unroll
        for (int t = 0; t < 8; ++t) { const size_t m = m0 + 8 * wid + t; oiw[t] = *(const u32x4*)(OI + m * 1536 + h * 384 + e0); gow[t] = *(const u32x4*)(Z + m * EV_INP + EZ_G + h * 384 + e0); }
        f32x4 acc[3][4];
#pragma unroll
        for (int el = 0; el < 3; ++el)
#pragma unroll
            for (int it = 0; it < 4; ++it) acc[el][it] = (f32x4){0.f, 0.f, 0.f, 0.f};
        LBAR();
#pragma unroll
        for (int i = 0; i < 3; ++i) { const int q = tid + 512 * i, row = q / 24, cc = q % 24; *(LAS u32x4*)(lds + QL_OFF + row * QL_ST + cc * 16) = sq[i]; }
        LBAR();
#pragma unroll
        for (int ks = 0; ks < 6; ++ks) { bf16x8 bb[4];
#pragma unroll
            for (int it = 0; it < 4; ++it) bb[it] = *(const LAS bf16x8*)(lds + QL_OFF + (16 * it + fr) * QL_ST + (32 * ks + 8 * fq) * 2);
#pragma unroll
            for (int el = 0; el < 3; ++el)
#pragma unroll
                for (int it = 0; it < 4; ++it) acc[el][it] = mfma16(afr[ks][el], bb[it], acc[el][it]); }
#pragma unroll
        for (int el = 0; el < 3; ++el)
#pragma unroll
            for (int it = 0; it < 4; ++it) *(LAS f32x4*)(lds + (16 * it + fr) * OST + (16 * (3 * wid + el) + 4 * fq) * 4) = acc[el][it];
        LBAR();
        if (u + G < GLA_UNITS) GLA3_PF(u + G);
        const f32x4 g0 = *(const f32x4*)(gn + e0), g1 = *(const f32x4*)(gn + e0 + 4);
#pragma unroll
        for (int t = 0; t < 8; ++t) { const int tok = 8 * wid + t; const LAS f32x4* op = (const LAS f32x4*)(lds + tok * OST + e0 * 4); f32x4 o0 = op[0], o1 = op[1];
            o0[0] += bflo_(oiw[t].x); o0[1] += bfhi_(oiw[t].x); o0[2] += bflo_(oiw[t].y); o0[3] += bfhi_(oiw[t].y); o1[0] += bflo_(oiw[t].z); o1[1] += bfhi_(oiw[t].z); o1[2] += bflo_(oiw[t].w); o1[3] += bfhi_(oiw[t].w);
            float ss = act ? ((o0[0] * o0[0] + o0[1] * o0[1]) + (o0[2] * o0[2] + o0[3] * o0[3])) + ((o1[0] * o1[0] + o1[1] * o1[1]) + (o1[2] * o1[2] + o1[3] * o1[3])) : 0.f;
            ss = wave_sum(ss); const float rstd = 1.0f / sqrtf(ss * (1.0f / 384.0f) + 1e-6f);
            f32x4 q0, q1; q0[0] = bflo_(gow[t].x); q0[1] = bfhi_(gow[t].x); q0[2] = bflo_(gow[t].y); q0[3] = bfhi_(gow[t].y); q1[0] = bflo_(gow[t].z); q1[1] = bfhi_(gow[t].z); q1[2] = bflo_(gow[t].w); q1[3] = bfhi_(gow[t].w);
            u32x4 w;
            w.x = pk2(o0[0] * rstd * g0[0] * (q0[0] * sigmoidf_(q0[0])), o0[1] * rstd * g0[1] * (q0[1] * sigmoidf_(q0[1]))); w.y = pk2(o0[2] * rstd * g0[2] * (q0[2] * sigmoidf_(q0[2])), o0[3] * rstd * g0[3] * (q0[3] * sigmoidf_(q0[3])));
            w.z = pk2(o1[0] * rstd * g1[0] * (q1[0] * sigmoidf_(q1[0])), o1[1] * rstd * g1[1] * (q1[1] * sigmoidf_(q1[1]))); w.w = pk2(o1[2] * rstd * g1[2] * (q1[2] * sigmoidf_(q1[2])), o1[3] * rstd * g1[3] * (q1[3] * sigmoidf_(q1[3])));
            if (act) *(u32x4*)(MIX + (m0 + tok) * DM + 512 + h * 384 + e0) = w; }
    }
#undef GLA3_PF
}

struct RwkvP { const float *mu, *w0, *w2, *a0, *a2, *g2, *kk, *ka, *rk, *lnw, *lnb; };
struct RwkvW { const bf16 *W2T, *A2T, *G2T; };
struct RwkvB { bf16 *R, *LD, *KM, *V, *KK, *BV, *G, *Y; float* BON; };
constexpr int ACT_ST = 656, PRM_OFF = 64 * 656, AS_OFF = PRM_OFF + 32768, AS_ST = 144, AS_WAVE = 64 * AS_ST;
__device__ __forceinline__ f32x4 prm4(const lds_t* lds, int which, int c) { return *(const LAS f32x4*)(lds + PRM_OFF + (which * 1024 + c) * 4); }
__device__ __forceinline__ f32x4 tshL(u32x2 cur, u32x2 prev, f32x4 mu4, bool hp) { const f32x4 c = unpack4(cur); const f32x4 p = unpack4(prev) * (hp ? 1.f : 0.f); return c + (p - c) * mu4; }
constexpr int ACT_ST_unused = 0;
__device__ __forceinline__ f32x4 tsh4(const bf16* zc, bool hasprev, int col, const float* __restrict__ mu) {
    const f32x4 c = unpack4(*(const u32x2*)(zc + col));
    const f32x4 p = unpack4(*(const u32x2*)(zc - (hasprev ? OD_INP : 0) + col)) * (hasprev ? 1.f : 0.f);
    const f32x4 m4 = *(const f32x4*)(mu + col); return c + (p - c) * m4;
}
template <int PASS> __device__ __forceinline__ void rwkv_prep_pass(lds_t* lds, size_t m0, const bf16* __restrict__ Z, const RwkvP& P, const RwkvW& W, const RwkvB& B) {
    const int tid = opq_((int)threadIdx.x), wid = tid >> 6, lane = tid & 63, fr = lane & 15, fq = lane >> 4;
    constexpr int NKS = (PASS == 2) ? 6 : 2; constexpr int WST = (PASS == 2) ? 192 : 64; constexpr int COFF = (PASS == 0) ? 0 : (PASS == 1 ? 64 : 128);
    const bf16* Wt = (PASS == 0) ? W.W2T : (PASS == 1 ? W.A2T : W.G2T);
#pragma unroll 1
    for (int hh = 0; hh < 2; ++hh) {
        const int cb = 128 * wid + 64 * hh;
        f32x4 acc[4][4];
#pragma unroll
        for (int ct = 0; ct < 4; ++ct)
#pragma unroll
            for (int tt = 0; tt < 4; ++tt) acc[ct][tt] = (f32x4){0.f, 0.f, 0.f, 0.f};
        bf16x8 wa[NKS][4];
#pragma unroll
        for (int ks = 0; ks < NKS; ++ks)
#pragma unroll
            for (int ct = 0; ct < 4; ++ct) wa[ks][ct] = *(const bf16x8*)(Wt + (size_t)(cb + 16 * ct + fr) * WST + 32 * ks + 8 * fq);
#pragma unroll
        for (int ks = 0; ks < NKS; ++ks) { bf16x8 bb[4];
#pragma unroll
            for (int tt = 0; tt < 4; ++tt) bb[tt] = *(const LAS bf16x8*)(lds + (16 * tt + fr) * ACT_ST + (COFF + 32 * ks + 8 * fq) * 2);
#pragma unroll
            for (int ct = 0; ct < 4; ++ct)
#pragma unroll
                for (int tt = 0; tt < 4; ++tt) acc[ct][tt] = mfma16(wa[ks][ct], bb[tt], acc[ct][tt]); }
        if constexpr (PASS == 0 || PASS == 2) {
            lds_t* as_ = lds + AS_OFF + wid * AS_WAVE;
#pragma unroll
            for (int ct = 0; ct < 4; ++ct) { const int c = cb + 16 * ct + 4 * fq; const f32x4 w0 = prm4(lds, 7, c);
#pragma unroll
                for (int tt = 0; tt < 4; ++tt) { f32x4 o = acc[ct][tt];
                    if (PASS == 0) {
#pragma unroll
                        for (int e = 0; e < 4; ++e) { const float dw = acc[ct][tt][e] + w0[e]; o[e] = -__expf(-softplusf_(-dw) - 0.5f); } }
                    *(LAS u32x2*)(as_ + (16 * tt + fr) * AS_ST + (16 * ct + 4 * fq) * 2) = pack4(o); } }
            asm volatile("s_waitcnt lgkmcnt(0)" ::: "memory");
            bf16* dst = (PASS == 0) ? B.LD : B.G; const int ch8 = lane & 7, tg = lane >> 3;
#pragma unroll
            for (int i = 0; i < 8; ++i) { const int tok = tg + 8 * i; *(u32x4*)(dst + (m0 + tok) * 1024 + cb + 8 * ch8) = *(const LAS u32x4*)(as_ + tok * AS_ST + ch8 * 16); }
            asm volatile("s_waitcnt lgkmcnt(0)" ::: "memory");
        } else {
            lds_t* as_ = lds + AS_OFF + wid * AS_WAVE;
#pragma unroll
            for (int ct = 0; ct < 4; ++ct) { const f32x4 a0 = prm4(lds, 4, cb + 16 * ct + 4 * fq);
#pragma unroll
                for (int tt = 0; tt < 4; ++tt) { const f32x4 v = acc[ct][tt] + a0; const u32x2 w = pack4((f32x4){sigmoidf_(v[0]), sigmoidf_(v[1]), sigmoidf_(v[2]), sigmoidf_(v[3])});
                    *(LAS u32x2*)(as_ + (16 * tt + fr) * AS_ST + (16 * ct + 4 * fq) * 2) = w; } }
            asm volatile("s_waitcnt lgkmcnt(0)" ::: "memory");
            const int ch8 = lane & 7, tg = lane >> 3; const int c = cb + 8 * ch8;
#pragma unroll 1
            for (int ib = 0; ib < 2; ++ib) { u32x4 zr[4][2], zk[4][2], zv[4][2];
#pragma unroll
                for (int i4 = 0; i4 < 4; ++i4) { const size_t m = m0 + tg + 8 * (4 * ib + i4); const bool hp = (m % SEQ) != 0; const bf16* zc = Z + m * OD_INP + c; const bf16* zp = zc - (hp ? OD_INP : 0);
                    zr[i4][0] = *(const u32x4*)zc; zr[i4][1] = *(const u32x4*)zp; zk[i4][0] = *(const u32x4*)(zc + 1024); zk[i4][1] = *(const u32x4*)(zp + 1024); zv[i4][0] = *(const u32x4*)(zc + 2048); zv[i4][1] = *(const u32x4*)(zp + 2048); }
                asm volatile("" ::: "memory");
#pragma unroll
                for (int i4 = 0; i4 < 4; ++i4) { const int tok = tg + 8 * (4 * ib + i4); const size_t m = m0 + tok; const float hpf = ((m % SEQ) != 0) ? 1.f : 0.f;
                    const u32x4 aw = *(const LAS u32x4*)(as_ + tok * AS_ST + ch8 * 16);
                    float r8[8], k8[8], v8[8], a8[8], km[8], kk[8]; float ss = 0.f, bon = 0.f;
#define PREP_TS(dst, cur, prv, which) do { const f32x4 mlo = prm4(lds, which, c), mhi = prm4(lds, which, c + 4); \
                        const float c0 = bflo_(cur.x), c1 = bfhi_(cur.x), c2 = bflo_(cur.y), c3 = bfhi_(cur.y), c4_ = bflo_(cur.z), c5 = bfhi_(cur.z), c6 = bflo_(cur.w), c7 = bfhi_(cur.w); \
                        dst[0] = c0 + (bflo_(prv.x) * hpf - c0) * mlo[0]; dst[1] = c1 + (bfhi_(prv.x) * hpf - c1) * mlo[1]; dst[2] = c2 + (bflo_(prv.y) * hpf - c2) * mlo[2]; dst[3] = c3 + (bfhi_(prv.y) * hpf - c3) * mlo[3]; \
                        dst[4] = c4_ + (bflo_(prv.z) * hpf - c4_) * mhi[0]; dst[5] = c5 + (bfhi_(prv.z) * hpf - c5) * mhi[1]; dst[6] = c6 + (bflo_(prv.w) * hpf - c6) * mhi[2]; dst[7] = c7 + (bfhi_(prv.w) * hpf - c7) * mhi[3]; } while (0)
                    PREP_TS(r8, zr[i4][0], zr[i4][1], 0); PREP_TS(k8, zk[i4][0], zk[i4][1], 1); PREP_TS(v8, zv[i4][0], zv[i4][1], 2);
#undef PREP_TS
                    a8[0] = bflo_(aw.x); a8[1] = bfhi_(aw.x); a8[2] = bflo_(aw.y); a8[3] = bfhi_(aw.y); a8[4] = bflo_(aw.z); a8[5] = bfhi_(aw.z); a8[6] = bflo_(aw.w); a8[7] = bfhi_(aw.w);
                    const f32x4 kklo = prm4(lds, 3, c), kkhi = prm4(lds, 3, c + 4), kalo = prm4(lds, 5, c), kahi = prm4(lds, 5, c + 4), rklo = prm4(lds, 6, c), rkhi = prm4(lds, 6, c + 4);
#pragma unroll
                    for (int e = 0; e < 8; ++e) { const float kkp = (e < 4) ? kklo[e & 3] : kkhi[e & 3], kap = (e < 4) ? kalo[e & 3] : kahi[e & 3], rkp = (e < 4) ? rklo[e & 3] : rkhi[e & 3];
                        kk[e] = k8[e] * kkp; ss += kk[e] * kk[e]; km[e] = k8[e] * (1.f + (a8[e] - 1.f) * kap); bon += r8[e] * km[e] * rkp; }
                    ss += __shfl_xor(ss, 1); ss += __shfl_xor(ss, 2); ss += __shfl_xor(ss, 4); bon += __shfl_xor(bon, 1); bon += __shfl_xor(bon, 2); bon += __shfl_xor(bon, 4);
                    const float inv = 1.0f / fmaxf(sqrtf(ss), 1e-12f);
                    u32x4 wr_, wv_, wkm, wkk, wbv;
                    wr_.x = pk2(r8[0], r8[1]); wr_.y = pk2(r8[2], r8[3]); wr_.z = pk2(r8[4], r8[5]); wr_.w = pk2(r8[6], r8[7]);
                    wv_.x = pk2(v8[0], v8[1]); wv_.y = pk2(v8[2], v8[3]); wv_.z = pk2(v8[4], v8[5]); wv_.w = pk2(v8[6], v8[7]);
                    wkm.x = pk2(km[0], km[1]); wkm.y = pk2(km[2], km[3]); wkm.z = pk2(km[4], km[5]); wkm.w = pk2(km[6], km[7]);
                    wkk.x = pk2(kk[0] * inv, kk[1] * inv); wkk.y = pk2(kk[2] * inv, kk[3] * inv); wkk.z = pk2(kk[4] * inv, kk[5] * inv); wkk.w = pk2(kk[6] * inv, kk[7] * inv);
                    wbv.x = pk2(kk[0] * inv * a8[0], kk[1] * inv * a8[1]); wbv.y = pk2(kk[2] * inv * a8[2], kk[3] * inv * a8[3]); wbv.z = pk2(kk[4] * inv * a8[4], kk[5] * inv * a8[5]); wbv.w = pk2(kk[6] * inv * a8[6], kk[7] * inv * a8[7]);
                    const size_t o = m * 1024 + c;
                    *(u32x4*)(B.R + o) = wr_; *(u32x4*)(B.V + o) = wv_; *(u32x4*)(B.KM + o) = wkm; *(u32x4*)(B.KK + o) = wkk; *(u32x4*)(B.BV + o) = wbv;
                    if (ch8 == 0) B.BON[m * 16 + 2 * wid + hh] = bon; }
                asm volatile("" ::: "memory"); }
        }
    }
}
__device__ __forceinline__ void ph_rwkv_prep(lds_t* lds, int vcu, int G, bf16* Z, const RwkvP& P, const RwkvW& W, const RwkvB& B) {
    const int tid = opq_((int)threadIdx.x);
    __syncthreads();
    { float pv_[16];
#pragma unroll
      for (int i = 0; i < 16; ++i) { const int idx = tid + 512 * i, which = idx >> 10, c = idx & 1023;
          const float* src = (which == 0) ? P.mu + c : (which == 1) ? P.mu + 1024 + c : (which == 2) ? P.mu + 2048 + c : (which == 3) ? P.kk + c : (which == 4) ? P.a0 + c : (which == 5) ? P.ka + c : (which == 6) ? P.rk + c : P.w0 + c;
          pv_[i] = *src; }
#pragma unroll
      for (int i = 0; i < 16; ++i) ((LAS float*)(lds + PRM_OFF))[tid + 512 * i] = pv_[i]; }
    _Pragma("unroll 1") for (int rpr_ = 0; rpr_ < RPR; ++rpr_)
    for (int u = vcu; u < M / 64; u += G) { const size_t m0 = (size_t)u * 64; const int tid = opq_((int)threadIdx.x);
        __syncthreads();
#pragma unroll 1
        for (int i0 = 0; i0 < 40; i0 += 20) { bf16 shc[20], spv[20]; float smu[20];
#pragma unroll
            for (int ii = 0; ii < 20; ++ii) { const int idx = tid + 512 * (i0 + ii), tok = idx / 320, col = idx % 320; const size_t m = m0 + tok; const int zc = OZ_HW + (col < 288 ? col : 287); const bool hp = (m % SEQ) != 0;
                shc[ii] = Z[m * OD_INP + zc]; spv[ii] = Z[(m - (hp ? 1 : 0)) * OD_INP + zc]; smu[ii] = P.mu[zc]; }
#pragma unroll
            for (int ii = 0; ii < 20; ++ii) { const int idx = tid + 512 * (i0 + ii), tok = idx / 320, col = idx % 320; const size_t m = m0 + tok; const bool hp = (m % SEQ) != 0;
                const float hc = bf2f(shc[ii]), pv = bf2f(spv[ii]) * (hp ? 1.f : 0.f); const float v = hc + (pv - hc) * smu[ii]; const float sg = 1.f / (1.f + __expf(col < 64 ? -2.f * v : -v));
                float f = (col < 64) ? (2.f * sg - 1.f) : (col < 128 ? v : sg); f = (col < 288) ? f : 0.f;
                *(LAS bf16*)(lds + tok * ACT_ST + col * 2) = (bf16)f2bf(f); } }
        __syncthreads();
        rwkv_prep_pass<0>(lds, m0, Z, P, W, B);
        rwkv_prep_pass<1>(lds, m0, Z, P, W, B);
        rwkv_prep_pass<2>(lds, m0, Z, P, W, B);
    }
    { const int tid = opq_((int)threadIdx.x); const int j8 = tid & 7, rl = tid >> 3;
      float inv[8];
#pragma unroll
      for (int e = 0; e < 8; ++e) inv[e] = powf(10000.0f, -(float)(8 * j8 + e) * (1.0f / 64.0f));
      for (int mb_ = vcu * 64; mb_ < M; mb_ += G * 64) { const int row = mb_ + rl; const int t = row % SEQ; float cs[8], sn[8];
#pragma unroll
          for (int e = 0; e < 8; ++e) { const float ang = (float)t * inv[e]; const double rev = (double)ang * 0.15915494309189535; const float frc = (float)(rev - rint(rev));
              sn[e] = __builtin_amdgcn_sinf(frc); cs[e] = __builtin_amdgcn_cosf(frc); }
#pragma unroll 1
          for (int h0 = 0; h0 < 16; h0 += 4) { u32x4 x1[4], x2[4];
#pragma unroll
              for (int k = 0; k < 4; ++k) { const bf16* p = Z + (size_t)row * OD_INP + OZ_DQ + (h0 + k) * 128 + 8 * j8; x1[k] = *(const u32x4*)p; x2[k] = *(const u32x4*)(p + 64); }
#pragma unroll
              for (int k = 0; k < 4; ++k) { float a1[8], a2[8], o1[8], o2[8];
                  a1[0] = bflo_(x1[k].x); a1[1] = bfhi_(x1[k].x); a1[2] = bflo_(x1[k].y); a1[3] = bfhi_(x1[k].y); a1[4] = bflo_(x1[k].z); a1[5] = bfhi_(x1[k].z); a1[6] = bflo_(x1[k].w); a1[7] = bfhi_(x1[k].w);
                  a2[0] = bflo_(x2[k].x); a2[1] = bfhi_(x2[k].x); a2[2] = bflo_(x2[k].y); a2[3] = bfhi_(x2[k].y); a2[4] = bflo_(x2[k].z); a2[5] = bfhi_(x2[k].z); a2[6] = bflo_(x2[k].w); a2[7] = bfhi_(x2[k].w);
#pragma unroll
                  for (int e = 0; e < 8; ++e) { o1[e] = a1[e] * cs[e] - a2[e] * sn[e]; o2[e] = a2[e] * cs[e] + a1[e] * sn[e]; }
                  u32x4 w1, w2; w1.x = pk2(o1[0], o1[1]); w1.y = pk2(o1[2], o1[3]); w1.z = pk2(o1[4], o1[5]); w1.w = pk2(o1[6], o1[7]); w2.x = pk2(o2[0], o2[1]); w2.y = pk2(o2[2], o2[3]); w2.z = pk2(o2[4], o2[5]); w2.w = pk2(o2[6], o2[7]);
                  bf16* p = Z + (size_t)row * OD_INP + OZ_DQ + (h0 + k) * 128 + 8 * j8; *(u32x4*)p = w1; *(u32x4*)(p + 64) = w2; } } } }
}
template <int CTRL> __device__ __forceinline__ float dpp_f(float v) { return __int_as_float(__builtin_amdgcn_update_dpp(0, __float_as_int(v), CTRL, 0xF, 0xF, false)); }
__device__ __forceinline__ float red16(float v) { v += dpp_f<0x128>(v); v += dpp_f<0x124>(v); v += dpp_f<0x122>(v); v += dpp_f<0x121>(v); return v; }
constexpr int SC_TB = 32, SC_BUF = SC_TB * 5 * 64 * 4, SC_VOFF = 2 * SC_BUF, SC_VBUF = SC_TB * 32 * 4, SC_YOFF = SC_VOFF + 2 * SC_VBUF, SC_LDS = SC_YOFF + SC_TB * 32 * 4;
__device__ __forceinline__ void ph_rwkv_scan(lds_t* lds, int sidx, const RwkvB& B) {
    const int tid = opq_((int)threadIdx.x), wid = tid >> 6, lane = tid & 63, rloc = wid * 4 + (lane >> 4), ks = lane & 15;
    const int b = sidx >> 5, h = (sidx >> 1) & 15, half = sidx & 1;
    const size_t rowbase = (size_t)b * SEQ * 1024 + h * 64;
    u32x4 pre[3]; u32x4 prev = (u32x4){0u, 0u, 0u, 0u};
#define SC_ISSUE(t0_) do { const int t0__ = (t0_); \
        _Pragma("unroll") for (int i = 0; i < 3; ++i) { const int q = tid + 512 * i; if (q < 1280) { const int a = q >> 8, rem = q & 255, s = rem >> 3, c8 = rem & 7; \
            const bf16* src = (a == 0) ? B.R : (a == 1) ? B.LD : (a == 2) ? B.KM : (a == 3) ? B.KK : B.BV; \
            pre[i] = *(const u32x4*)(src + rowbase + (size_t)(t0__ + s) * 1024 + 8 * c8); } } \
        if (tid < 128) { const int s = tid >> 2, c8 = tid & 3; prev = *(const u32x4*)(B.V + rowbase + (size_t)(t0__ + s) * 1024 + half * 32 + 8 * c8); } } while (0)
#define SC_COMMIT(bufi_) do { const int bufi__ = (bufi_); \
        _Pragma("unroll") for (int i = 0; i < 3; ++i) { const int q = tid + 512 * i; if (q < 1280) { const int a = q >> 8, rem = q & 255, s = rem >> 3, c8 = rem & 7; \
            f32x4 lo, hi; lo[0] = bflo_(pre[i].x); lo[1] = bfhi_(pre[i].x); lo[2] = bflo_(pre[i].y); lo[3] = bfhi_(pre[i].y); hi[0] = bflo_(pre[i].z); hi[1] = bfhi_(pre[i].z); hi[2] = bflo_(pre[i].w); hi[3] = bfhi_(pre[i].w); \
            if (a == 1) { _Pragma("unroll") for (int e = 0; e < 4; ++e) { lo[e] = __expf(lo[e]); hi[e] = __expf(hi[e]); } } \
            LAS f32x4* dst = (LAS f32x4*)(lds + bufi__ * SC_BUF + ((s * 5 + a) * 64 + 8 * c8) * 4); dst[0] = lo; dst[1] = hi; } } \
        if (tid < 128) { const int s = tid >> 2, c8 = tid & 3; f32x4 lo, hi; lo[0] = bflo_(prev.x); lo[1] = bfhi_(prev.x); lo[2] = bflo_(prev.y); lo[3] = bfhi_(prev.y); hi[0] = bflo_(prev.z); hi[1] = bfhi_(prev.z); hi[2] = bflo_(prev.w); hi[3] = bfhi_(prev.w); \
            LAS f32x4* dst = (LAS f32x4*)(lds + SC_VOFF + bufi__ * SC_VBUF + (s * 32 + 8 * c8) * 4); dst[0] = lo; dst[1] = hi; } } while (0)
    float S0 = 0.f, S1 = 0.f, S2 = 0.f, S3 = 0.f;
    __syncthreads();
    SC_ISSUE(0); SC_COMMIT(0);
    __syncthreads();
    for (int blk = 0; blk < SEQ / SC_TB; ++blk) { const int bufi = blk & 1;
        if (blk + 1 < SEQ / SC_TB) SC_ISSUE((blk + 1) * SC_TB);
        const lds_t* bp = lds + bufi * SC_BUF; const lds_t* vp = lds + SC_VOFF + bufi * SC_VBUF;
#define SC_LOAD(R4, W4, M4, K4, B4, VV, s_) do { const LAS f32x4* sp_ = (const LAS f32x4*)(bp + (s_) * 5 * 64 * 4) + ks; R4 = sp_[0]; W4 = sp_[16]; M4 = sp_[32]; K4 = sp_[48]; B4 = sp_[64]; VV = ((const LAS float*)vp)[(s_) * 32 + rloc]; } while (0)
#define SC_STEP(R4, W4, M4, K4, B4, VV, s_) do { \
            const float sa_ = -red16((S0 * K4[0] + S1 * K4[1]) + (S2 * K4[2] + S3 * K4[3])); \
            S0 = S0 * W4[0] + (sa_ * B4[0] + VV * M4[0]); S1 = S1 * W4[1] + (sa_ * B4[1] + VV * M4[1]); S2 = S2 * W4[2] + (sa_ * B4[2] + VV * M4[2]); S3 = S3 * W4[3] + (sa_ * B4[3] + VV * M4[3]); \
            const float y_ = red16((S0 * R4[0] + S1 * R4[1]) + (S2 * R4[2] + S3 * R4[3])); \
            ((LAS float*)(lds + SC_YOFF))[(s_) * 32 + rloc] = y_; } while (0)
        { f32x4 ra, wa, ma, ka, ba, rb, wb, mb, kb, bb; float va, vb;
          SC_LOAD(ra, wa, ma, ka, ba, va, 0); SC_LOAD(rb, wb, mb, kb, bb, vb, 1);
#pragma unroll
          for (int s = 0; s < SC_TB; s += 2) {
              SC_STEP(ra, wa, ma, ka, ba, va, s);
              if (s + 2 < SC_TB) SC_LOAD(ra, wa, ma, ka, ba, va, s + 2);
              SC_STEP(rb, wb, mb, kb, bb, vb, s + 1);
              if (s + 3 < SC_TB) SC_LOAD(rb, wb, mb, kb, bb, vb, s + 3);
          } }
        __syncthreads();
        if (tid < 128) { const int s = tid >> 2, c8 = tid & 3; const LAS f32x4* yp = (const LAS f32x4*)(lds + SC_YOFF + (s * 32 + 8 * c8) * 4); const f32x4 a = yp[0], c = yp[1];
            u32x4 o; o.x = pk2(a[0], a[1]); o.y = pk2(a[2], a[3]); o.z = pk2(c[0], c[1]); o.w = pk2(c[2], c[3]);
            *(u32x4*)(B.Y + rowbase + (size_t)(blk * SC_TB + s) * 1024 + half * 32 + 8 * c8) = o; }
        if (blk + 1 < SEQ / SC_TB) SC_COMMIT(bufi ^ 1);
        __syncthreads();
    }
}
__device__ __forceinline__ float red16x(float v) { v += __shfl_xor(v, 1); v += __shfl_xor(v, 2); v += __shfl_xor(v, 4); v += __shfl_xor(v, 8); return v; }
struct DilP { bf16* O1; float* ML0; };
__device__ __forceinline__ void ph_rwkv_fin(int vcu, int G, const RwkvP& P, const RwkvB& B, const DilP& D, bf16* __restrict__ MIX) {
    const int tix_ = opq_((int)threadIdx.x); const int wid = tix_ >> 6, lane = tix_ & 63;
    for (int task = vcu * 8 + wid; task < M * 4; task += G * 8) { const size_t m = task >> 2; const int c = (task & 3) * 256 + 4 * lane; const size_t o = m * 1024 + c;
        const f32x4 y = unpack4(*(const u32x2*)(B.Y + o)), v = unpack4(*(const u32x2*)(B.V + o)), g = unpack4(*(const u32x2*)(B.G + o));
        const f32x4 lw = *(const f32x4*)(P.lnw + c), lb = *(const f32x4*)(P.lnb + c);
        const float mean = red16x((y[0] + y[1]) + (y[2] + y[3])) * (1.0f / 64.0f); const f32x4 dy = y - mean;
        const float var = red16x((dy[0] * dy[0] + dy[1] * dy[1]) + (dy[2] * dy[2] + dy[3] * dy[3])) * (1.0f / 64.0f); const float rs = 1.0f / sqrtf(var + 64e-5f);
        const float bon = B.BON[m * 16 + (task & 3) * 4 + (lane >> 4)];
        f32x4 out;
#pragma unroll
        for (int e = 0; e < 4; ++e) out[e] = (dy[e] * rs * lw[e] + lb[e] + bon * v[e]) * g[e];
        *(u32x2*)(MIX + m * DM + c) = pack4(out);
        { const int hd = (task & 3) * 2 + (lane >> 5); const size_t ml = (m * 8 + hd) * 2;
          const float* ML1_ = D.ML0 + (size_t)M * 16; const float* ML2_ = D.ML0 + (size_t)M * 32; const float m0_ = D.ML0[ml], l0_ = D.ML0[ml + 1], m1_ = ML1_[ml], l1_ = ML1_[ml + 1], m2_ = ML2_[ml], l2_ = ML2_[ml + 1];
          const f32x4 o0 = unpack4(*(const u32x2*)(MIX + m * DM + 1024 + c)), o1 = unpack4(*(const u32x2*)(D.O1 + o)), o2 = unpack4(*(const u32x2*)(D.O1 + (size_t)M * 1024 + o));
          const float mm = fmaxf(m0_, fmaxf(m1_, m2_)); const float w0 = l0_ * __expf(m0_ - mm), w1 = l1_ * __expf(m1_ - mm), w2 = l2_ * __expf(m2_ - mm); const float iw = 1.0f / (w0 + w1 + w2);
          *(u32x2*)(MIX + m * DM + 1024 + c) = pack4((o0 * w0 + o1 * w1 + o2 * w2) * iw); } }
}
constexpr int DA_ST = 272, DA_K = 0, DA_V = 272 * DA_ST, DA_LDS = 2 * 272 * DA_ST;
__device__ __forceinline__ void ph_dil(lds_t* lds, int aidx, int NA, const bf16* __restrict__ Z, bf16* MIX, const DilP& D) {
    const int tid = opq_((int)threadIdx.x), wid = tid >> 6, lane = tid & 63, fr = lane & 15, fq = lane >> 4, lq = fr >> 2, lp = fr & 3;
    const float scale = 0.08838834764831845f;
    for (int uu = aidx; uu < 3 * BATCH * 8 * 8; uu += NA) { const int stage = uu >> 7, u = uu & 127; const int b = u >> 6, h = (u >> 3) & 7, W = u & 7;
        const size_t mb = (size_t)b * SEQ; const int dil = (stage == 0) ? 1 : (stage == 1 ? 4 : 16);
        float* MLs = D.ML0 + (size_t)stage * M * 16;
        for (int sb = 0; sb < 16; ++sb) {
            int r, qs0;
            if (stage == 0) { r = 0; qs0 = 2048 * W + 128 * sb; } else if (stage == 1) { r = sb >> 2; qs0 = 512 * W + 128 * (sb & 3); } else { r = sb; qs0 = 128 * W; }
            asm volatile("s_waitcnt lgkmcnt(0)" ::: "memory"); __builtin_amdgcn_s_barrier(); asm volatile("" ::: "memory");
            const int tid_s = opq_(tid);
            const size_t mq = mb + (size_t)(qs0 + 16 * wid + fr) * dil + r;
            bf16x8 qf[4];
            { u32x4 stg[16];
#pragma unroll
              for (int i = 0; i < 16; ++i) { const int q = tid_s + 512 * i, kv = q >> 12, rem = q & 4095, j = rem >> 4, cc = rem & 15; const int sp = qs0 - 128 + j;
                  stg[i] = *(const u32x4*)(Z + (mb + (size_t)(sp >= 0 ? sp : 0) * dil + r) * OD_INP + (kv ? OZ_DV : OZ_DK) + h * 128 + cc * 8); }
#pragma unroll
              for (int ks = 0; ks < 4; ++ks) qf[ks] = *(const bf16x8*)(Z + mq * OD_INP + OZ_DQ + h * 128 + 32 * ks + 8 * fq);
#pragma unroll
              for (int i = 0; i < 16; ++i) { const int q = tid_s + 512 * i, kv = q >> 12, rem = q & 4095, j = rem >> 4, cc = rem & 15; const int sp = qs0 - 128 + j;
                  *(LAS u32x4*)(lds + (kv ? DA_V : DA_K) + j * DA_ST + cc * 16) = (sp < 0) ? (u32x4){0u, 0u, 0u, 0u} : stg[i]; } }
            { const unsigned z0_ = (unsigned)opq_(0); const int kv = tid_s >> 8, rem = tid_s & 255, j = 256 + (rem >> 4), cc = rem & 15; *(LAS u32x4*)(lds + (kv ? DA_V : DA_K) + j * DA_ST + cc * 16) = (u32x4){z0_, z0_, z0_, z0_}; }
            asm volatile("s_waitcnt lgkmcnt(0)" ::: "memory"); __builtin_amdgcn_s_barrier(); asm volatile("" ::: "memory");
            f32x4 sc[9];
#pragma unroll
            for (int kt = 0; kt < 9; ++kt) { f32x4 a = (f32x4){0.f, 0.f, 0.f, 0.f};
#pragma unroll
                for (int ks = 0; ks < 4; ++ks) { const bf16x8 kf = *(const LAS bf16x8*)(lds + DA_K + (16 * wid + 16 * kt + fr) * DA_ST + (32 * ks + 8 * fq) * 2); a = mfma16(kf, qf[ks], a); }
                sc[kt] = a; }
            float mx = -INFINITY;
#pragma unroll
            for (int kt = 0; kt < 9; ++kt)
#pragma unroll
                for (int e = 0; e < 4; ++e) { const int dist = 128 + fr - 16 * kt - 4 * fq - e; const int j = 16 * wid + 16 * kt + 4 * fq + e;
                    const bool ok = (dist >= 0) && (dist <= 128) && (qs0 - 128 + j >= 0);
                    const float sv = ok ? sc[kt][e] * scale : -INFINITY; sc[kt][e] = sv; mx = fmaxf(mx, sv); }
            mx = fmaxf(mx, __shfl_xor(mx, 16)); mx = fmaxf(mx, __shfl_xor(mx, 32));
            float ls = 0.f;
#pragma unroll
            for (int kt = 0; kt < 9; ++kt)
#pragma unroll
                for (int e = 0; e < 4; ++e) { const float p = __expf(sc[kt][e] - mx); sc[kt][e] = p; ls += p; }
            ls += __shfl_xor(ls, 16); ls += __shfl_xor(ls, 32);
            f32x4 oacc[8];
#pragma unroll
            for (int dt = 0; dt < 8; ++dt) oacc[dt] = (f32x4){0.f, 0.f, 0.f, 0.f};
#pragma unroll
            for (int k2 = 0; k2 < 5; ++k2) { u32x4 pw; pw.x = pk2(sc[2 * k2][0], sc[2 * k2][1]); pw.y = pk2(sc[2 * k2][2], sc[2 * k2][3]);
                if (k2 < 4) { pw.z = pk2(sc[2 * k2 + 1][0], sc[2 * k2 + 1][1]); pw.w = pk2(sc[2 * k2 + 1][2], sc[2 * k2 + 1][3]); } else { pw.z = 0u; pw.w = 0u; }
                const bf16x8 pf = __builtin_bit_cast(bf16x8, pw);
#pragma unroll
                for (int dt = 0; dt < 8; ++dt) { const lds_t* p0 = lds + DA_V + (16 * wid + 32 * k2 + 4 * fq + lq) * DA_ST + (16 * dt + 4 * lp) * 2;
                    const bf16x8 vf = cat8(vtr(p0), vtr(p0 + 16 * DA_ST)); oacc[dt] = mfma16(vf, pf, oacc[dt]); } }
            const float il = 1.0f / ls;
            bf16* op = ((stage == 0) ? MIX + mq * DM + 1024 : D.O1 + (size_t)(stage - 1) * M * 1024 + mq * 1024) + h * 128 + 4 * fq;
#pragma unroll
            for (int dt = 0; dt < 8; ++dt) *(u32x2*)(op + 16 * dt) = pack4(oacc[dt] * il);
            if (fq == 0) { float* mlp = MLs + (mq * 8 + h) * 2; mlp[0] = mx; mlp[1] = ls; }
        }
    }
}

constexpr int R1_ST = 136, R1_AT = 0, R1_BT = 4352, R1_KT = 8704, R1_RT = 13056, R1_WT = 17408, R1_LDS = 17664, R1_TST = 72;
__device__ __forceinline__ bf16x8 r1_rowfrag(const lds_t* tile, int row, int ks, int fq) { const lds_t* p = tile + row * R1_ST + (32 * ks + 8 * fq) * 2; return cat8(*(const LAS s16x4*)p, *(const LAS s16x4*)(p + 8)); }
__device__ __forceinline__ bf16x8 pack8(f32x4 a, f32x4 b) { u32x4 w; w.x = pk2(a[0], a[1]); w.y = pk2(a[2], a[3]); w.z = pk2(b[0], b[1]); w.w = pk2(b[2], b[3]); return __builtin_bit_cast(bf16x8, w); }
template <bool DRY> __device__ __forceinline__ void ph_rwkv_r1(lds_t* lds, int vcu, int G, bf16* Z, const RwkvB& B) {
    float chk_ = 0.f;
    const int tid = opq_((int)threadIdx.x), wid = tid >> 6, lane = tid & 63, fr = lane & 15, fq = lane >> 4, lq = fr >> 2, lp = fr & 3;
    lds_t* wl = lds + wid * R1_LDS;
    const f32x4 zero4 = (f32x4){0.f, 0.f, 0.f, 0.f};
#pragma unroll 1
    for (int u = vcu * 8 + wid; u < 32 * 512; u += G * 8) {
        const int bh = u >> 9, c = u & 511, b = bh >> 4, h = bh & 15; const size_t m0 = (size_t)b * SEQ + (size_t)c * 32; const size_t ob = m0 * 1024 + h * 64;
        { float cum = 0.f, eprev = 1.f;
#pragma unroll 1
          for (int t0 = 0; t0 < 32; t0 += 8) { bf16 sl[8], sk[8], sb[8], sm[8], sr[8];
#pragma unroll
              for (int tt = 0; tt < 8; ++tt) { const size_t o = ob + (size_t)(t0 + tt) * 1024 + lane; sl[tt] = B.LD[o]; sk[tt] = B.KK[o]; sb[tt] = B.BV[o]; sm[tt] = B.KM[o]; sr[tt] = B.R[o]; }
#pragma unroll
              for (int tt = 0; tt < 8; ++tt) { const int t = t0 + tt; const size_t o = ob + (size_t)t * 1024 + lane;
                  const float ldv = bf2f(sl[tt]), kkv = bf2f(sk[tt]), bvv = bf2f(sb[tt]), kmv = bf2f(sm[tt]), rv = bf2f(sr[tt]);
                  cum += ldv; const float epos = __expf(cum), eneg = __expf(-cum);
                  const bf16 rt = (bf16)f2bf(rv * epos);
                  *(LAS bf16*)(wl + R1_AT + t * R1_ST + lane * 2) = (bf16)f2bf(-kkv * eprev);
                  *(LAS bf16*)(wl + R1_BT + t * R1_ST + lane * 2) = (bf16)f2bf(bvv * eneg);
                  *(LAS bf16*)(wl + R1_KT + t * R1_ST + lane * 2) = (bf16)f2bf(kmv * eneg);
                  *(LAS bf16*)(wl + R1_RT + t * R1_ST + lane * 2) = rt;
                  if (!DRY) B.LD[o] = rt; else chk_ += rv;
                  eprev = epos; } }
          *(LAS float*)(wl + R1_WT + lane * 4) = eprev; }
        bf16x8 mrbA[2], mrkA[2], lakA[2];
        { f32x4 x[2][2];
#define R1_TT(Atile, Btile, STRICT, OUT) do { \
            _Pragma("unroll") for (int ms = 0; ms < 2; ++ms) _Pragma("unroll") for (int nt = 0; nt < 2; ++nt) { f32x4 a_ = zero4; \
                _Pragma("unroll") for (int ks = 0; ks < 2; ++ks) a_ = mfma16(r1_rowfrag(wl + Atile, 16 * ms + fr, ks, fq), r1_rowfrag(wl + Btile, 16 * nt + fr, ks, fq), a_); \
                _Pragma("unroll") for (int i = 0; i < 4; ++i) { const int s_ = 16 * ms + 4 * fq + i, t_ = 16 * nt + fr; if (STRICT ? !(s_ < t_) : !(s_ <= t_)) a_[i] = 0.f; } x[ms][nt] = a_; } \
            OUT[0] = pack8(x[0][0], x[1][0]); OUT[1] = pack8(x[0][1], x[1][1]); } while (0)
          R1_TT(R1_BT, R1_RT, false, mrbA);
          R1_TT(R1_KT, R1_RT, false, mrkA);
          R1_TT(R1_KT, R1_AT, true, lakA);
#undef R1_TT
#pragma unroll
          for (int mt = 0; mt < 2; ++mt)
#pragma unroll
              for (int ns = 0; ns < 2; ++ns) { f32x4 a_ = zero4;
#pragma unroll
                  for (int ks = 0; ks < 2; ++ks) a_ = mfma16(r1_rowfrag(wl + R1_AT, 16 * mt + fr, ks, fq), r1_rowfrag(wl + R1_BT, 16 * ns + fr, ks, fq), a_);
#pragma unroll
                  for (int i = 0; i < 4; ++i) { const int t_ = 16 * mt + 4 * fq + i, s_ = 16 * ns + fr; *(LAS float*)(wl + R1_RT + (t_ * 32 + s_) * 4) = (s_ < t_) ? a_[i] : 0.f; } } }
        { const int j = lane & 31; float ci[32];
#pragma unroll
          for (int t = 0; t < 32; ++t) { float acc = (t == j) ? 1.f : 0.f;
#pragma unroll
              for (int s4 = 0; s4 < (t + 3) / 4; ++s4) { const f32x4 n4 = *(const LAS f32x4*)(wl + R1_RT + (t * 32 + 4 * s4) * 4);
#pragma unroll
                  for (int e = 0; e < 4; ++e) if (4 * s4 + e < t) acc += n4[e] * ci[4 * s4 + e]; }
              ci[t] = acc; }
#pragma unroll
          for (int t = 0; t < 32; ++t) *(LAS bf16*)(wl + R1_RT + t * R1_TST + j * 2) = (bf16)f2bf(ci[t]); }
        bf16x8 tiA[2], tiP[2];
#pragma unroll
        for (int mt = 0; mt < 2; ++mt) { const lds_t* p = wl + R1_RT + (16 * mt + fr) * R1_TST;
            tiA[mt] = cat8(*(const LAS s16x4*)(p + 16 * fq), *(const LAS s16x4*)(p + 16 * fq + 8));
            tiP[mt] = cat8(*(const LAS s16x4*)(p + 8 * fq), *(const LAS s16x4*)(p + 32 + 8 * fq)); }
        bf16x8 ahF[4];
#pragma unroll
        for (int kt = 0; kt < 4; ++kt) { const lds_t* p = wl + R1_AT + (8 * fq + lq) * R1_ST + (16 * kt + 4 * lp) * 2; const bf16x8 atB = cat8(vtr(p), vtr(p + 4 * R1_ST));
            const f32x4 a0 = mfma16(tiA[0], atB, zero4), a1 = mfma16(tiA[1], atB, zero4); ahF[kt] = pack8(a0, a1); }
        bf16x8 vF[4];
#pragma unroll
        for (int vt = 0; vt < 4; ++vt) { const bf16* vp = B.V + ob + 16 * vt + fr; bf16x8 f;
#pragma unroll
            for (int jj = 0; jj < 4; ++jj) { f[jj] = (short)vp[(size_t)(4 * fq + jj) * 1024]; f[4 + jj] = (short)vp[(size_t)(16 + 4 * fq + jj) * 1024]; }
            vF[vt] = f; }
        bf16x8 p1pF[4];
#pragma unroll
        for (int vt = 0; vt < 4; ++vt) { const f32x4 a0 = mfma16(lakA[0], vF[vt], zero4), a1 = mfma16(lakA[1], vF[vt], zero4); const bf16x8 p1F = pack8(a0, a1);
            const f32x4 c0 = mfma16(tiP[0], p1F, zero4), c1 = mfma16(tiP[1], p1F, zero4); p1pF[vt] = pack8(c0, c1); }
        asm volatile("s_waitcnt vmcnt(0)" ::: "memory");
#pragma unroll
        for (int mt = 0; mt < 2; ++mt) {
            { bf16 oldv[4][4];
#pragma unroll
              for (int kt = 0; kt < 4; ++kt)
#pragma unroll
                  for (int i = 0; i < 4; ++i) oldv[kt][i] = __builtin_nontemporal_load(B.LD + ob + (size_t)(16 * mt + 4 * fq + i) * 1024 + 16 * kt + fr);
#pragma unroll
              for (int kt = 0; kt < 4; ++kt) { const f32x4 a_ = mfma16(mrbA[mt], ahF[kt], zero4);
#pragma unroll
                  for (int i = 0; i < 4; ++i) { if (!DRY) B.LD[ob + (size_t)(16 * mt + 4 * fq + i) * 1024 + 16 * kt + fr] = (bf16)f2bf(bf2f(oldv[kt][i]) + a_[i]); else chk_ += bf2f(oldv[kt][i]) + a_[i]; } } }
#pragma unroll
            for (int vt = 0; vt < 4; ++vt) { f32x4 a_ = mfma16(mrbA[mt], p1pF[vt], zero4); a_ = mfma16(mrkA[mt], vF[vt], a_); const int v = 16 * vt + fr;
                if (!DRY) *(u32x2*)(B.KK + ob + (size_t)(v >> 1) * 1024 + (v & 1) * 32 + 16 * mt + 4 * fq) = pack4(a_); else chk_ += a_[0] + a_[1] + a_[2] + a_[3]; } }
        bf16x8 btP[4], ktP[4];
#pragma unroll
        for (int kt = 0; kt < 4; ++kt) { const lds_t* pb = wl + R1_BT + (4 * fq + lq) * R1_ST + (16 * kt + 4 * lp) * 2; btP[kt] = cat8(vtr(pb), vtr(pb + 16 * R1_ST));
            const lds_t* pk = wl + R1_KT + (4 * fq + lq) * R1_ST + (16 * kt + 4 * lp) * 2; ktP[kt] = cat8(vtr(pk), vtr(pk + 16 * R1_ST)); }
#pragma unroll
        for (int kt = 0; kt < 4; ++kt) { const int k = 16 * kt + fr; const float wk = *(const LAS float*)(wl + R1_WT + k * 4);
            bf16* prow = Z + (m0 + (k >> 1)) * OD_INP + h * 128 + (k & 1) * 64;
#pragma unroll
            for (int k2 = 0; k2 < 4; ++k2) { f32x4 a_ = mfma16(ahF[k2], btP[kt], zero4);
#pragma unroll
                for (int i = 0; i < 4; ++i) { const int kp = 16 * k2 + 4 * fq + i; a_[i] = wk * (a_[i] + ((kp == k) ? 1.f : 0.f)); }
                if (!DRY) *(u32x2*)(prow + 16 * k2 + 4 * fq) = pack4(a_); else chk_ += a_[0] + a_[1] + a_[2] + a_[3]; } }
#pragma unroll
        for (int kt = 0; kt < 4; ++kt) { const f32x4 w4 = *(const LAS f32x4*)(wl + R1_WT + (16 * kt + 4 * fq) * 4);
#pragma unroll
            for (int vt = 0; vt < 4; ++vt) { f32x4 a_ = mfma16(btP[kt], p1pF[vt], zero4); a_ = mfma16(ktP[kt], vF[vt], a_); const int v = 16 * vt + fr;
                bf16* dst = ((v < 32) ? B.BV : B.KM) + ob + (size_t)(v & 31) * 1024 + 16 * kt + 4 * fq; if (!DRY) *(u32x2*)dst = pack4(a_ * w4); else chk_ += a_[0] + a_[1] + a_[2] + a_[3]; } }
    }
    if (DRY) B.Y[(size_t)(vcu * 8 + wid) * 64 + lane] = (bf16)f2bf(chk_);
}
constexpr int R2_SLOT = 18432, R2_D = 8, R2_LDS = R2_SLOT * R2_D;
__device__ __forceinline__ void ph_rwkv_r2(lds_t* lds, int bh, int half, const bf16* __restrict__ Z, const RwkvB& B) {
    const int tid = opq_((int)threadIdx.x), wid = __builtin_amdgcn_readfirstlane(tid >> 6), lane = tid & 63, fr = lane & 15, fq = lane >> 4;
    const int b = bh >> 4, h = bh & 15;
    const size_t obase = (size_t)b * SEQ * 1024 + h * 64;
    const bool comp = wid < 2;
    const bf16* srcp[3]; size_t cstr[3];
#pragma unroll
    for (int i = 0; i < 3; ++i) { const int piece = 3 * (wid >= 2 ? wid - 2 : 0) + i, row8 = lane >> 3, ch = lane & 7;
        if (piece < 8) { const int k = 8 * piece + row8, sw = ch ^ (k & 7); srcp[i] = Z + ((size_t)b * SEQ + (k >> 1)) * OD_INP + h * 128 + (k & 1) * 64 + 8 * sw; cstr[i] = (size_t)32 * OD_INP; }
        else if (piece < 12) { const int t = 8 * (piece - 8) + row8, sw = ch ^ (t & 7); srcp[i] = B.LD + obase + (size_t)t * 1024 + 8 * sw; cstr[i] = (size_t)32 * 1024; }
        else if (piece < 16) { const int vl = 8 * (piece - 12) + row8, sw = ch ^ (vl & 7); srcp[i] = (half ? B.KM : B.BV) + obase + (size_t)vl * 1024 + 8 * sw; cstr[i] = (size_t)32 * 1024; }
        else { const int rl = 8 * (piece - 16) + row8, sw = ch ^ (rl & 7); srcp[i] = B.KK + obase + (size_t)(16 * half + rl) * 1024 + 8 * sw; cstr[i] = (size_t)32 * 1024; } }
#define R2_ISSUE(c_) do { const int c__ = (c_); lds_t* sl_ = lds + (c__ % R2_D) * R2_SLOT + 3 * (wid - 2) * 1024; \
        _Pragma("unroll") for (int i = 0; i < 3; ++i) __builtin_amdgcn_global_load_lds((const unsigned*)(srcp[i] + (size_t)c__ * cstr[i]), (LAS unsigned*)(sl_ + i * 1024), 16, 0, 0); } while (0)
    const int vl = 16 * wid + fr;
    bf16* ydst = B.Y + obase + (size_t)(4 * fq) * 1024 + 32 * half + vl;
    const int hb = (fq & 1) * 8, fh = fq >> 1;
    f32x4 X[4];
#pragma unroll
    for (int kt = 0; kt < 4; ++kt) X[kt] = (f32x4){0.f, 0.f, 0.f, 0.f};
    __syncthreads();
    if (!comp) {
#pragma unroll
        for (int c = 0; c < R2_D - 1; ++c) R2_ISSUE(c); }
#pragma unroll 1
    for (int c = 0; c < 512; ++c) {
        if (!comp) { if (c + R2_D - 1 <= 512) asm volatile("s_waitcnt vmcnt(18)" ::: "memory"); else asm volatile("s_waitcnt vmcnt(0)" ::: "memory"); }
        __builtin_amdgcn_s_barrier(); asm volatile("" ::: "memory");
        if (!comp) { if (c + R2_D - 1 < 512) R2_ISSUE(c + R2_D - 1); }
        else {
            const lds_t* sl = lds + (c % R2_D) * R2_SLOT;
            bf16x8 pm[4][2], rh[2][2]; f32x4 xn[4], y[2];
#pragma unroll
            for (int kt = 0; kt < 4; ++kt) { const int k = 16 * kt + fr; const lds_t* rp = sl + k * 128 + hb;
#pragma unroll
                for (int ks = 0; ks < 2; ++ks) { const int L = 4 * ks + fh; pm[kt][ks] = cat8(*(const LAS s16x4*)(rp + ((L ^ (k & 7)) << 4)), *(const LAS s16x4*)(rp + (((L + 2) ^ (k & 7)) << 4))); }
                const int Lq = 2 * kt + fh; xn[kt] = unpack4(*(const LAS u32x2*)(sl + 12288 + vl * 128 + ((Lq ^ (vl & 7)) << 4) + hb)); }
#pragma unroll
            for (int mt = 0; mt < 2; ++mt) { const int t = 16 * mt + fr; const lds_t* rp = sl + 8192 + t * 128 + hb;
#pragma unroll
                for (int ks = 0; ks < 2; ++ks) { const int L = 4 * ks + fh; rh[mt][ks] = cat8(*(const LAS s16x4*)(rp + ((L ^ (t & 7)) << 4)), *(const LAS s16x4*)(rp + (((L + 2) ^ (t & 7)) << 4))); }
                const int rl = vl >> 1, Lp = (vl & 1) * 4 + 2 * mt + fh; y[mt] = unpack4(*(const LAS u32x2*)(sl + 16384 + rl * 128 + ((Lp ^ (rl & 7)) << 4) + hb)); }
            const bf16x8 xb0 = pack8(X[0], X[1]), xb1 = pack8(X[2], X[3]);
#pragma unroll
            for (int kt = 0; kt < 4; ++kt) { xn[kt] = mfma16(pm[kt][0], xb0, xn[kt]); xn[kt] = mfma16(pm[kt][1], xb1, xn[kt]); }
#pragma unroll
            for (int mt = 0; mt < 2; ++mt) { y[mt] = mfma16(rh[mt][0], xb0, y[mt]); y[mt] = mfma16(rh[mt][1], xb1, y[mt]); }
#pragma unroll
            for (int kt = 0; kt < 4; ++kt) X[kt] = xn[kt];
#pragma unroll
            for (int mt = 0; mt < 2; ++mt)
#pragma unroll
                for (int i = 0; i < 4; ++i) ydst[((size_t)c * 32 + 16 * mt + i) * 1024] = (bf16)f2bf(y[mt][i]);
            asm volatile("s_waitcnt lgkmcnt(0)" ::: "memory");
        }
    }
    asm volatile("s_waitcnt vmcnt(0)" ::: "memory");
    __syncthreads();
#undef R2_ISSUE
}
__device__ __forceinline__ void ph_x0(int vcu, int G, const float* __restrict__ xin, bf16* __restrict__ xb, float* __restrict__ ss) {
    const int tix_ = opq_((int)threadIdx.x); const int wid = tix_ >> 6, lane = tix_ & 63;
    for (int row = vcu * 8 + wid; row < M; row += G * 8) {
        const f32x4* xr = (const f32x4*)(xin + (size_t)row * DM) + lane; u32x2* xo = (u32x2*)(xb + (size_t)row * DM) + lane;
        f32x4 v[8]; float s = 0.f;
#pragma unroll
        for (int j = 0; j < 8; ++j) v[j] = __builtin_nontemporal_load(xr + 64 * j);
#pragma unroll
        for (int j = 0; j < 8; ++j) { const u32x2 w = pack4(v[j]); xo[64 * j] = w; const f32x4 q = unpack4(w); s += (q[0] * q[0] + q[1] * q[1]) + (q[2] * q[2] + q[3] * q[3]); }
        s = wave_sum(s); if (lane == 0) ss[row] = s;
    }
}
__device__ __forceinline__ void ph_xss(int vcu, int G, const bf16* __restrict__ xb, float* __restrict__ ss) {
    const int tix_ = opq_((int)threadIdx.x); const int wid = tix_ >> 6, lane = tix_ & 63;
    for (int row = vcu * 8 + wid; row < M; row += G * 8) {
        const u32x2* xr = (const u32x2*)(xb + (size_t)row * DM) + lane; u32x2 w[8]; float s = 0.f;
#pragma unroll
        for (int j = 0; j < 8; ++j) w[j] = xr[64 * j];
#pragma unroll
        for (int j = 0; j < 8; ++j) { const f32x4 q = unpack4(w[j]); s += (q[0] * q[0] + q[1] * q[1]) + (q[2] * q[2] + q[3] * q[3]); }
        s = wave_sum(s); if (lane == 0) ss[row] = s;
    }
}
__device__ __forceinline__ void ph_xss_part(int vcu, int G, const float* __restrict__ ssp, float* __restrict__ ss) {
    const int tix_ = opq_((int)threadIdx.x);
    for (int row = vcu * 512 + tix_; row < M; row += G * 512) {
        const f32x4* p = (const f32x4*)(ssp + (size_t)row * 32); f32x4 v[8]; float s = 0.f;
#pragma unroll
        for (int j = 0; j < 8; ++j) v[j] = p[j];
#pragma unroll
        for (int j = 0; j < 8; ++j) s += (v[j][0] + v[j][1]) + (v[j][2] + v[j][3]);
        ss[row] = s;
    }
}
__device__ __forceinline__ void ph_norm_res(int vcu, int G, const bf16* __restrict__ y, bf16* x, const float* __restrict__ g1, float* __restrict__ rs) {
    const int tix_ = opq_((int)threadIdx.x); const int wid = tix_ >> 6, lane = tix_ & 63;
    for (int row = vcu * 8 + wid; row < M; row += G * 8) {
        const u32x2* yr = (const u32x2*)(y + (size_t)row * DM) + lane;
        u32x2* xr = (u32x2*)(x + (size_t)row * DM) + lane;
        u32x2 yw[8], xw[8];
#pragma unroll
        for (int j = 0; j < 8; ++j) { yw[j] = __builtin_nontemporal_load(yr + 64 * j); xw[j] = __builtin_nontemporal_load(xr + 64 * j); }
        f32x4 yv[8]; float s = 0.f;
#pragma unroll
        for (int j = 0; j < 8; ++j) { yv[j] = unpack4(yw[j]); s += (yv[j][0] * yv[j][0] + yv[j][1] * yv[j][1]) + (yv[j][2] * yv[j][2] + yv[j][3] * yv[j][3]); }
        s = wave_sum(s); const float rstd = 1.0f / sqrtf(s * (1.0f / DM) + 1e-6f);
        float s2 = 0.f;
#pragma unroll
        for (int j = 0; j < 8; ++j) { const f32x4 gg = ((const f32x4*)g1)[lane + 64 * j]; const u32x2 w = pack4(unpack4(xw[j]) + yv[j] * rstd * gg); xr[64 * j] = w; const f32x4 q = unpack4(w);
            s2 += (q[0] * q[0] + q[1] * q[1]) + (q[2] * q[2] + q[3] * q[3]); }
        s2 = wave_sum(s2); if (lane == 0) rs[row] = 1.0f / sqrtf(s2 * (1.0f / DM) + 1e-6f);
    }
}
__device__ __forceinline__ void wt_load(const float* __restrict__ W, const float* __restrict__ gk, int K, int N, int nblk, int item, int lane, float (&sw)[32]) {
    const int kb = item / nblk, nb = item % nblk, k0 = 64 * kb, n0 = 32 * nb; const int n = n0 + (lane & 31); const int nc = (n < N) ? n : 0;
#pragma unroll
    for (int i = 0; i < 32; ++i) { const int kk = 2 * i + (lane >> 5); const int kr = (k0 + kk < K) ? k0 + kk : 0; sw[i] = __builtin_nontemporal_load(W + (size_t)kr * N + nc) * (gk ? gk[kr] : 1.f); }
}
__device__ __forceinline__ void wt_store(int K, int N, bf16* __restrict__ Wt, int Kpad, int nblk, LAS float* scr, int item, int lane, const float (&sw)[32]) {
    const int kb = item / nblk, nb = item % nblk, k0 = 64 * kb, n0 = 32 * nb; const bool nok = n0 + (lane & 31) < N;
#pragma unroll
    for (int i = 0; i < 32; ++i) { const int kk = 2 * i + (lane >> 5); scr[kk * 33 + (lane & 31)] = (nok && k0 + kk < K) ? sw[i] : 0.f; }
    asm volatile("s_waitcnt lgkmcnt(0)" ::: "memory");
    const int c = lane & 7;
#pragma unroll
    for (int j = 0; j < 4; ++j) { const int n = (lane >> 3) + 8 * j; const LAS float* s = scr + (8 * c) * 33 + n;
        u32x4 o; o.x = pk2(s[0 * 33], s[1 * 33]); o.y = pk2(s[2 * 33], s[3 * 33]); o.z = pk2(s[4 * 33], s[5 * 33]); o.w = pk2(s[6 * 33], s[7 * 33]);
        *(u32x4*)(Wt + (size_t)(n0 + n) * Kpad + k0 + 8 * c) = o; }
    asm volatile("s_waitcnt lgkmcnt(0)" ::: "memory");
}
struct WtJob { const float* W; bf16* Wt; const float* gk; int K, N, Kpad, Npad; };
__device__ __forceinline__ void ph_wt(lds_t* lds, int gw, int NGW, const WtJob& jb, int& base) {
    const int nblk = jb.Npad / 32, nitems = (jb.Kpad / 64) * nblk; const int tix_ = opq_((int)threadIdx.x); const int lane = tix_ & 63;
    LAS float* scr = (LAS float*)(lds + (tix_ >> 6) * 16384);
    int first = (gw - base % NGW + NGW) % NGW;
#pragma unroll 1
    for (int it = first; it < nitems; it += 2 * NGW) { float sa[32], sb[32]; const bool two = it + NGW < nitems;
        wt_load(jb.W, jb.gk, jb.K, jb.N, nblk, it, lane, sa); if (two) wt_load(jb.W, jb.gk, jb.K, jb.N, nblk, it + NGW, lane, sb);
        wt_store(jb.K, jb.N, jb.Wt, jb.Kpad, nblk, scr, it, lane, sa); if (two) wt_store(jb.K, jb.N, jb.Wt, jb.Kpad, nblk, scr, it + NGW, lane, sb); }
    base += nitems;
}
#define XB_TMO      128
#define XB_XCNT(j)  (256  + 64 * (j))
#define XB_XSUB(j)  (1280 + 64 * (j))
#define XB_XGEN(j)  (2304 + 64 * (j))
#define XB_TOP      3328
#define XB_TOPGEN   3392
#define XCD_BAR_WORDS 3456
#define XB_SPIN_CAP (1u << 18)

__device__ __forceinline__ unsigned xb_ld(unsigned* p)              { return __hip_atomic_load(p, __ATOMIC_RELAXED, __HIP_MEMORY_SCOPE_AGENT); }
__device__ __forceinline__ unsigned xb_add(unsigned* p, unsigned v) { return __hip_atomic_fetch_add(p, v, __ATOMIC_RELAXED, __HIP_MEMORY_SCOPE_AGENT); }
__device__ __forceinline__ unsigned xb_xcc_id() { return (unsigned)__builtin_amdgcn_s_getreg((3 << 11) | 20) & 0xFu; }
#define XB_SPIN(cond, bar) do { unsigned _sp = 0; while (cond) { __builtin_amdgcn_s_sleep(1); \
    if ((++_sp & 255u) == 0u) { if (xb_ld(&(bar)[XB_TMO])) break; if (_sp > XB_SPIN_CAP) { atomicAdd(&(bar)[XB_TMO], 1u); break; } } } } while (0)

struct XcdBarrier {
    unsigned* bar; unsigned x;
    volatile LAS unsigned* st;
};

__device__ __forceinline__ XcdBarrier xcd_barrier_post(unsigned* bar, volatile LAS unsigned* st) {
    XcdBarrier b; b.bar = bar; b.x = xb_xcc_id(); b.st = st;
    if (threadIdx.x == 0) (void)xb_add(&bar[XB_XCNT(b.x)], 1u);
    return b;
}
__device__ __forceinline__ void xcd_barrier_complete(unsigned* bar, unsigned x, unsigned& nloc, unsigned& nx) {
    const unsigned G = gridDim.x * gridDim.y * gridDim.z;
    unsigned sum, cnt, mine, sp = 0u;
    for (;;) {
        sum = 0u; cnt = 0u; mine = 0u;
#pragma unroll
        for (unsigned j = 0; j < 16; ++j) { const unsigned c = xb_ld(&bar[XB_XCNT(j)]); sum += c; cnt += (c > 0u) ? 1u : 0u; mine = (j == x) ? c : mine; }
        if (sum == G) break;
        __builtin_amdgcn_s_sleep(1);
        if ((++sp & 255u) == 0u) { if (xb_ld(&bar[XB_TMO])) break; if (sp > XB_SPIN_CAP) { atomicAdd(&bar[XB_TMO], 1u); break; } }
    }
    nloc = mine > 0u ? mine : 1u; nx = cnt > 0u ? cnt : 1u;
}

__device__ __forceinline__ void xcd_barrier(const XcdBarrier& b) {
    asm volatile("s_waitcnt vmcnt(0)" ::: "memory");
    __syncthreads();
    if (threadIdx.x == 0) {
        unsigned* bar = b.bar;
        __builtin_amdgcn_s_waitcnt(0);
        unsigned nloc = b.st[0], nx = b.st[1];
        if (nloc == 0u) { xcd_barrier_complete(bar, b.x, nloc, nx); b.st[0] = nloc; b.st[1] = nx; }
        const unsigned old = xb_add(&bar[XB_XSUB(b.x)], 1u);
        const unsigned gen = old / nloc;
        if (old + 1u == (gen + 1u) * nloc) {
            __builtin_amdgcn_fence(__ATOMIC_RELEASE, "agent");
            asm volatile("s_waitcnt vmcnt(0)" ::: "memory");
            const unsigned og = xb_add(&bar[XB_TOP], 1u);
            const unsigned tg = og / nx;
            if (og + 1u == (tg + 1u) * nx) xb_add(&bar[XB_TOPGEN], 1u);
            else XB_SPIN(xb_ld(&bar[XB_TOPGEN]) == tg, bar);
            __builtin_amdgcn_fence(__ATOMIC_ACQUIRE, "agent");
            xb_add(&bar[XB_XGEN(b.x)], 1u);
            asm volatile("s_waitcnt vmcnt(0)" ::: "memory");
        } else {
            XB_SPIN(xb_ld(&bar[XB_XGEN(b.x)]) == gen, bar);
            __builtin_amdgcn_fence(__ATOMIC_ACQUIRE, "agent");
            asm volatile("s_waitcnt vmcnt(0)" ::: "memory");
        }
    }
    __syncthreads();
}

constexpr int LDS_MISC = 155648, LDS_BYTES = LDS_MISC + 256;
constexpr int CW_BAR = 4096;
constexpr size_t CTL_ZERO_BYTES = 1024 * 1024;
constexpr size_t CTL_SS = 256 * 1024  , CTL_RSA = 768 * 1024  , CTL_RSB = 896 * 1024  ;
constexpr int NPH = 12;
struct MKArgs { const float* in[31]; float* out; unsigned char* ws; int lo, hi; };
typedef __attribute__((address_space(4))) const unsigned long long kq_t;
__device__ __forceinline__ kq_t* karg_() { kq_t* p = (kq_t*)__builtin_amdgcn_kernarg_segment_ptr(); asm volatile("" : "+s"(p)); return p; }
#define GASP __attribute__((address_space(1)))
#define INP(k) ((const float*)(const GASP float*)karg_()[(k)])
#define OUTP() ((float*)(GASP float*)karg_()[31])
#define OUTB() ((unsigned char*)(GASP unsigned char*)karg_()[31])
#define WSP() ((unsigned char*)(GASP unsigned char*)karg_()[32])
__device__ __forceinline__ RwkvP mk_rwkvp(int j) { RwkvP P; P.mu = INP(15) + (size_t)j * 3360; P.w0 = INP(16) + (size_t)j * 1024; P.w2 = INP(17) + (size_t)j * 64 * 1024; P.a0 = INP(18) + (size_t)j * 1024; P.a2 = INP(19) + (size_t)j * 64 * 1024;
    P.g2 = INP(20) + (size_t)j * 160 * 1024; P.kk = INP(21) + (size_t)j * 1024; P.ka = INP(22) + (size_t)j * 1024; P.rk = INP(23) + (size_t)j * 1024; P.lnw = INP(24) + (size_t)j * 1024; P.lnb = INP(25) + (size_t)j * 1024; return P; }
__device__ __forceinline__ RwkvW mk_rwkvw(unsigned char* ws) { RwkvW RW; RW.W2T = (bf16*)(ws + WS_SMALL); RW.A2T = RW.W2T + 1024 * 64; RW.G2T = RW.A2T + 1024 * 64; return RW; }
__device__ __forceinline__ RwkvB mk_rwkvb(unsigned char* ws) { RwkvB RB; RB.R = (bf16*)(ws + WS_H); RB.LD = (bf16*)(ws + WS_H + SLOT); RB.KM = (bf16*)(OUTB() + 2 * SLOT); RB.KK = (bf16*)(OUTB() + 3 * SLOT);
    RB.BV = (bf16*)(ws + WS_T_OD); RB.V = (bf16*)(ws + WS_T_OD + SLOT); RB.G = (bf16*)(ws + WS_T_OD + 2 * SLOT); RB.Y = (bf16*)(ws + WS_T_OD + 3 * SLOT); RB.BON = (float*)(ws + WS_ML + 6 * MiB); return RB; }
__global__ void __launch_bounds__(512, 2) mk_fwd(MKArgs a_unused) {
    extern __shared__ __attribute__((aligned(16))) unsigned char lds_raw[]; lds_t* lds = (lds_t*)lds_raw;
    const int G = gridDim.x, bx = blockIdx.x;
    const int vcu = (G % 8 == 0) ? (bx % 8) * (G / 8) + bx / 8 : bx;
    if (threadIdx.x < 64) ((LAS unsigned*)(lds + LDS_MISC))[threadIdx.x] = 0u;
    __syncthreads();
    (void)xcd_barrier_post((unsigned*)(WSP() + WS_CTL) + CW_BAR, (volatile LAS unsigned*)(lds + LDS_MISC));
    const int lo = ((const int*)&a_unused.lo)[0], hi = a_unused.hi;
#define PH(p) (lo <= (p) && (p) < hi)
#define SEAM(p) do { if (PH(p) && PH((p) + 1)) { XcdBarrier b_; b_.bar = (unsigned*)(WSP() + WS_CTL) + CW_BAR; b_.x = xb_xcc_id(); b_.st = (volatile LAS unsigned*)(lds + LDS_MISC); xcd_barrier(b_); if (RBAR > 1) xcd_barrier(b_); } } while (0)
#define WS_(off) (ws + (off))
#pragma unroll 1
    for (int layer = 0; layer < DEPTH; ++layer) {
        const int j = layer >> 1; const bool odd = (layer & 1) != 0; const int pb = layer * NPH; const int NZ = odd ? OD_INP : EV_INP;
#define XCUR() ((bf16*)(odd ? WSP() + WS_XB : OUTB()))
#define YCUR() ((bf16*)(odd ? OUTB() : WSP() + WS_XB))
        if (PH(pb + 0)) {
            unsigned char* ws = WSP(); const int tid = opq_((int)threadIdx.x), wid = tid >> 6;
            const int gw = opqs_(vcu) * 8 + wid, NGW = opqs_(G) * 8;
            _Pragma("unroll 1") for (int rep0_ = 0; rep0_ < R0; ++rep0_) { int base = 0;
            __syncthreads();
            { WtJob jb; jb.gk = nullptr; if (odd) { jb.W = INP(13) + (size_t)j * DM * OD_IN; jb.N = OD_IN; } else { jb.W = INP(6) + (size_t)j * DM * EV_IN; jb.N = EV_IN; } jb.Wt = (bf16*)WS_(WS_WIN); jb.gk = INP(2) + (size_t)layer * DM; jb.K = DM; jb.Kpad = DM; jb.Npad = NZ; ph_wt(lds, gw, NGW, jb, base); }
            { WtJob jb; jb.gk = nullptr; jb.W = (odd ? INP(14) : INP(7)) + (size_t)j * DM * DM; jb.Wt = (bf16*)WS_(WS_WOUT); jb.K = DM; jb.N = DM; jb.Kpad = DM; jb.Npad = DM; ph_wt(lds, gw, NGW, jb, base); }
            { WtJob jb; jb.gk = nullptr; jb.W = INP(26) + (size_t)layer * DM * DFF; jb.Wt = (bf16*)WS_(WS_WUP); jb.gk = INP(4) + (size_t)layer * DM; jb.K = DM; jb.N = DFF; jb.Kpad = DM; jb.Npad = DFF; ph_wt(lds, gw, NGW, jb, base); }
            { WtJob jb; jb.gk = nullptr; jb.W = INP(27) + (size_t)layer * DFF * DM; jb.Wt = (bf16*)WS_(WS_WDN); jb.K = DFF; jb.N = DM; jb.Kpad = DFF; jb.Npad = DM; ph_wt(lds, gw, NGW, jb, base); }
            { WtJob jb; jb.gk = nullptr; jb.W = INP(29) + (size_t)layer * DM * DM; jb.Wt = (bf16*)WS_(WS_WGT); jb.gk = INP(30) + (size_t)layer * DM; jb.K = DM; jb.N = DM; jb.Kpad = DM; jb.Npad = DM; ph_wt(lds, gw, NGW, jb, base); }
            { WtJob jb; jb.gk = nullptr; jb.W = INP(28) + (size_t)layer * PLE * DM; jb.Wt = (bf16*)WS_(WS_WPJ); jb.K = PLE; jb.N = DM; jb.Kpad = PLE; jb.Npad = DM; ph_wt(lds, gw, NGW, jb, base); }
            if (odd) {
                const RwkvW RW = mk_rwkvw(ws);
                { WtJob jb; jb.gk = nullptr; jb.W = INP(17) + (size_t)j * 64 * 1024; jb.Wt = (bf16*)RW.W2T; jb.K = 64; jb.N = 1024; jb.Kpad = 64; jb.Npad = 1024; ph_wt(lds, gw, NGW, jb, base); }
                { WtJob jb; jb.gk = nullptr; jb.W = INP(19) + (size_t)j * 64 * 1024; jb.Wt = (bf16*)RW.A2T; jb.K = 64; jb.N = 1024; jb.Kpad = 64; jb.Npad = 1024; ph_wt(lds, gw, NGW, jb, base); }
                { WtJob jb; jb.gk = nullptr; jb.W = INP(20) + (size_t)j * 160 * 1024; jb.Wt = (bf16*)RW.G2T; jb.K = 160; jb.N = 1024; jb.Kpad = 192; jb.Npad = 1024; ph_wt(lds, gw, NGW, jb, base); }
            }
            { const f32x4* ps = (const f32x4*)(INP(1) + (size_t)layer * M * PLE); u32x2* pd = (u32x2*)WS_(WS_PB);
              for (size_t i = (size_t)opqs_(vcu) * 512 + tid; i < (size_t)M * PLE / 4; i += (size_t)opqs_(G) * 512) pd[i] = pack4(__builtin_nontemporal_load(ps + i)); }
            if (layer == 0) ph_x0(opqs_(vcu), opqs_(G), INP(0), XCUR(), (float*)WS_(WS_CTL + CTL_SS)); else ph_xss_part(opqs_(vcu), opqs_(G), (const float*)WS_(WS_T_EV), (float*)WS_(WS_CTL + CTL_SS) + (size_t)layer * M); }
        }
        SEAM(pb + 0);
        if (PH(pb + 1)) { unsigned char* ws = WSP(); pg8::Gemm g; g.A = XCUR(); g.Bt = (const bf16*)WS_(WS_WIN); g.M = M; g.N = NZ; g.K = DM; pg8::StaticOrder S; S.init(M, NZ, opqs_(G), opqs_(bx)); pg8::EpiBf16<0> E{(bf16*)WS_(WS_Z), NZ, (const float*)WS_(WS_CTL + CTL_SS) + (size_t)layer * M, 2};
            pg8::gemm_phase<pg8::EpiBf16<0>, pg8::StaticOrder, true, true>(lds, g, S, E);
#if RG == 2
            __syncthreads(); pg8::gemm_phase<pg8::EpiBf16<0>, pg8::StaticOrder, true, true>(lds, g, S, E);
#endif
            }
        SEAM(pb + 1);
        if (!odd) {
            if (PH(pb + 2)) { unsigned char* ws = WSP(); bf16* Z = (bf16*)WS_(WS_Z); bf16* MIX = (bf16*)WS_(WS_MIX);
                              _Pragma("unroll 1") for (int rep_ = 0; rep_ < REP; ++rep_) ph_pool(lds, opqs_(vcu), opqs_(G), Z, INP(8) + (size_t)j * 4 * 128 * 128, INP(9) + (size_t)j * 512, MIX);
                              if (RE1 > 2) ph_gla1<false>(lds, opqs_(vcu), opqs_(G), Z, INP(10) + (size_t)j * 16 * 768, INP(11) + (size_t)j * 768, (bf16*)(OUTB() + 2 * SLOT), (bf16*)WS_(WS_H), (bf16*)WS_(WS_T_EV), (float*)WS_(WS_DEC));
                              if (RE1 == 2) ph_gla1<true>(lds, opqs_(vcu), opqs_(G), Z, INP(10) + (size_t)j * 16 * 768, INP(11) + (size_t)j * 768, (bf16*)(OUTB() + 2 * SLOT), (bf16*)WS_(WS_H), (bf16*)WS_(WS_T_EV), (float*)WS_(WS_DEC));
                              ph_gla1<false>(lds, opqs_(vcu), opqs_(G), Z, INP(10) + (size_t)j * 16 * 768, INP(11) + (size_t)j * 768, (bf16*)(OUTB() + 2 * SLOT), (bf16*)WS_(WS_H), (bf16*)WS_(WS_T_EV), (float*)WS_(WS_DEC)); }
            SEAM(pb + 2);
            if (PH(pb + 3)) { unsigned char* ws = WSP(); ph_gla2(opqs_(vcu), opqs_(G), (bf16*)WS_(WS_T_EV), (const float*)WS_(WS_DEC)); }
            SEAM(pb + 3);
            if (PH(pb + 4)) _Pragma("unroll 1") for (int re3_ = 0; re3_ < RE3; ++re3_) { unsigned char* ws = WSP(); ph_gla3(lds, opqs_(vcu), opqs_(G), (const bf16*)WS_(WS_Z), (const bf16*)WS_(WS_T_EV), INP(12) + (size_t)j * 384, (const bf16*)(OUTB() + 2 * SLOT), (const bf16*)WS_(WS_H), (bf16*)WS_(WS_MIX)); }
            SEAM(pb + 4);
        } else {
            if (PH(pb + 2)) { unsigned char* ws = WSP(); const RwkvP P = mk_rwkvp(j); const RwkvW RW = mk_rwkvw(ws); const RwkvB RB = mk_rwkvb(ws); ph_rwkv_prep(lds, opqs_(vcu), opqs_(G), (bf16*)WS_(WS_Z), P, RW, RB); }
            SEAM(pb + 2);
            if (PH(pb + 3)) { unsigned char* ws = WSP(); const RwkvB RB = mk_rwkvb(ws); if (RR1 > 1) ph_rwkv_r1<true>(lds, opqs_(vcu), opqs_(G), (bf16*)WS_(WS_Z), RB); ph_rwkv_r1<false>(lds, opqs_(vcu), opqs_(G), (bf16*)WS_(WS_Z), RB); }
            SEAM(pb + 3);
            if (PH(pb + 4)) { unsigned char* ws = WSP();
                if (opqs_(bx) < 64) { const RwkvB RB = mk_rwkvb(ws); const int bx_ = opqs_(bx); _Pragma("unroll 1") for (int r2_ = 0; r2_ < RSC; ++r2_) ph_rwkv_r2(lds, (bx_ & 7) + 8 * (bx_ >> 4), (bx_ >> 3) & 1, (const bf16*)WS_(WS_Z), RB); }
                else { DilP D; D.O1 = (bf16*)OUTB(); D.ML0 = (float*)WS_(WS_ML);
                    _Pragma("unroll 1") for (int r3_ = 0; r3_ < RAT; ++r3_) ph_dil(lds, opqs_(bx) - 64, opqs_(G) - 64, (const bf16*)WS_(WS_Z), (bf16*)WS_(WS_MIX), D); } }
            SEAM(pb + 4);
            if (PH(pb + 5)) { unsigned char* ws = WSP(); const RwkvP P = mk_rwkvp(j); const RwkvB RB = mk_rwkvb(ws); DilP D; D.O1 = (bf16*)OUTB(); D.ML0 = (float*)WS_(WS_ML);
                ph_rwkv_fin(opqs_(vcu), opqs_(G), P, RB, D, (bf16*)WS_(WS_MIX)); }
            SEAM(pb + 5);
        }
        if (PH(pb + 6)) { unsigned char* ws = WSP(); pg8::Gemm g; g.A = (const bf16*)WS_(WS_MIX); g.Bt = (const bf16*)WS_(WS_WOUT); g.M = M; g.N = DM; g.K = DM; pg8::StaticOrder S; S.init(M, DM, opqs_(G), opqs_(bx)); pg8::EpiBf16<0> E{YCUR(), DM, nullptr, 0};
            pg8::gemm_phase<pg8::EpiBf16<0>, pg8::StaticOrder, true, true>(lds, g, S, E);
#if RG == 2
            __syncthreads(); pg8::gemm_phase<pg8::EpiBf16<0>, pg8::StaticOrder, true, true>(lds, g, S, E);
#endif
            }
        SEAM(pb + 6);
        if (PH(pb + 7)) { unsigned char* ws = WSP(); ph_norm_res(opqs_(vcu), opqs_(G), YCUR(), XCUR(), INP(3) + (size_t)layer * DM, (float*)WS_(WS_CTL + CTL_RSA)); }
        SEAM(pb + 7);
#pragma unroll 1
        for (int fs_ = 0; fs_ < FSPL; ++fs_) { const int fs = opqs_(fs_); constexpr int MS = M / FSPL;
            if (PH(pb + 8)) { unsigned char* ws = WSP(); pg8::Gemm g; g.A = XCUR() + (size_t)fs * MS * DM; g.Bt = (const bf16*)WS_(WS_WUP); g.M = MS; g.N = DFF; g.K = DM; pg8::StaticOrder S; S.init(MS, DFF, opqs_(G), opqs_(bx)); pg8::EpiBf16<2> E{(bf16*)WS_(WS_HID) + (size_t)fs * MS * DFF, DFF, (const float*)WS_(WS_CTL + CTL_RSA) + (size_t)fs * MS, 1};
                pg8::gemm_phase<pg8::EpiBf16<2>, pg8::StaticOrder, true, true>(lds, g, S, E); }
            SEAM(pb + 8);
            if (PH(pb + 9)) { unsigned char* ws = WSP(); pg8::Gemm g; g.A = (const bf16*)WS_(WS_HID) + (size_t)fs * MS * DFF; g.Bt = (const bf16*)WS_(WS_WDN); g.M = MS; g.N = DM; g.K = DFF; pg8::StaticOrder S; S.init(MS, DM, opqs_(G), opqs_(bx)); pg8::EpiBf16<0> E{YCUR() + (size_t)fs * MS * DM, DM, nullptr, 0};
                pg8::gemm_phase<pg8::EpiBf16<0>, pg8::StaticOrder, true, true>(lds, g, S, E); }
        }
        SEAM(pb + 9);
        if (PH(pb + 10)) { unsigned char* ws = WSP(); ph_norm_res(opqs_(vcu), opqs_(G), YCUR(), XCUR(), INP(5) + (size_t)layer * DM, (float*)WS_(WS_CTL + CTL_RSB));
            __syncthreads();
            pg8::Gemm g; g.A = (const bf16*)WS_(WS_PB); g.Bt = (const bf16*)WS_(WS_WPJ); g.M = M; g.N = DM; g.K = PLE; pg8::StaticOrder S; S.init(M, DM, opqs_(G), opqs_(bx)); pg8::EpiBf16<0> E{(bf16*)WS_(WS_MIX), DM, nullptr, 0};
            pg8::gemm_phase<pg8::EpiBf16<0>, pg8::StaticOrder, true, true>(lds, g, S, E);
#if RG == 2
            __syncthreads(); pg8::gemm_phase<pg8::EpiBf16<0>, pg8::StaticOrder, true, true>(lds, g, S, E);
#endif
            }
        SEAM(pb + 10);
        if (PH(pb + 11)) { unsigned char* ws = WSP(); pg8::Gemm g; g.A = XCUR(); g.Bt = (const bf16*)WS_(WS_WGT); g.M = M; g.N = DM; g.K = DM; pg8::StaticOrder S; S.init(M, DM, opqs_(G), opqs_(bx));
            pg8::EpiGate E{(const bf16*)WS_(WS_MIX), XCUR(), YCUR(), (layer == DEPTH - 1) ? OUTP() : nullptr, (const float*)WS_(WS_CTL + CTL_RSB), (layer == DEPTH - 1) ? nullptr : (float*)WS_(WS_T_EV)  , DM};
            pg8::gemm_phase<pg8::EpiGate, pg8::StaticOrder, true, true>(lds, g, S, E); }
        SEAM(pb + 11);
    }
#undef XCUR
#undef YCUR
#undef PH
#undef SEAM
#undef WS_
}
#ifndef MK_SPLIT
#define MK_SPLIT 0
#endif
extern "C" void kernel_launch(void* const* d_in, const int* in_sizes, int n_in, void* d_out, int out_size, void* d_ws, size_t ws_size, hipStream_t stream) {
    static int grid = 0;
    if (grid == 0) {
        if (n_in != 31 || out_size != M * DM || ws_size < WS_NEED) { fprintf(stderr, "kernel_launch: unexpected shapes n_in %d out %d ws %zu\n", n_in, out_size, ws_size); grid = -1; return; }
        int dev = 0, cus = 0, per_cu = 0;
        if (hipGetDevice(&dev) != hipSuccess || hipDeviceGetAttribute(&cus, hipDeviceAttributeMultiprocessorCount, dev) != hipSuccess) { grid = -1; return; }
        if (hipFuncSetAttribute((const void*)mk_fwd, hipFuncAttributeMaxDynamicSharedMemorySize, LDS_BYTES) != hipSuccess) { fprintf(stderr, "kernel_launch: hipFuncSetAttribute failed\n"); grid = -1; return; }
        if (hipOccupancyMaxActiveBlocksPerMultiprocessor(&per_cu, (const void*)mk_fwd, 512, LDS_BYTES) != hipSuccess || per_cu < 1) fprintf(stderr, "kernel_launch: occupancy query says %d\n", per_cu);
        (void)hipGetLastError();
        grid = cus;
        if (grid != 256) fprintf(stderr, "kernel_launch: note: %d CUs\n", grid);
    }
    if (grid < 0) return;
    if (hipMemsetAsync((char*)d_ws + WS_CTL, 0, CTL_ZERO_BYTES, stream) != hipSuccess) return;
    MKArgs a{};
    for (int i = 0; i < 31; ++i) a.in[i] = (const float*)d_in[i];
    a.out = (float*)d_out; a.ws = (unsigned char*)d_ws;
#if MK_SPLIT
    for (int p = 0; p < DEPTH * NPH; ++p) { a.lo = p; a.hi = p + 1; mk_fwd<<<grid, 512, LDS_BYTES, stream>>>(a); }
#else
    a.lo = 0; a.hi = DEPTH * NPH; mk_fwd<<<grid, 512, LDS_BYTES, stream>>>(a);
#endif
}
```

```cpp
#include <hip/hip_runtime.h>
#include <cstdio>
#include <cstdint>
#ifndef FSPL
#define FSPL 4
#endif
#ifndef RBAR
#define RBAR 1
#endif
#ifndef RR1
#define RR1 1
#endif
#ifndef RE1
#define RE1 1
#endif
#ifndef RE3
#define RE3 1
#endif
#ifndef REP
#define REP 1
#endif
#ifndef RPR
#define RPR 1
#endif
#ifndef RSC
#define RSC 1
#endif
#ifndef RAT
#define RAT 1
#endif
#ifndef RG
#define RG 1
#endif
#ifndef R0
#define R0 1
#endif
#ifndef RS
#define RS 1
#endif
#ifndef RF
#define RF 1
#endif
__device__ __forceinline__ int opqs_(int v) { asm volatile("" : "+s"(v)); return v; }
__device__ __forceinline__ int opq_(int v) { asm volatile("" : "+v"(v)); return v; }
namespace pg8 {
#define PG8_LAS __attribute__((address_space(3)))
typedef unsigned short bf16_t;
typedef short bf16x8 __attribute__((ext_vector_type(8)));
typedef float f32x4 __attribute__((ext_vector_type(4)));
typedef unsigned u32x4 __attribute__((ext_vector_type(4)));
constexpr int BM = 256, BK = 64, HALF = 128, HTB = HALF * BK * 2  , STAGE_BYTES = 8 * HTB, NXCD = 8, WGM = 8;

__host__ __device__ __forceinline__ int lds_byte(int r, int c) { const int st = (r >> 4) * 2 + (c >> 5), rr = r & 15, cc = c & 31, ob = rr * 64 + cc * 2; return st * 1024 + (ob ^ (((ob >> 9) & 1) << 5)); }
__host__ __device__ __forceinline__ void stage_rc(int b, int& R, int& C) { const int st = b / 1024, sb = b % 1024, swz = sb ^ (((sb >> 9) & 1) << 5); R = (st >> 1) * 16 + swz / 64; C = (st & 1) * 32 + (swz % 64) / 2; }
__host__ __device__ __forceinline__ int perm32(int rho) { const int n = rho >> 4, i = rho & 15; return 8 * (i >> 2) + 4 * n + (i & 3); }

struct Unit { int pm, pn; };
struct Gemm { const bf16_t* A; const bf16_t* Bt; int M, N, K; };

struct StaticOrder {
    int nM, nN, nwg, G, c;
    __host__ __device__ void init(int M, int N, int G_, int c_) { nM = M / BM; nN = N / BM; nwg = nM * nN; G = G_; c = c_; }
    __host__ __device__ bool next(int i, Unit& u) const {
        const long L = (long)i * G + c; if (L >= nwg) return false;
        int wgid = (int)L; { const int q = nwg / NXCD, r = nwg % NXCD, xcd = wgid % NXCD, off = wgid / NXCD; wgid = (xcd < r ? xcd * (q + 1) : r * (q + 1) + (xcd - r) * q) + off; }
        const int nig = WGM * nN, gid = wgid / nig, fm = gid * WGM, gsz = (nM - fm) < WGM ? (nM - fm) : WGM;
        u.pm = fm + ((wgid % nig) % gsz); u.pn = (wgid % nig) / gsz; return true;
    }
    __device__ __forceinline__ void a_ready(const Unit&) const {}
    __device__ __forceinline__ void done(const Unit&) const {}
};

__device__ __forceinline__ unsigned cvt_pk_bf16(float lo, float hi) { unsigned r; asm volatile("v_cvt_pk_bf16_f32 %0, %1, %2" : "=v"(r) : "v"(lo), "v"(hi)); return r; }
__device__ __forceinline__ float bflo(unsigned w) { return __uint_as_float(w << 16); }
__device__ __forceinline__ float bfhi(unsigned w) { return __uint_as_float(w & 0xffff0000u); }
template <int ACT  > struct EpiBf16 {
    static constexpr bool PERM = true, AFTER_DRAIN = false;
    bf16_t* O; int ldc; const float* rowsc; int rsmode;
    __device__ __forceinline__ void pre(float (&rv)[8], const Unit& u, int wr, int fr) const {
        const int row0 = u.pm * BM + wr * 64 + fr;
#pragma unroll
        for (int q = 0; q < 8; ++q) rv[q] = rsmode ? rowsc[row0 + (q >> 2) * HALF + (q & 3) * 16] : 1.f;
    }
    __device__ __forceinline__ void operator()(const f32x4 (&acc)[2][2][4][2], const float (&rv)[8], const Unit& u, int wr, int wc, int fr, int fq) const {
        const int row0 = u.pm * BM + wr * 64 + fr; const int col0 = u.pn * BM + wc * 32 + 8 * fq;
        float rsv[2][4];
#pragma unroll
        for (int ai = 0; ai < 2; ++ai)
#pragma unroll
            for (int m = 0; m < 4; ++m) { float sc = 1.f; if (rsmode) { const float r_ = rv[ai * 4 + m]; sc = (rsmode == 1) ? r_ : 1.0f / sqrtf(r_ * (1.0f / 2048.0f) + 1e-6f); } rsv[ai][m] = sc; }
#pragma unroll
        for (int ai = 0; ai < 2; ++ai)
#pragma unroll
            for (int m = 0; m < 4; ++m) { bf16_t* rowp = O + (size_t)(row0 + ai * HALF + m * 16) * ldc + col0; const float sc = rsv[ai][m];
#pragma unroll
                for (int bj = 0; bj < 2; ++bj) { f32x4 v0 = acc[ai][bj][m][0] * sc, v1 = acc[ai][bj][m][1] * sc;
                    if (ACT == 2) {
#pragma unroll
                        for (int e = 0; e < 4; ++e) { float a = fmaxf(v0[e], 0.f), b = fmaxf(v1[e], 0.f); v0[e] = a * a; v1[e] = b * b; } }
                    u32x4 w; w.x = cvt_pk_bf16(v0[0], v0[1]); w.y = cvt_pk_bf16(v0[2], v0[3]); w.z = cvt_pk_bf16(v1[0], v1[1]); w.w = cvt_pk_bf16(v1[2], v1[3]);
                    *(u32x4*)(rowp + bj * HALF) = w; } }
    }
};
struct EpiGate {
    static constexpr bool PERM = true, AFTER_DRAIN = false;
    const bf16_t* PP; const bf16_t* XI; bf16_t* XO; float* FO; const float* rowsc; float* SSN; int ldc;
    __device__ __forceinline__ void pre(float (&rv)[8], const Unit& u, int wr, int fr) const {
        const int row0 = u.pm * BM + wr * 64 + fr;
#pragma unroll
        for (int q = 0; q < 8; ++q) rv[q] = rowsc[row0 + (q >> 2) * HALF + (q & 3) * 16];
    }
    __device__ __forceinline__ void operator()(const f32x4 (&acc)[2][2][4][2], const float (&rv)[8], const Unit& u, int wr, int wc, int fr, int fq) const {
        const int row0 = u.pm * BM + wr * 64 + fr; const int col0 = u.pn * BM + wc * 32 + 8 * fq;
        u32x4 pwn[2], xwn[2];
#pragma unroll
        for (int bj = 0; bj < 2; ++bj) { const size_t ro0 = (size_t)row0 * ldc + col0; pwn[bj] = *(const u32x4*)(PP + ro0 + bj * HALF); xwn[bj] = *(const u32x4*)(XI + ro0 + bj * HALF); }
#pragma unroll
        for (int ai = 0; ai < 2; ++ai)
#pragma unroll
            for (int m = 0; m < 4; ++m) { const int row = row0 + ai * HALF + m * 16; const size_t ro = (size_t)row * ldc + col0; const float sc = rv[ai * 4 + m];
                u32x4 pw[2], xw[2]; float ss = 0.f;
#pragma unroll
                for (int bj = 0; bj < 2; ++bj) { pw[bj] = pwn[bj]; xw[bj] = xwn[bj]; }
                if (ai * 4 + m < 7) { const int qn = ai * 4 + m + 1; const size_t ron = (size_t)(row0 + (qn >> 2) * HALF + (qn & 3) * 16) * ldc + col0;
#pragma unroll
                    for (int bj = 0; bj < 2; ++bj) { pwn[bj] = *(const u32x4*)(PP + ron + bj * HALF); xwn[bj] = *(const u32x4*)(XI + ron + bj * HALF); } }
#pragma unroll
                for (int bj = 0; bj < 2; ++bj) { const size_t off = ro + bj * HALF;
                    const f32x4 a0 = acc[ai][bj][m][0] * sc, a1 = acc[ai][bj][m][1] * sc; f32x4 x0, x1;
                    x0[0] = bflo(xw[bj].x) + bflo(pw[bj].x) * __builtin_amdgcn_rcpf(1.f + __expf(-a0[0])); x0[1] = bfhi(xw[bj].x) + bfhi(pw[bj].x) * __builtin_amdgcn_rcpf(1.f + __expf(-a0[1]));
                    x0[2] = bflo(xw[bj].y) + bflo(pw[bj].y) * __builtin_amdgcn_rcpf(1.f + __expf(-a0[2])); x0[3] = bfhi(xw[bj].y) + bfhi(pw[bj].y) * __builtin_amdgcn_rcpf(1.f + __expf(-a0[3]));
                    x1[0] = bflo(xw[bj].z) + bflo(pw[bj].z) * __builtin_amdgcn_rcpf(1.f + __expf(-a1[0])); x1[1] = bfhi(xw[bj].z) + bfhi(pw[bj].z) * __builtin_amdgcn_rcpf(1.f + __expf(-a1[1]));
                    x1[2] = bflo(xw[bj].w) + bflo(pw[bj].w) * __builtin_amdgcn_rcpf(1.f + __expf(-a1[2])); x1[3] = bfhi(xw[bj].w) + bfhi(pw[bj].w) * __builtin_amdgcn_rcpf(1.f + __expf(-a1[3]));
                    if (FO) { *(f32x4*)(FO + off) = x0; *(f32x4*)(FO + off + 4) = x1; }
                    else { u32x4 w; w.x = cvt_pk_bf16(x0[0], x0[1]); w.y = cvt_pk_bf16(x0[2], x0[3]); w.z = cvt_pk_bf16(x1[0], x1[1]); w.w = cvt_pk_bf16(x1[2], x1[3]); *(u32x4*)(XO + off) = w;
                        const float q0 = bflo(w.x), q1 = bfhi(w.x), q2 = bflo(w.y), q3 = bfhi(w.y), q4 = bflo(w.z), q5 = bfhi(w.z), q6 = bflo(w.w), q7 = bfhi(w.w);
                        ss += (q0 * q0 + q1 * q1) + (q2 * q2 + q3 * q3) + (q4 * q4 + q5 * q5) + (q6 * q6 + q7 * q7); } }
                if (SSN) { ss += __shfl_xor(ss, 16); ss += __shfl_xor(ss, 32); if (fq == 0) SSN[(size_t)row * 32 + u.pn * 4 + wc] = ss; } }
    }
};

template <class Epi, class Sched, bool ALIGN_EPI = false, bool SP2 = false>
__device__ __forceinline__ void gemm_phase(PG8_LAS unsigned char* lds, const Gemm g, const Sched& S, const Epi& E) {
    const int tid = opq_((int)threadIdx.x), wid = __builtin_amdgcn_readfirstlane(tid >> 6), lane = tid & 63, wr = wid >> 2, wc = wid & 3, fr = lane & 15, fq = lane >> 4;
    const int K = g.K, nt = K / BK;
    unsigned voffA[2], voffB[2];
#pragma unroll
    for (int i = 0; i < 2; ++i) { int R, C; stage_rc(tid * 16 + i * 8192, R, C); const int Rb = Epi::PERM ? ((R & ~31) + perm32(R & 31)) : R;
        voffA[i] = (unsigned)(R * K + C) * 2u; voffB[i] = (unsigned)(Rb * K + C) * 2u; }
    const size_t kstep = (size_t)(BK * 2);
    const size_t hstep = (size_t)HALF * K * 2;
    const size_t tstep = 2 * hstep;
    const unsigned ldsw = (unsigned)wid * 1024u;
    const int aoff = lds_byte(wr * 64 + fr, fq * 8), boff = lds_byte(wc * 32 + fr, fq * 8);
#define PG8_SA(b, h) (((b) * 2 + (h)) * HTB)
#define PG8_SB(b, h) ((4 + (b) * 2 + (h)) * HTB)
#define PG8_STAGE(bufoff, gbase, voff) do { _Pragma("unroll") for (int _i = 0; _i < 2; ++_i) \
        __builtin_amdgcn_global_load_lds((const unsigned*)((const char*)(gbase) + (voff)[_i]), (PG8_LAS unsigned*)(lds + (bufoff) + ldsw + _i * 8192), 16, 0, 0); } while (0)
#define PG8_LDA(dst, b, h) do { _Pragma("unroll") for (int m = 0; m < 4; ++m) _Pragma("unroll") for (int k = 0; k < 2; ++k) dst[m][k] = *(const PG8_LAS bf16x8*)(lds + PG8_SA(b, h) + aoff + m * 2048 + k * 1024); } while (0)
#define PG8_LDB(dst, b, h) do { _Pragma("unroll") for (int n = 0; n < 2; ++n) _Pragma("unroll") for (int k = 0; k < 2; ++k) dst[n][k] = *(const PG8_LAS bf16x8*)(lds + PG8_SB(b, h) + boff + n * 2048 + k * 1024); } while (0)
#define PG8_MMA(ai, bj, At, Bt) do { __builtin_amdgcn_s_setprio(1); _Pragma("unroll") for (int m = 0; m < 4; ++m) _Pragma("unroll") for (int n = 0; n < 2; ++n) _Pragma("unroll") for (int k = 0; k < 2; ++k) \
        acc[ai][bj][m][n] = __builtin_amdgcn_mfma_f32_16x16x32_bf16(Bt[n][k], At[m][k], acc[ai][bj][m][n], 0, 0, 0); __builtin_amdgcn_s_setprio(0); } while (0)
#define PG8_WAIT_V(n) asm volatile("s_waitcnt vmcnt(" #n ")" ::: "memory")
#define PG8_WAIT_L(n) asm volatile("s_waitcnt lgkmcnt(" #n ")" ::: "memory")
#define PG8_BAR __builtin_amdgcn_s_barrier()
#define PG8_SCHED __builtin_amdgcn_sched_barrier(0)
    Unit cur, nxt; int ui = 0;
    if (!S.next(0, cur)) return;
    f32x4 acc[2][2][4][2];
#pragma unroll
    for (int a = 0; a < 2; ++a)
#pragma unroll
        for (int b = 0; b < 2; ++b)
#pragma unroll
            for (int m = 0; m < 4; ++m)
#pragma unroll
                for (int n = 0; n < 2; ++n) acc[a][b][m][n] = (f32x4){0.f, 0.f, 0.f, 0.f};
    bf16x8 At[4][2], B0[2][2], B1[2][2];
    const char* cA = (const char*)g.A + (size_t)cur.pm * tstep; const char* cB = (const char*)g.Bt + (size_t)cur.pn * tstep;
    S.a_ready(cur);
    float rv[8]; E.pre(rv, cur, wr, fr);
    if constexpr (SP2) {
        PG8_STAGE(PG8_SB(0, 0), cB, voffB); PG8_STAGE(PG8_SB(0, 1), cB + hstep, voffB); PG8_STAGE(PG8_SA(0, 0), cA, voffA); PG8_STAGE(PG8_SA(0, 1), cA + hstep, voffA);
        if (wr == 1) PG8_BAR;
        PG8_WAIT_V(2); PG8_BAR;
        PG8_STAGE(PG8_SB(1, 0), cB + kstep, voffB); PG8_STAGE(PG8_SA(1, 0), cA + kstep, voffA); PG8_STAGE(PG8_SB(1, 1), cB + hstep + kstep, voffB);
        PG8_WAIT_V(6); PG8_BAR;
    } else {
        PG8_STAGE(PG8_SB(0, 0), cB, voffB); PG8_STAGE(PG8_SA(0, 0), cA, voffA); PG8_STAGE(PG8_SB(0, 1), cB + hstep, voffB); PG8_STAGE(PG8_SA(0, 1), cA + hstep, voffA);
        if (wr == 1) PG8_BAR;
        PG8_WAIT_V(4); PG8_BAR;
        PG8_STAGE(PG8_SB(1, 0), cB + kstep, voffB); PG8_STAGE(PG8_SA(1, 0), cA + kstep, voffA); PG8_STAGE(PG8_SB(1, 1), cB + hstep + kstep, voffB);
        PG8_WAIT_V(6); PG8_BAR;
    }
    for (;;) {
        const bool has_next = S.next(ui + 1, nxt);
        const char* nA = has_next ? (const char*)g.A + (size_t)nxt.pm * tstep : cA; const char* nB = has_next ? (const char*)g.Bt + (size_t)nxt.pn * tstep : cB;
        for (int t = 0; t < nt; t += 2) {
            const bool last = (t == nt - 2);
            const char* a1 = cA + (size_t)(t + 1) * kstep;
            const char* a2 = last ? nA : cA + (size_t)(t + 2) * kstep; const char* b2 = last ? nB : cB + (size_t)(t + 2) * kstep;
            const char* a3 = a2 + kstep; const char* b3 = b2 + kstep;
            if (last && has_next) S.a_ready(nxt);
            if constexpr (SP2) {
            PG8_LDB(B0, 0, 0); PG8_LDB(B1, 0, 1); PG8_SCHED; PG8_LDA(At, 0, 0); PG8_STAGE(PG8_SA(1, 1), a1 + hstep, voffA);
            PG8_WAIT_V(8); PG8_WAIT_L(0); PG8_BAR; PG8_MMA(0, 0, At, B0); PG8_MMA(0, 1, At, B1); PG8_BAR; PG8_SCHED;
            PG8_LDA(At, 0, 1); PG8_STAGE(PG8_SB(0, 0), b2, voffB); PG8_STAGE(PG8_SB(0, 1), b2 + hstep, voffB); PG8_STAGE(PG8_SA(0, 0), a2, voffA);
            PG8_WAIT_V(8); PG8_WAIT_L(0); PG8_BAR; PG8_MMA(1, 0, At, B0); PG8_MMA(1, 1, At, B1); PG8_BAR; PG8_SCHED;
            PG8_LDB(B0, 1, 0); PG8_LDB(B1, 1, 1); PG8_SCHED; PG8_LDA(At, 1, 0); PG8_STAGE(PG8_SA(0, 1), a2 + hstep, voffA);
            PG8_WAIT_V(8); PG8_WAIT_L(0); PG8_BAR; PG8_MMA(0, 0, At, B0); PG8_MMA(0, 1, At, B1); PG8_BAR; PG8_SCHED;
            PG8_LDA(At, 1, 1); PG8_STAGE(PG8_SB(1, 0), b3, voffB); PG8_STAGE(PG8_SB(1, 1), b3 + hstep, voffB); PG8_STAGE(PG8_SA(1, 0), a3, voffA);
            PG8_WAIT_V(8); PG8_WAIT_L(0); PG8_BAR; PG8_MMA(1, 0, At, B0); PG8_MMA(1, 1, At, B1); PG8_BAR; PG8_SCHED;
            } else {
            PG8_LDB(B0, 0, 0); PG8_SCHED; PG8_LDA(At, 0, 0); PG8_STAGE(PG8_SA(1, 1), a1 + hstep, voffA);
            PG8_WAIT_L(8); PG8_BAR; PG8_WAIT_L(0); PG8_MMA(0, 0, At, B0); PG8_BAR; PG8_SCHED;
            PG8_LDB(B1, 0, 1); PG8_STAGE(PG8_SB(0, 0), b2, voffB);
            PG8_BAR; PG8_WAIT_L(0); PG8_MMA(0, 1, At, B1); PG8_BAR;
            PG8_LDA(At, 0, 1); PG8_STAGE(PG8_SA(0, 0), a2, voffA);
            PG8_BAR; PG8_WAIT_L(0); PG8_MMA(1, 0, At, B0); PG8_BAR; PG8_SCHED;
            PG8_STAGE(PG8_SB(0, 1), b2 + hstep, voffB);
            PG8_WAIT_V(6); PG8_BAR; PG8_MMA(1, 1, At, B1); PG8_BAR;
            PG8_LDB(B0, 1, 0); PG8_SCHED; PG8_LDA(At, 1, 0); PG8_STAGE(PG8_SA(0, 1), a2 + hstep, voffA);
            PG8_WAIT_L(8); PG8_BAR; PG8_WAIT_L(0); PG8_MMA(0, 0, At, B0); PG8_BAR; PG8_SCHED;
            PG8_LDB(B1, 1, 1); PG8_STAGE(PG8_SB(1, 0), b3, voffB);
            PG8_BAR; PG8_WAIT_L(0); PG8_MMA(0, 1, At, B1); PG8_BAR;
            PG8_LDA(At, 1, 1); PG8_STAGE(PG8_SA(1, 0), a3, voffA);
            PG8_BAR; PG8_WAIT_L(0); PG8_MMA(1, 0, At, B0); PG8_BAR; PG8_SCHED;
            PG8_STAGE(PG8_SB(1, 1), b3 + hstep, voffB);
            PG8_WAIT_V(6); PG8_BAR; PG8_MMA(1, 1, At, B1); PG8_BAR;
            }
        }
        if constexpr (ALIGN_EPI) { if (wr == 0) PG8_BAR; }
        if constexpr (!Epi::AFTER_DRAIN) { E(acc, rv, cur, wr, wc, fr, fq); S.done(cur); }
        if (!has_next) break;
#pragma unroll
        for (int a = 0; a < 2; ++a)
#pragma unroll
            for (int b = 0; b < 2; ++b)
#pragma unroll
                for (int m = 0; m < 4; ++m)
#pragma unroll
                    for (int n = 0; n < 2; ++n) acc[a][b][m][n] = (f32x4){0.f, 0.f, 0.f, 0.f};
        cur = nxt; cA = nA; cB = nB; ++ui;
        E.pre(rv, cur, wr, fr);
        if constexpr (ALIGN_EPI) { if (wr == 1) PG8_BAR; }
    }
    PG8_WAIT_V(0);
    if constexpr (!ALIGN_EPI) { if (wr == 0) PG8_BAR; }
    PG8_BAR;
    if constexpr (Epi::AFTER_DRAIN) { E.fused(acc, cur, wr, wc, fr, fq, lds, wid, lane); S.done(cur); }
#undef PG8_SA
#undef PG8_SB
#undef PG8_STAGE
#undef PG8_LDA
#undef PG8_LDB
#undef PG8_MMA
#undef PG8_WAIT_V
#undef PG8_WAIT_L
#undef PG8_BAR
#undef PG8_SCHED
}
}
typedef unsigned short bf16;
typedef float f32x4 __attribute__((ext_vector_type(4)));
typedef unsigned u32x4 __attribute__((ext_vector_type(4)));
typedef unsigned u32x2 __attribute__((ext_vector_type(2)));
constexpr int BATCH = 2, SEQ = 16384, DM = 2048, DEPTH = 4, M = BATCH * SEQ, DFF = 8192, PLE = 256;
constexpr int EV_IN = 5136, EV_INP = 5376, OD_IN = 6432, OD_INP = 6656;
constexpr int EZ_Q = 512, EZ_K = 1280, EZ_V = 2048, EZ_G = 3584, EZ_R = 5120;
constexpr int OZ_HW = 3072, OZ_HA = 3136, OZ_HG = 3200, OZ_DQ = 3360, OZ_DK = 4384, OZ_DV = 5408;
constexpr size_t MiB = 1u << 20;
constexpr size_t WS_CTL = 0, WS_WIN = 1 * MiB, WS_WOUT = 27 * MiB, WS_WUP = 35 * MiB, WS_WDN = 67 * MiB, WS_WGT = 99 * MiB, WS_WPJ = 107 * MiB;
constexpr size_t WS_H = 110 * MiB, WS_XB = 238 * MiB  , WS_MIX = 366 * MiB, WS_PB = 494 * MiB, WS_Z = 510 * MiB, WS_HID = 510 * MiB;
constexpr size_t WS_SMALL = 108 * MiB, WS_ML = 1184 * MiB, WS_DEC = 1136 * MiB, WS_T_EV = 846 * MiB, WS_T_OD = 926 * MiB, WS_NEED = 1200 * MiB;
constexpr size_t SLOT = 64 * MiB;

typedef float f32x2_t_ __attribute__((ext_vector_type(2))); typedef __bf16 bf16x2_t_ __attribute__((ext_vector_type(2)));
__device__ __forceinline__ unsigned f2bf(float f) { return (unsigned)__builtin_bit_cast(unsigned short, (__bf16)f); }
__device__ __forceinline__ unsigned pk2(float lo, float hi) { const f32x2_t_ v = {lo, hi}; return __builtin_bit_cast(unsigned, __builtin_convertvector(v, bf16x2_t_)); }
__device__ __forceinline__ float bf2f(bf16 h) { return __uint_as_float((unsigned)h << 16); }
__device__ __forceinline__ float bflo_(unsigned w) { return __uint_as_float(w << 16); }
__device__ __forceinline__ float bfhi_(unsigned w) { return __uint_as_float(w & 0xffff0000u); }
__device__ __forceinline__ float wave_sum(float v) {
#pragma unroll
    for (int o = 1; o < 64; o <<= 1) v += __shfl_xor(v, o);
    return v;
}
__device__ __forceinline__ float sigmoidf_(float x) { return 1.f / (1.f + __expf(-x)); }
__device__ __forceinline__ float softplusf_(float x) { return fmaxf(x, 0.f) + __logf(1.f + __expf(-fabsf(x))); }

#ifndef LAS
#define LAS __attribute__((address_space(3)))
#endif
typedef LAS unsigned char lds_t;
typedef short bf16x8 __attribute__((ext_vector_type(8)));
typedef short s16x4 __attribute__((ext_vector_type(4)));
typedef short v4i16_t __attribute__((ext_vector_type(4)));
__device__ __forceinline__ s16x4 vtr(const lds_t* p) { return __builtin_bit_cast(s16x4, __builtin_amdgcn_ds_read_tr16_b64_v4i16((LAS v4i16_t*)p)); }
__device__ __forceinline__ bf16x8 cat8(s16x4 a, s16x4 b) { bf16x8 r; r[0] = a[0]; r[1] = a[1]; r[2] = a[2]; r[3] = a[3]; r[4] = b[0]; r[5] = b[1]; r[6] = b[2]; r[7] = b[3]; return r; }
#define LBAR() do { asm volatile("s_waitcnt lgkmcnt(0)" ::: "memory"); __builtin_amdgcn_s_barrier(); asm volatile("" ::: "memory"); } while (0)
__device__ __forceinline__ f32x4 mfma16(bf16x8 a, bf16x8 b, f32x4 c) { return __builtin_amdgcn_mfma_f32_16x16x32_bf16(a, b, c, 0, 0, 0); }
__device__ __forceinline__ u32x2 pack4(f32x4 v) { u32x2 o; o.x = pk2(v[0], v[1]); o.y = pk2(v[2], v[3]); return o; }
__device__ __forceinline__ f32x4 unpack4(u32x2 w) { f32x4 v; v[0] = __uint_as_float(w.x << 16); v[1] = __uint_as_float(w.x & 0xffff0000u); v[2] = __uint_as_float(w.y << 16); v[3] = __uint_as_float(w.y & 0xffff0000u); return v; }
constexpr int NCHUNK = SEQ / 64;
constexpr int GLA_UNITS = BATCH * 4 * NCHUNK;

__device__ __forceinline__ void ph_pool(lds_t* lds, int vcu, int G, const bf16* __restrict__ Z, const float* __restrict__ pw, const float* __restrict__ ps, bf16* __restrict__ MIX) {
    const int tid = opq_((int)threadIdx.x), wid = tid >> 6, lane = tid & 63, fr = lane & 15, fq = lane >> 4;
    constexpr int WST = 136;
    for (int u = vcu; u < M / 128; u += G) {
        const int m = u * 128 + wid * 16 + fr, t = m % SEQ;
        for (int g = 0; g < 4; ++g) {
            __syncthreads();
            { float sw[32];
#pragma unroll
              for (int i = 0; i < 32; ++i) sw[i] = pw[(size_t)g * 16384 + tid + 512 * i];
#pragma unroll
              for (int i = 0; i < 32; ++i) { const int idx = tid + 512 * i, c = idx >> 7, d = idx & 127; ((LAS bf16*)lds)[d * WST + c] = (bf16)f2bf(sw[i]); } }
            __syncthreads();
            const int w = 2 << g, cnt = (t + 1 < w) ? (t + 1) : w; const float icnt = 1.0f / (float)cnt;
            f32x4 acc[8];
#pragma unroll
            for (int dt = 0; dt < 8; ++dt) acc[dt] = (f32x4){0.f, 0.f, 0.f, 0.f};
#pragma unroll
            for (int ks = 0; ks < 4; ++ks) {
                const bf16* zp = Z + (size_t)m * EV_INP + g * 128 + 32 * ks + 8 * fq;
                float s[8], own[8];
                { const u32x4 r = *(const u32x4*)zp; own[0] = bflo_(r.x); own[1] = bfhi_(r.x); own[2] = bflo_(r.y); own[3] = bfhi_(r.y); own[4] = bflo_(r.z); own[5] = bfhi_(r.z); own[6] = bflo_(r.w); own[7] = bfhi_(r.w); }
#pragma unroll
                for (int e = 0; e < 8; ++e) s[e] = own[e];
#pragma unroll 5
                for (int j = 1; j < w; ++j) { const float mk = (j < cnt) ? 1.f : 0.f; const u32x4 r = *(const u32x4*)(zp - (size_t)(j < cnt ? j : 0) * EV_INP);
                    s[0] += mk * bflo_(r.x); s[1] += mk * bfhi_(r.x); s[2] += mk * bflo_(r.y); s[3] += mk * bfhi_(r.y); s[4] += mk * bflo_(r.z); s[5] += mk * bfhi_(r.z); s[6] += mk * bflo_(r.w); s[7] += mk * bfhi_(r.w); }
                u32x4 pk; pk.x = pk2(s[0] * icnt - own[0], s[1] * icnt - own[1]); pk.y = pk2(s[2] * icnt - own[2], s[3] * icnt - own[3]);
                pk.z = pk2(s[4] * icnt - own[4], s[5] * icnt - own[5]); pk.w = pk2(s[6] * icnt - own[6], s[7] * icnt - own[7]);
                const bf16x8 bfrag = __builtin_bit_cast(bf16x8, pk);
#pragma unroll
                for (int dt = 0; dt < 8; ++dt) { const bf16x8 afrag = *(const LAS bf16x8*)(lds + ((16 * dt + fr) * WST + 32 * ks + 8 * fq) * 2); acc[dt] = mfma16(afrag, bfrag, acc[dt]); }
            }
#pragma unroll
            for (int dt = 0; dt < 8; ++dt) { const int d = 16 * dt + 4 * fq; const f32x4 sc = *(const f32x4*)(ps + g * 128 + d);
                *(u32x2*)(MIX + (size_t)m * DM + g * 128 + d) = pack4(acc[dt] * sc); }
        }
    }
}
constexpr int G1_QT = 0, G1_KT = 25600, G1_KH = 51200, G1_VT = 76800, G1_SCR = 126976, G1_LDS = 145664;
constexpr int G1_W2 = G1_SCR, G1_BIAS = G1_SCR + 12288, G1_GLR = G1_BIAS + 768, G1_TOT = G1_GLR + 4096, G1_AT = G1_SCR;
constexpr int QST = 400, VST = 784, AST = 144;
template <bool FRONT> __device__ __forceinline__ void ph_gla1(lds_t* lds, int vcu, int G, const bf16* __restrict__ Z, const float* __restrict__ w2, const float* __restrict__ gb, bf16* __restrict__ OI, bf16* __restrict__ QG, bf16* __restrict__ ST, float* __restrict__ DEC) {
    const float scale = 0.07216878364870323f;
    for (int u = vcu; u < GLA_UNITS; u += G) {
        const int tid = opq_((int)threadIdx.x), wid = tid >> 6, lane = tid & 63, fr = lane & 15, fq = lane >> 4, lq = fr >> 2, lp = fr & 3;
        const int b = u / (4 * NCHUNK), h = (u / NCHUNK) & 3, n = u % NCHUNK; const size_t m0 = (size_t)b * SEQ + (size_t)n * 64;
        __syncthreads();
        { u32x4 sv[6], sq[3], sk[3]; float sw[6]; bf16 sg[2]; float sb = 0.f;
#pragma unroll
          for (int i = 0; i < 3; ++i) { const int q = tid + 512 * i, row = q / 24, cc = q % 24; sq[i] = *(const u32x4*)(Z + (m0 + row) * EV_INP + EZ_Q + h * 192 + cc * 8); sk[i] = *(const u32x4*)(Z + (m0 + row) * EV_INP + EZ_K + h * 192 + cc * 8); }
#pragma unroll
          for (int i = 0; i < 6; ++i) { const int q = tid + 512 * i, row = q / 48, cc = q % 48; sv[i] = *(const u32x4*)(Z + (m0 + row) * EV_INP + EZ_V + h * 384 + cc * 8); }
#pragma unroll
          for (int i = 0; i < 6; ++i) { const int q = tid + 512 * i, r = q / 192, d = q % 192; sw[i] = w2[r * 768 + h * 192 + d]; }
          if (tid < 192) sb = gb[h * 192 + tid];
#pragma unroll
          for (int i = 0; i < 2; ++i) { const int q = tid + 512 * i, row = q >> 4, r = q & 15; sg[i] = Z[(m0 + row) * EV_INP + EZ_R + r]; }
#pragma unroll
          for (int i = 0; i < 6; ++i) { const int q = tid + 512 * i, row = q / 48, cc = q % 48; *(LAS u32x4*)(lds + G1_VT + row * VST + cc * 16) = sv[i]; }
#pragma unroll
          for (int i = 0; i < 3; ++i) { const int q = tid + 512 * i, row = q / 24, cc = q % 24; *(LAS u32x4*)(lds + G1_QT + row * QST + cc * 16) = sq[i]; *(LAS u32x4*)(lds + G1_KT + row * QST + cc * 16) = sk[i]; }
#pragma unroll
          for (int i = 0; i < 6; ++i) ((LAS float*)(lds + G1_W2))[tid + 512 * i] = sw[i];
          if (tid < 192) ((LAS float*)(lds + G1_BIAS))[tid] = sb;
#pragma unroll
          for (int i = 0; i < 2; ++i) ((LAS float*)(lds + G1_GLR))[tid + 512 * i] = bf2f(sg[i]); }
        __syncthreads();
        float lg[3][8];
#pragma unroll
        for (int k = 0; k < 3; ++k) { const int task = tid + 512 * k, d = task % 192, seg = task / 192;
            float wc[16];
#pragma unroll
            for (int r = 0; r < 16; ++r) wc[r] = ((LAS float*)(lds + G1_W2))[r * 192 + d];
            const float b0 = ((LAS float*)(lds + G1_BIAS))[d]; float run = 0.f;
#pragma unroll
            for (int s = 0; s < 8; ++s) { const LAS f32x4* gp = (const LAS f32x4*)(lds + G1_GLR + (seg * 8 + s) * 64); float x = b0;
#pragma unroll
                for (int r4 = 0; r4 < 4; ++r4) { const f32x4 g4 = gp[r4]; x += g4[0] * wc[4 * r4] + g4[1] * wc[4 * r4 + 1] + g4[2] * wc[4 * r4 + 2] + g4[3] * wc[4 * r4 + 3]; }
                lg[k][s] = -softplusf_(-x) * (1.0f / 16.0f); run += lg[k][s]; }
            ((LAS float*)(lds + G1_TOT))[seg * 192 + d] = run; }
        __syncthreads();
#pragma unroll
        for (int k = 0; k < 3; ++k) { const int task = tid + 512 * k, d = task % 192, seg = task / 192;
            float run = 0.f, blast = 0.f;
#pragma unroll
            for (int j = 0; j < 8; ++j) { const float tj = ((LAS float*)(lds + G1_TOT))[j * 192 + d]; blast += tj; run += (j < seg) ? tj : 0.f; }
            const float eb = __expf(blast);
            if (seg == 0) DEC[(size_t)u * 192 + d] = eb;
#pragma unroll
            for (int s = 0; s < 8; ++s) { const int t = seg * 8 + s;
                run += lg[k][s]; const float bb = run; const float en = __expf(-bb);
                const float qv = bf2f(*(const LAS bf16*)(lds + G1_QT + t * QST + d * 2)), kv = bf2f(*(const LAS bf16*)(lds + G1_KT + t * QST + d * 2));
                *(LAS bf16*)(lds + G1_QT + t * QST + d * 2) = (bf16)f2bf(qv * scale * __expf(bb));
                *(LAS bf16*)(lds + G1_KT + t * QST + d * 2) = (bf16)f2bf(kv * en);
                *(LAS bf16*)(lds + G1_KH + t * QST + d * 2) = (bf16)f2bf(kv * (eb * en)); } }
        __syncthreads();
        if (FRONT) continue;
        { const int it = wid >> 1;
#pragma unroll
            for (int jj = 0; jj < 2; ++jj) { const int jt = 2 * (wid & 1) + jj; f32x4 acc = (f32x4){0.f, 0.f, 0.f, 0.f};
                if (jt <= it) {
#pragma unroll
                    for (int ks = 0; ks < 6; ++ks) { const bf16x8 a = *(const LAS bf16x8*)(lds + G1_QT + (16 * it + fr) * QST + (32 * ks + 8 * fq) * 2);
                        const bf16x8 bb = *(const LAS bf16x8*)(lds + G1_KT + (16 * jt + fr) * QST + (32 * ks + 8 * fq) * 2); acc = mfma16(a, bb, acc); } }
#pragma unroll
                for (int r = 0; r < 4; ++r) { const int i = 16 * it + 4 * fq + r, j = 16 * jt + fr; const float v = (j <= i) ? acc[r] : 0.f;
                    *(LAS bf16*)(lds + G1_AT + i * AST + j * 2) = (bf16)f2bf(v); } } }
        __syncthreads();
#pragma unroll
        for (int i = 0; i < 3; ++i) { const int q = tid + 512 * i, row = q / 24, cc = q % 24;
            *(u32x4*)(QG + (m0 + row) * 768 + h * 192 + cc * 8) = *(const LAS u32x4*)(lds + G1_QT + row * QST + cc * 16); }
        bf16x8 vf[3][2];
#pragma unroll
        for (int el = 0; el < 3; ++el)
#pragma unroll
            for (int ks = 0; ks < 2; ++ks) { const lds_t* p = lds + G1_VT + (32 * ks + 8 * fq + lq) * VST + (16 * (3 * wid + el) + 4 * lp) * 2; vf[el][ks] = cat8(vtr(p), vtr(p + 4 * VST)); }
        { f32x4 acc[3][4];
#pragma unroll
            for (int el = 0; el < 3; ++el)
#pragma unroll
                for (int it = 0; it < 4; ++it) acc[el][it] = (f32x4){0.f, 0.f, 0.f, 0.f};
#pragma unroll
            for (int ks = 0; ks < 2; ++ks)
#pragma unroll
                for (int it = 0; it < 4; ++it) { const bf16x8 bb = *(const LAS bf16x8*)(lds + G1_AT + (16 * it + fr) * AST + (32 * ks + 8 * fq) * 2);
#pragma unroll
                    for (int el = 0; el < 3; ++el) acc[el][it] = mfma16(vf[el][ks], bb, acc[el][it]); }
#pragma unroll
            for (int el = 0; el < 3; ++el)
#pragma unroll
                for (int it = 0; it < 4; ++it) *(u32x2*)(OI + (m0 + 16 * it + fr) * 1536 + h * 384 + 16 * (3 * wid + el) + 4 * fq) = pack4(acc[el][it]); }
        asm volatile("s_waitcnt lgkmcnt(0)" ::: "memory"); __builtin_amdgcn_s_barrier(); asm volatile("" ::: "memory");
        { lds_t* zt = lds + G1_QT + wid * 6144;
#pragma unroll 1
          for (int part = 0; part < 3; ++part) { f32x4 acc[4][3];
#pragma unroll
            for (int dl = 0; dl < 4; ++dl)
#pragma unroll
                for (int el = 0; el < 3; ++el) acc[dl][el] = (f32x4){0.f, 0.f, 0.f, 0.f};
#pragma unroll
            for (int ks = 0; ks < 2; ++ks)
#pragma unroll
                for (int dl = 0; dl < 4; ++dl) { const lds_t* p = lds + G1_KH + (32 * ks + 8 * fq + lq) * QST + (16 * (4 * part + dl) + 4 * lp) * 2; const bf16x8 a = cat8(vtr(p), vtr(p + 4 * QST));
#pragma unroll
                    for (int el = 0; el < 3; ++el) acc[dl][el] = mfma16(a, vf[el][ks], acc[dl][el]); }
#pragma unroll
            for (int dl = 0; dl < 4; ++dl)
#pragma unroll
                for (int el = 0; el < 3; ++el) { const int e = 16 * el + fr, c = 2 * dl + (fq >> 1); *(LAS u32x2*)(zt + e * 128 + ((c ^ (e & 7)) << 4) + (fq & 1) * 8) = pack4(acc[dl][el]); }
            asm volatile("s_waitcnt lgkmcnt(0)" ::: "memory");
#pragma unroll
            for (int i = 0; i < 6; ++i) { const int idx = lane + 64 * i, e = idx >> 3, c = idx & 7;
                *(u32x4*)(ST + ((size_t)u * 384 + 48 * wid + e) * 192 + 64 * part + 8 * c) = *(const LAS u32x4*)(zt + e * 128 + ((c ^ (e & 7)) << 4)); }
            asm volatile("s_waitcnt lgkmcnt(0)" ::: "memory"); } }
    }
}
__device__ __forceinline__ void ph_gla2(int vcu, int G, bf16* ST, const float* __restrict__ DEC) {
    const int g = vcu * 512 + opq_((int)threadIdx.x);
    if (g < 8 * 384 * 24) {
    const int bh = g / 9216, rem = g % 9216, e = rem / 24, d8 = rem % 24;
    float S[8];
#pragma unroll
    for (int i = 0; i < 8; ++i) S[i] = 0.f;
    for (int n0 = 0; n0 < NCHUNK; n0 += 8) {
        u32x4 zin[8]; f32x4 dc[8][2];
#pragma unroll
        for (int k = 0; k < 8; ++k) { const size_t un = (size_t)bh * NCHUNK + n0 + k; zin[k] = *(const u32x4*)(ST + (un * 384 + e) * 192 + 8 * d8);
            dc[k][0] = *(const f32x4*)(DEC + un * 192 + 8 * d8); dc[k][1] = *(const f32x4*)(DEC + un * 192 + 8 * d8 + 4); }
#pragma unroll
        for (int k = 0; k < 8; ++k) { const size_t un = (size_t)bh * NCHUNK + n0 + k;
            u32x4 o; o.x = pk2(S[0], S[1]); o.y = pk2(S[2], S[3]); o.z = pk2(S[4], S[5]); o.w = pk2(S[6], S[7]);
            *(u32x4*)(ST + (un * 384 + e) * 192 + 8 * d8) = o;
            S[0] = S[0] * dc[k][0][0] + bflo_(zin[k].x); S[1] = S[1] * dc[k][0][1] + bfhi_(zin[k].x); S[2] = S[2] * dc[k][0][2] + bflo_(zin[k].y); S[3] = S[3] * dc[k][0][3] + bfhi_(zin[k].y);
            S[4] = S[4] * dc[k][1][0] + bflo_(zin[k].z); S[5] = S[5] * dc[k][1][1] + bfhi_(zin[k].z); S[6] = S[6] * dc[k][1][2] + bflo_(zin[k].w); S[7] = S[7] * dc[k][1][3] + bfhi_(zin[k].w); }
    }
    }
}
__device__ __forceinline__ void ph_gla3(lds_t* lds, int vcu, int G, const bf16* __restrict__ Z, const bf16* __restrict__ ST, const float* __restrict__ gn, const bf16* __restrict__ OI, const bf16* __restrict__ QG, bf16* __restrict__ MIX) {
    constexpr int OST = 1568;
    constexpr int QL_OFF = 64 * OST, QL_ST = 400;
    bf16x8 afr[6][3]; u32x4 sq[3];
#define GLA3_PF(uu) do { const int t_ = opq_((int)threadIdx.x), w_ = t_ >> 6, l_ = t_ & 63; const int hq_ = ((uu) / NCHUNK) & 3; const size_t mq_ = (size_t)((uu) / (4 * NCHUNK)) * SEQ + (size_t)((uu) % NCHUNK) * 64; \
        _Pragma("unroll") for (int ks = 0; ks < 6; ++ks) _Pragma("unroll") for (int el = 0; el < 3; ++el) afr[ks][el] = *(const bf16x8*)(ST + ((size_t)(uu) * 384 + 16 * (3 * w_ + el) + (l_ & 15)) * 192 + 32 * ks + 8 * (l_ >> 4)); \
        _Pragma("unroll") for (int i = 0; i < 3; ++i) { const int q = t_ + 512 * i, row = q / 24, cc = q % 24; sq[i] = *(const u32x4*)(QG + (mq_ + row) * 768 + hq_ * 192 + cc * 8); } } while (0)
    if (vcu < GLA_UNITS) GLA3_PF(vcu);
    for (int u = vcu; u < GLA_UNITS; u += G) {
        const int tid = opq_((int)threadIdx.x), wid = tid >> 6, lane = tid & 63, fr = lane & 15, fq = lane >> 4;
        const int b = u / (4 * NCHUNK), h = (u / NCHUNK) & 3, n = u % NCHUNK; const size_t m0 = (size_t)b * SEQ + (size_t)n * 64;
        const int le = lane < 48 ? lane : 47; const bool act = lane < 48; const int e0 = 8 * le;
        u32x4 oiw[8], gow[8];
#pragma unroll
        for (int t = 0; t < 8; ++t) { const size_t m = m0 + 8 * wid + t; oiw[t] = *(const u32x4*)(OI + m * 1536 + h * 384 + e0); gow[t] = *(const u32x4*)(Z + m * EV_INP + EZ_G + h * 384 + e0); }
        f32x4 acc[3][4];
#pragma unroll
        for (int el = 0; el < 3; ++el)
#pragma unroll
            for (int it = 0; it < 4; ++it) acc[el][it] = (f32x4){0.f, 0.f, 0.f, 0.f};
        LBAR();
#pragma unroll
        for (int i = 0; i < 3; ++i) { const int q = tid + 512 * i, row = q / 24, cc = q % 24; *(LAS u32x4*)(lds + QL_OFF + row * QL_ST + cc * 16) = sq[i]; }
        LBAR();
#pragma unroll
        for (int ks = 0; ks < 6; ++ks) { bf16x8 bb[4];
#pragma unroll
            for (int it = 0; it < 4; ++it) bb[it] = *(const LAS bf16x8*)(lds + QL_OFF + (16 * it + fr) * QL_ST + (32 * ks + 8 * fq) * 2);
#pragma unroll
            for (int el = 0; el < 3; ++el)
#pragma unroll
                for (int it = 0; it < 4; ++it) acc[el][it] = mfma16(afr[ks][el], bb[it], acc[el][it]); }
#pragma unroll
        for (int el = 0; el < 3; ++el)
#pragma unroll
            for (int it = 0; it < 4; ++it) *(LAS f32x4*)(lds + (16 * it + fr) * OST + (16 * (3 * wid + el) + 4 * fq) * 4) = acc[el][it];
        LBAR();
        if (u + G < GLA_UNITS) GLA3_PF(u + G);
        const f32x4 g0 = *(const f32x4*)(gn + e0), g1 = *(const f32x4*)(gn + e0 + 4);
#pragma unroll
        for (int t = 0; t < 8; ++t) { const int tok = 8 * wid + t; const LAS f32x4* op = (const LAS f32x4*)(lds + tok * OST + e0 * 4); f32x4 o0 = op[0], o1 = op[1];
            o0[0] += bflo_(oiw[t].x); o0[1] += bfhi_(oiw[t].x); o0[2] += bflo_(oiw[t].y); o0[3] += bfhi_(oiw[t].y); o1[0] += bflo_(oiw[t].z); o1[1] += bfhi_(oiw[t].z); o1[2] += bflo_(oiw[t].w); o1[3] += bfhi_(oiw[t].w);
            float ss = act ? ((o0[0] * o0[0] + o0[1] * o0[1]) + (o0[2] * o0[2] + o0[3] * o0[3])) + ((o1[0] * o1[0] + o1[1] * o1[1]) + (o1[2] * o1[2] + o1[3] * o1[3])) : 0.f;
            ss = wave_sum(ss); const float rstd = 1.0f / sqrtf(ss * (1.0f / 384.0f) + 1e-6f);
            f32x4 q0, q1; q0[0] = bflo_(gow[t].x); q0[1] = bfhi_(gow[t].x); q0[2] = bflo_(gow[t].y); q0[3] = bfhi_(gow[t].y); q1[0] = bflo_(gow[t].z); q1[1] = bfhi_(gow[t].z); q1[2] = bflo_(gow[t].w); q1[3] = bfhi_(gow[t].w);
            u32x4 w;
            w.x = pk2(o0[0] * rstd * g0[0] * (q0[0] * sigmoidf_(q0[0])), o0[1] * rstd * g0[1] * (q0[1] * sigmoidf_(q0[1]))); w.y = pk2(o0[2] * rstd * g0[2] * (q0[2] * sigmoidf_(q0[2])), o0[3] * rstd * g0[3] * (q0[3] * sigmoidf_(q0[3])));
            w.z = pk2(o1[0] * rstd * g1[0] * (q1[0] * sigmoidf_(q1[0])), o1[1] * rstd * g1[1] * (q1[1] * sigmoidf_(q1[1]))); w.w = pk2(o1[2] * rstd * g1[2] * (q1[2] * sigmoidf_(q1[2])), o1[3] * rstd * g1[3] * (q1[3] * sigmoidf_(q1[3])));
            if (act) *(u32x4*)(MIX + (m0 + tok) * DM + 512 + h * 384 + e0) = w; }
    }
#undef GLA3_PF
}

struct RwkvP { const float *mu, *w0, *w2, *a0, *a2, *g2, *kk, *ka, *rk, *lnw, *lnb; };
struct RwkvW { const bf16 *W2T, *A2T, *G2T; };
struct RwkvB { bf16 *R, *LD, *KM, *V, *KK, *BV, *G, *Y; float* BON; };
constexpr int ACT_ST = 656, PRM_OFF = 64 * 656, AS_OFF = PRM_OFF + 32768, AS_ST = 144, AS_WAVE = 64 * AS_ST;
__device__ __forceinline__ f32x4 prm4(const lds_t* lds, int which, int c) { return *(const LAS f32x4*)(lds + PRM_OFF + (which * 1024 + c) * 4); }
__device__ __forceinline__ f32x4 tshL(u32x2 cur, u32x2 prev, f32x4 mu4, bool hp) { const f32x4 c = unpack4(cur); const f32x4 p = unpack4(prev) * (hp ? 1.f : 0.f); return c + (p - c) * mu4; }
constexpr int ACT_ST_unused = 0;
__device__ __forceinline__ f32x4 tsh4(const bf16* zc, bool hasprev, int col, const float* __restrict__ mu) {
    const f32x4 c = unpack4(*(const u32x2*)(zc + col));
    const f32x4 p = unpack4(*(const u32x2*)(zc - (hasprev ? OD_INP : 0) + col)) * (hasprev ? 1.f : 0.f);
    const f32x4 m4 = *(const f32x4*)(mu + col); return c + (p - c) * m4;
}
template <int PASS> __device__ __forceinline__ void rwkv_prep_pass(lds_t* lds, size_t m0, const bf16* __restrict__ Z, const RwkvP& P, const RwkvW& W, const RwkvB& B) {
    const int tid = opq_((int)threadIdx.x), wid = tid >> 6, lane = tid & 63, fr = lane & 15, fq = lane >> 4;
    constexpr int NKS = (PASS == 2) ? 6 : 2; constexpr int WST = (PASS == 2) ? 192 : 64; constexpr int COFF = (PASS == 0) ? 0 : (PASS == 1 ? 64 : 128);
    const bf16* Wt = (PASS == 0) ? W.W2T : (PASS == 1 ? W.A2T : W.G2T);
#pragma unroll 1
    for (int hh = 0; hh < 2; ++hh) {
        const int cb = 128 * wid + 64 * hh;
        f32x4 acc[4][4];
#pragma unroll
        for (int ct = 0; ct < 4; ++ct)
#pragma unroll
            for (int tt = 0; tt < 4; ++tt) acc[ct][tt] = (f32x4){0.f, 0.f, 0.f, 0.f};
        bf16x8 wa[NKS][4];
#pragma unroll
        for (int ks = 0; ks < NKS; ++ks)
#pragma unroll
            for (int ct = 0; ct < 4; ++ct) wa[ks][ct] = *(const bf16x8*)(Wt + (size_t)(cb + 16 * ct + fr) * WST + 32 * ks + 8 * fq);
#pragma unroll
        for (int ks = 0; ks < NKS; ++ks) { bf16x8 bb[4];
#pragma unroll
            for (int tt = 0; tt < 4; ++tt) bb[tt] = *(const LAS bf16x8*)(lds + (16 * tt + fr) * ACT_ST + (COFF + 32 * ks + 8 * fq) * 2);
#pragma unroll
            for (int ct = 0; ct < 4; ++ct)
#pragma unroll
                for (int tt = 0; tt < 4; ++tt) acc[ct][tt] = mfma16(wa[ks][ct], bb[tt], acc[ct][tt]); }
        if constexpr (PASS == 0 || PASS == 2) {
            lds_t* as_ = lds + AS_OFF + wid * AS_WAVE;
#pragma unroll
            for (int ct = 0; ct < 4; ++ct) { const int c = cb + 16 * ct + 4 * fq; const f32x4 w0 = prm4(lds, 7, c);
#pragma unroll
                for (int tt = 0; tt < 4; ++tt) { f32x4 o = acc[ct][tt];
                    if (PASS == 0) {
#pragma unroll
                        for (int e = 0; e < 4; ++e) { const float dw = acc[ct][tt][e] + w0[e]; o[e] = -__expf(-softplusf_(-dw) - 0.5f); } }
                    *(LAS u32x2*)(as_ + (16 * tt + fr) * AS_ST + (16 * ct + 4 * fq) * 2) = pack4(o); } }
            asm volatile("s_waitcnt lgkmcnt(0)" ::: "memory");
            bf16* dst = (PASS == 0) ? B.LD : B.G; const int ch8 = lane & 7, tg = lane >> 3;
#pragma unroll
            for (int i = 0; i < 8; ++i) { const int tok = tg + 8 * i; *(u32x4*)(dst + (m0 + tok) * 1024 + cb + 8 * ch8) = *(const LAS u32x4*)(as_ + tok * AS_ST + ch8 * 16); }
            asm volatile("s_waitcnt lgkmcnt(0)" ::: "memory");
        } else {
            lds_t* as_ = lds + AS_OFF + wid * AS_WAVE;
#pragma unroll
            for (int ct = 0; ct < 4; ++ct) { const f32x4 a0 = prm4(lds, 4, cb + 16 * ct + 4 * fq);
#pragma unroll
                for (int tt = 0; tt < 4; ++tt) { const f32x4 v = acc[ct][tt] + a0; const u32x2 w = pack4((f32x4){sigmoidf_(v[0]), sigmoidf_(v[1]), sigmoidf_(v[2]), sigmoidf_(v[3])});
                    *(LAS u32x2*)(as_ + (16 * tt + fr) * AS_ST + (16 * ct + 4 * fq) * 2) = w; } }
            asm volatile("s_waitcnt lgkmcnt(0)" ::: "memory");
            const int ch8 = lane & 7, tg = lane >> 3; const int c = cb + 8 * ch8;
#pragma unroll 1
            for (int ib = 0; ib < 2; ++ib) { u32x4 zr[4][2], zk[4][2], zv[4][2];
#pragma unroll
                for (int i4 = 0; i4 < 4; ++i4) { const size_t m = m0 + tg + 8 * (4 * ib + i4); const bool hp = (m % SEQ) != 0; const bf16* zc = Z + m * OD_INP + c; const bf16* zp = zc - (hp ? OD_INP : 0);
                    zr[i4][0] = *(const u32x4*)zc; zr[i4][1] = *(const u32x4*)zp; zk[i4][0] = *(const u32x4*)(zc + 1024); zk[i4][1] = *(const u32x4*)(zp + 1024); zv[i4][0] = *(const u32x4*)(zc + 2048); zv[i4][1] = *(const u32x4*)(zp + 2048); }
                asm volatile("" ::: "memory");
#pragma unroll
                for (int i4 = 0; i4 < 4; ++i4) { const int tok = tg + 8 * (4 * ib + i4); const size_t m = m0 + tok; const float hpf = ((m % SEQ) != 0) ? 1.f : 0.f;
                    const u32x4 aw = *(const LAS u32x4*)(as_ + tok * AS_ST + ch8 * 16);
                    float r8[8], k8[8], v8[8], a8[8], km[8], kk[8]; float ss = 0.f, bon = 0.f;
#define PREP_TS(dst, cur, prv, which) do { const f32x4 mlo = prm4(lds, which, c), mhi = prm4(lds, which, c + 4); \
                        const float c0 = bflo_(cur.x), c1 = bfhi_(cur.x), c2 = bflo_(cur.y), c3 = bfhi_(cur.y), c4_ = bflo_(cur.z), c5 = bfhi_(cur.z), c6 = bflo_(cur.w), c7 = bfhi_(cur.w); \
                        dst[0] = c0 + (bflo_(prv.x) * hpf - c0) * mlo[0]; dst[1] = c1 + (bfhi_(prv.x) * hpf - c1) * mlo[1]; dst[2] = c2 + (bflo_(prv.y) * hpf - c2) * mlo[2]; dst[3] = c3 + (bfhi_(prv.y) * hpf - c3) * mlo[3]; \
                        dst[4] = c4_ + (bflo_(prv.z) * hpf - c4_) * mhi[0]; dst[5] = c5 + (bfhi_(prv.z) * hpf - c5) * mhi[1]; dst[6] = c6 + (bflo_(prv.w) * hpf - c6) * mhi[2]; dst[7] = c7 + (bfhi_(prv.w) * hpf - c7) * mhi[3]; } while (0)
                    PREP_TS(r8, zr[i4][0], zr[i4][1], 0); PREP_TS(k8, zk[i4][0], zk[i4][1], 1); PREP_TS(v8, zv[i4][0], zv[i4][1], 2);
#undef PREP_TS
                    a8[0] = bflo_(aw.x); a8[1] = bfhi_(aw.x); a8[2] = bflo_(aw.y); a8[3] = bfhi_(aw.y); a8[4] = bflo_(aw.z); a8[5] = bfhi_(aw.z); a8[6] = bflo_(aw.w); a8[7] = bfhi_(aw.w);
                    const f32x4 kklo = prm4(lds, 3, c), kkhi = prm4(lds, 3, c + 4), kalo = prm4(lds, 5, c), kahi = prm4(lds, 5, c + 4), rklo = prm4(lds, 6, c), rkhi = prm4(lds, 6, c + 4);
#pragma unroll
                    for (int e = 0; e < 8; ++e) { const float kkp = (e < 4) ? kklo[e & 3] : kkhi[e & 3], kap = (e < 4) ? kalo[e & 3] : kahi[e & 3], rkp = (e < 4) ? rklo[e & 3] : rkhi[e & 3];
                        kk[e] = k8[e] * kkp; ss += kk[e] * kk[e]; km[e] = k8[e] * (1.f + (a8[e] - 1.f) * kap); bon += r8[e] * km[e] * rkp; }
                    ss += __shfl_xor(ss, 1); ss += __shfl_xor(ss, 2); ss += __shfl_xor(ss, 4); bon += __shfl_xor(bon, 1); bon += __shfl_xor(bon, 2); bon += __shfl_xor(bon, 4);
                    const float inv = 1.0f / fmaxf(sqrtf(ss), 1e-12f);
                    u32x4 wr_, wv_, wkm, wkk, wbv;
                    wr_.x = pk2(r8[0], r8[1]); wr_.y = pk2(r8[2], r8[3]); wr_.z = pk2(r8[4], r8[5]); wr_.w = pk2(r8[6], r8[7]);
                    wv_.x = pk2(v8[0], v8[1]); wv_.y = pk2(v8[2], v8[3]); wv_.z = pk2(v8[4], v8[5]); wv_.w = pk2(v8[6], v8[7]);
                    wkm.x = pk2(km[0], km[1]); wkm.y = pk2(km[2], km[3]); wkm.z = pk2(km[4], km[5]); wkm.w = pk2(km[6], km[7]);
                    wkk.x = pk2(kk[0] * inv, kk[1] * inv); wkk.y = pk2(kk[2] * inv, kk[3] * inv); wkk.z = pk2(kk[4] * inv, kk[5] * inv); wkk.w = pk2(kk[6] * inv, kk[7] * inv);
                    wbv.x = pk2(kk[0] * inv * a8[0], kk[1] * inv * a8[1]); wbv.y = pk2(kk[2] * inv * a8[2], kk[3] * inv * a8[3]); wbv.z = pk2(kk[4] * inv * a8[4], kk[5] * inv * a8[5]); wbv.w = pk2(kk[6] * inv * a8[6], kk[7] * inv * a8[7]);
                    const size_t o = m * 1024 + c;
                    *(u32x4*)(B.R + o) = wr_; *(u32x4*)(B.V + o) = wv_; *(u32x4*)(B.KM + o) = wkm; *(u32x4*)(B.KK + o) = wkk; *(u32x4*)(B.BV + o) = wbv;
                    if (ch8 == 0) B.BON[m * 16 + 2 * wid + hh] = bon; }
                asm volatile("" ::: "memory"); }
        }
    }
}
__device__ __forceinline__ void ph_rwkv_prep(lds_t* lds, int vcu, int G, bf16* Z, const RwkvP& P, const RwkvW& W, const RwkvB& B) {
    const int tid = opq_((int)threadIdx.x);
    __syncthreads();
    { float pv_[16];
#pragma unroll
      for (int i = 0; i < 16; ++i) { const int idx = tid + 512 * i, which = idx >> 10, c = idx & 1023;
          const float* src = (which == 0) ? P.mu + c : (which == 1) ? P.mu + 1024 + c : (which == 2) ? P.mu + 2048 + c : (which == 3) ? P.kk + c : (which == 4) ? P.a0 + c : (which == 5) ? P.ka + c : (which == 6) ? P.rk + c : P.w0 + c;
          pv_[i] = *src; }
#pragma unroll
      for (int i = 0; i < 16; ++i) ((LAS float*)(lds + PRM_OFF))[tid + 512 * i] = pv_[i]; }
    _Pragma("unroll 1") for (int rpr_ = 0; rpr_ < RPR; ++rpr_)
    for (int u = vcu; u < M / 64; u += G) { const size_t m0 = (size_t)u * 64; const int tid = opq_((int)threadIdx.x);
        __syncthreads();
#pragma unroll 1
        for (int i0 = 0; i0 < 40; i0 += 20) { bf16 shc[20], spv[20]; float smu[20];
#pragma unroll
            for (int ii = 0; ii < 20; ++ii) { const int idx = tid + 512 * (i0 + ii), tok = idx / 320, col = idx % 320; const size_t m = m0 + tok; const int zc = OZ_HW + (col < 288 ? col : 287); const bool hp = (m % SEQ) != 0;
                shc[ii] = Z[m * OD_INP + zc]; spv[ii] = Z[(m - (hp ? 1 : 0)) * OD_INP + zc]; smu[ii] = P.mu[zc]; }
#pragma unroll
            for (int ii = 0; ii < 20; ++ii) { const int idx = tid + 512 * (i0 + ii), tok = idx / 320, col = idx % 320; const size_t m = m0 + tok; const bool hp = (m % SEQ) != 0;
                const float hc = bf2f(shc[ii]), pv = bf2f(spv[ii]) * (hp ? 1.f : 0.f); const float v = hc + (pv - hc) * smu[ii]; const float sg = 1.f / (1.f + __expf(col < 64 ? -2.f * v : -v));
                float f = (col < 64) ? (2.f * sg - 1.f) : (col < 128 ? v : sg); f = (col < 288) ? f : 0.f;
                *(LAS bf16*)(lds + tok * ACT_ST + col * 2) = (bf16)f2bf(f); } }
        __syncthreads();
        rwkv_prep_pass<0>(lds, m0, Z, P, W, B);
        rwkv_prep_pass<1>(lds, m0, Z, P, W, B);
        rwkv_prep_pass<2>(lds, m0, Z, P, W, B);
    }
    { const int tid = opq_((int)threadIdx.x); const int j8 = tid & 7, rl = tid >> 3;
      float inv[8];
#pragma unroll
      for (int e = 0; e < 8; ++e) inv[e] = powf(10000.0f, -(float)(8 * j8 + e) * (1.0f / 64.0f));
      for (int mb_ = vcu * 64; mb_ < M; mb_ += G * 64) { const int row = mb_ + rl; const int t = row % SEQ; float cs[8], sn[8];
#pragma unroll
          for (int e = 0; e < 8; ++e) { const float ang = (float)t * inv[e]; const double rev = (double)ang * 0.15915494309189535; const float frc = (float)(rev - rint(rev));
              sn[e] = __builtin_amdgcn_sinf(frc); cs[e] = __builtin_amdgcn_cosf(frc); }
#pragma unroll 1
          for (int h0 = 0; h0 < 16; h0 += 4) { u32x4 x1[4], x2[4];
#pragma unroll
              for (int k = 0; k < 4; ++k) { const bf16* p = Z + (size_t)row * OD_INP + OZ_DQ + (h0 + k) * 128 + 8 * j8; x1[k] = *(const u32x4*)p; x2[k] = *(const u32x4*)(p + 64); }
#pragma unroll
              for (int k = 0; k < 4; ++k) { float a1[8], a2[8], o1[8], o2[8];
                  a1[0] = bflo_(x1[k].x); a1[1] = bfhi_(x1[k].x); a1[2] = bflo_(x1[k].y); a1[3] = bfhi_(x1[k].y); a1[4] = bflo_(x1[k].z); a1[5] = bfhi_(x1[k].z); a1[6] = bflo_(x1[k].w); a1[7] = bfhi_(x1[k].w);
                  a2[0] = bflo_(x2[k].x); a2[1] = bfhi_(x2[k].x); a2[2] = bflo_(x2[k].y); a2[3] = bfhi_(x2[k].y); a2[4] = bflo_(x2[k].z); a2[5] = bfhi_(x2[k].z); a2[6] = bflo_(x2[k].w); a2[7] = bfhi_(x2[k].w);
#pragma unroll
                  for (int e = 0; e < 8; ++e) { o1[e] = a1[e] * cs[e] - a2[e] * sn[e]; o2[e] = a2[e] * cs[e] + a1[e] * sn[e]; }
                  u32x4 w1, w2; w1.x = pk2(o1[0], o1[1]); w1.y = pk2(o1[2], o1[3]); w1.z = pk2(o1[4], o1[5]); w1.w = pk2(o1[6], o1[7]); w2.x = pk2(o2[0], o2[1]); w2.y = pk2(o2[2], o2[3]); w2.z = pk2(o2[4], o2[5]); w2.w = pk2(o2[6], o2[7]);
                  bf16* p = Z + (size_t)row * OD_INP + OZ_DQ + (h0 + k) * 128 + 8 * j8; *(u32x4*)p = w1; *(u32x4*)(p + 64) = w2; } } } }
}
template <int CTRL> __device__ __forceinline__ float dpp_f(float v) { return __int_as_float(__builtin_amdgcn_update_dpp(0, __float_as_int(v), CTRL, 0xF, 0xF, false)); }
__device__ __forceinline__ float red16(float v) { v += dpp_f<0x128>(v); v += dpp_f<0x124>(v); v += dpp_f<0x122>(v); v += dpp_f<0x121>(v); return v; }
constexpr int SC_TB = 32, SC_BUF = SC_TB * 5 * 64 * 4, SC_VOFF = 2 * SC_BUF, SC_VBUF = SC_TB * 32 * 4, SC_YOFF = SC_VOFF + 2 * SC_VBUF, SC_LDS = SC_YOFF + SC_TB * 32 * 4;
__device__ __forceinline__ void ph_rwkv_scan(lds_t* lds, int sidx, const RwkvB& B) {
    const int tid = opq_((int)threadIdx.x), wid = tid >> 6, lane = tid & 63, rloc = wid * 4 + (lane >> 4), ks = lane & 15;
    const int b = sidx >> 5, h = (sidx >> 1) & 15, half = sidx & 1;
    const size_t rowbase = (size_t)b * SEQ * 1024 + h * 64;
    u32x4 pre[3]; u32x4 prev = (u32x4){0u, 0u, 0u, 0u};
#define SC_ISSUE(t0_) do { const int t0__ = (t0_); \
        _Pragma("unroll") for (int i = 0; i < 3; ++i) { const int q = tid + 512 * i; if (q < 1280) { const int a = q >> 8, rem = q & 255, s = rem >> 3, c8 = rem & 7; \
            const bf16* src = (a == 0) ? B.R : (a == 1) ? B.LD : (a == 2) ? B.KM : (a == 3) ? B.KK : B.BV; \
            pre[i] = *(const u32x4*)(src + rowbase + (size_t)(t0__ + s) * 1024 + 8 * c8); } } \
        if (tid < 128) { const int s = tid >> 2, c8 = tid & 3; prev = *(const u32x4*)(B.V + rowbase + (size_t)(t0__ + s) * 1024 + half * 32 + 8 * c8); } } while (0)
#define SC_COMMIT(bufi_) do { const int bufi__ = (bufi_); \
        _Pragma("unroll") for (int i = 0; i < 3; ++i) { const int q = tid + 512 * i; if (q < 1280) { const int a = q >> 8, rem = q & 255, s = rem >> 3, c8 = rem & 7; \
            f32x4 lo, hi; lo[0] = bflo_(pre[i].x); lo[1] = bfhi_(pre[i].x); lo[2] = bflo_(pre[i].y); lo[3] = bfhi_(pre[i].y); hi[0] = bflo_(pre[i].z); hi[1] = bfhi_(pre[i].z); hi[2] = bflo_(pre[i].w); hi[3] = bfhi_(pre[i].w); \
            if (a == 1) { _Pragma("unroll") for (int e = 0; e < 4; ++e) { lo[e] = __expf(lo[e]); hi[e] = __expf(hi[e]); } } \
            LAS f32x4* dst = (LAS f32x4*)(lds + bufi__ * SC_BUF + ((s * 5 + a) * 64 + 8 * c8) * 4); dst[0] = lo; dst[1] = hi; } } \
        if (tid < 128) { const int s = tid >> 2, c8 = tid & 3; f32x4 lo, hi; lo[0] = bflo_(prev.x); lo[1] = bfhi_(prev.x); lo[2] = bflo_(prev.y); lo[3] = bfhi_(prev.y); hi[0] = bflo_(prev.z); hi[1] = bfhi_(prev.z); hi[2] = bflo_(prev.w); hi[3] = bfhi_(prev.w); \
            LAS f32x4* dst = (LAS f32x4*)(lds + SC_VOFF + bufi__ * SC_VBUF + (s * 32 + 8 * c8) * 4); dst[0] = lo; dst[1] = hi; } } while (0)
    float S0 = 0.f, S1 = 0.f, S2 = 0.f, S3 = 0.f;
    __syncthreads();
    SC_ISSUE(0); SC_COMMIT(0);
    __syncthreads();
    for (int blk = 0; blk < SEQ / SC_TB; ++blk) { const int bufi = blk & 1;
        if (blk + 1 < SEQ / SC_TB) SC_ISSUE((blk + 1) * SC_TB);
        const lds_t* bp = lds + bufi * SC_BUF; const lds_t* vp = lds + SC_VOFF + bufi * SC_VBUF;
#define SC_LOAD(R4, W4, M4, K4, B4, VV, s_) do { const LAS f32x4* sp_ = (const LAS f32x4*)(bp + (s_) * 5 * 64 * 4) + ks; R4 = sp_[0]; W4 = sp_[16]; M4 = sp_[32]; K4 = sp_[48]; B4 = sp_[64]; VV = ((const LAS float*)vp)[(s_) * 32 + rloc]; } while (0)
#define SC_STEP(R4, W4, M4, K4, B4, VV, s_) do { \
            const float sa_ = -red16((S0 * K4[0] + S1 * K4[1]) + (S2 * K4[2] + S3 * K4[3])); \
            S0 = S0 * W4[0] + (sa_ * B4[0] + VV * M4[0]); S1 = S1 * W4[1] + (sa_ * B4[1] + VV * M4[1]); S2 = S2 * W4[2] + (sa_ * B4[2] + VV * M4[2]); S3 = S3 * W4[3] + (sa_ * B4[3] + VV * M4[3]); \
            const float y_ = red16((S0 * R4[0] + S1 * R4[1]) + (S2 * R4[2] + S3 * R4[3])); \
            ((LAS float*)(lds + SC_YOFF))[(s_) * 32 + rloc] = y_; } while (0)
        { f32x4 ra, wa, ma, ka, ba, rb, wb, mb, kb, bb; float va, vb;
          SC_LOAD(ra, wa, ma, ka, ba, va, 0); SC_LOAD(rb, wb, mb, kb, bb, vb, 1);
#pragma unroll
          for (int s = 0; s < SC_TB; s += 2) {
              SC_STEP(ra, wa, ma, ka, ba, va, s);
              if (s + 2 < SC_TB) SC_LOAD(ra, wa, ma, ka, ba, va, s + 2);
              SC_STEP(rb, wb, mb, kb, bb, vb, s + 1);
              if (s + 3 < SC_TB) SC_LOAD(rb, wb, mb, kb, bb, vb, s + 3);
          } }
        __syncthreads();
        if (tid < 128) { const int s = tid >> 2, c8 = tid & 3; const LAS f32x4* yp = (const LAS f32x4*)(lds + SC_YOFF + (s * 32 + 8 * c8) * 4); const f32x4 a = yp[0], c = yp[1];
            u32x4 o; o.x = pk2(a[0], a[1]); o.y = pk2(a[2], a[3]); o.z = pk2(c[0], c[1]); o.w = pk2(c[2], c[3]);
            *(u32x4*)(B.Y + rowbase + (size_t)(blk * SC_TB + s) * 1024 + half * 32 + 8 * c8) = o; }
        if (blk + 1 < SEQ / SC_TB) SC_COMMIT(bufi ^ 1);
        __syncthreads();
    }
}
__device__ __forceinline__ float red16x(float v) { v += __shfl_xor(v, 1); v += __shfl_xor(v, 2); v += __shfl_xor(v, 4); v += __shfl_xor(v, 8); return v; }
struct DilP { bf16* O1; float* ML0; };
__device__ __forceinline__ void ph_rwkv_fin(int vcu, int G, const RwkvP& P, const RwkvB& B, const DilP& D, bf16* __restrict__ MIX) {
    const int tix_ = opq_((int)threadIdx.x); const int wid = tix_ >> 6, lane = tix_ & 63;
    for (int task = vcu * 8 + wid; task < M * 4; task += G * 8) { const size_t m = task >> 2; const int c = (task & 3) * 256 + 4 * lane; const size_t o = m * 1024 + c;
        const f32x4 y = unpack4(*(const u32x2*)(B.Y + o)), v = unpack4(*(const u32x2*)(B.V + o)), g = unpack4(*(const u32x2*)(B.G + o));
        const f32x4 lw = *(const f32x4*)(P.lnw + c), lb = *(const f32x4*)(P.lnb + c);
        const float mean = red16x((y[0] + y[1]) + (y[2] + y[3])) * (1.0f / 64.0f); const f32x4 dy = y - mean;
        const float var = red16x((dy[0] * dy[0] + dy[1] * dy[1]) + (dy[2] * dy[2] + dy[3] * dy[3])) * (1.0f / 64.0f); const float rs = 1.0f / sqrtf(var + 64e-5f);
        const float bon = B.BON[m * 16 + (task & 3) * 4 + (lane >> 4)];
        f32x4 out;
#pragma unroll
        for (int e = 0; e < 4; ++e) out[e] = (dy[e] * rs * lw[e] + lb[e] + bon * v[e]) * g[e];
        *(u32x2*)(MIX + m * DM + c) = pack4(out);
        { const int hd = (task & 3) * 2 + (lane >> 5); const size_t ml = (m * 8 + hd) * 2;
          const float* ML1_ = D.ML0 + (size_t)M * 16; const float* ML2_ = D.ML0 + (size_t)M * 32; const float m0_ = D.ML0[ml], l0_ = D.ML0[ml + 1], m1_ = ML1_[ml], l1_ = ML1_[ml + 1], m2_ = ML2_[ml], l2_ = ML2_[ml + 1];
          const f32x4 o0 = unpack4(*(const u32x2*)(MIX + m * DM + 1024 + c)), o1 = unpack4(*(const u32x2*)(D.O1 + o)), o2 = unpack4(*(const u32x2*)(D.O1 + (size_t)M * 1024 + o));
          const float mm = fmaxf(m0_, fmaxf(m1_, m2_)); const float w0 = l0_ * __expf(m0_ - mm), w1 = l1_ * __expf(m1_ - mm), w2 = l2_ * __expf(m2_ - mm); const float iw = 1.0f / (w0 + w1 + w2);
          *(u32x2*)(MIX + m * DM + 1024 + c) = pack4((o0 * w0 + o1 * w1 + o2 * w2) * iw); } }
}
constexpr int DA_ST = 272, DA_K = 0, DA_V = 272 * DA_ST, DA_LDS = 2 * 272 * DA_ST;
__device__ __forceinline__ void ph_dil(lds_t* lds, int aidx, int NA, const bf16* __restrict__ Z, bf16* MIX, const DilP& D) {
    const int tid = opq_((int)threadIdx.x), wid = tid >> 6, lane = tid & 63, fr = lane & 15, fq = lane >> 4, lq = fr >> 2, lp = fr & 3;
    const float scale = 0.08838834764831845f;
    for (int uu = aidx; uu < 3 * BATCH * 8 * 8; uu += NA) { const int stage = uu >> 7, u = uu & 127; const int b = u >> 6, h = (u >> 3) & 7, W = u & 7;
        const size_t mb = (size_t)b * SEQ; const int dil = (stage == 0) ? 1 : (stage == 1 ? 4 : 16);
        float* MLs = D.ML0 + (size_t)stage * M * 16;
        for (int sb = 0; sb < 16; ++sb) {
            int r, qs0;
            if (stage == 0) { r = 0; qs0 = 2048 * W + 128 * sb; } else if (stage == 1) { r = sb >> 2; qs0 = 512 * W + 128 * (sb & 3); } else { r = sb; qs0 = 128 * W; }
            asm volatile("s_waitcnt lgkmcnt(0)" ::: "memory"); __builtin_amdgcn_s_barrier(); asm volatile("" ::: "memory");
            const int tid_s = opq_(tid);
            const size_t mq = mb + (size_t)(qs0 + 16 * wid + fr) * dil + r;
            bf16x8 qf[4];
            { u32x4 stg[16];
#pragma unroll
              for (int i = 0; i < 16; ++i) { const int q = tid_s + 512 * i, kv = q >> 12, rem = q & 4095, j = rem >> 4, cc = rem & 15; const int sp = qs0 - 128 + j;
                  stg[i] = *(const u32x4*)(Z + (mb + (size_t)(sp >= 0 ? sp : 0) * dil + r) * OD_INP + (kv ? OZ_DV : OZ_DK) + h * 128 + cc * 8); }
#pragma unroll
              for (int ks = 0; ks < 4; ++ks) qf[ks] = *(const bf16x8*)(Z + mq * OD_INP + OZ_DQ + h * 128 + 32 * ks + 8 * fq);
#pragma unroll
              for (int i = 0; i < 16; ++i) { const int q = tid_s + 512 * i, kv = q >> 12, rem = q & 4095, j = rem >> 4, cc = rem & 15; const int sp = qs0 - 128 + j;
                  *(LAS u32x4*)(lds + (kv ? DA_V : DA_K) + j * DA_ST + cc * 16) = (sp < 0) ? (u32x4){0u, 0u, 0u, 0u} : stg[i]; } }
            { const unsigned z0_ = (unsigned)opq_(0); const int kv = tid_s >> 8, rem = tid_s & 255, j = 256 + (rem >> 4), cc = rem & 15; *(LAS u32x4*)(lds + (kv ? DA_V : DA_K) + j * DA_ST + cc * 16) = (u32x4){z0_, z0_, z0_, z0_}; }
            asm volatile("s_waitcnt lgkmcnt(0)" ::: "memory"); __builtin_amdgcn_s_barrier(); asm volatile("" ::: "memory");
            f32x4 sc[9];
#pragma unroll
            for (int kt = 0; kt < 9; ++kt) { f32x4 a = (f32x4){0.f, 0.f, 0.f, 0.f};
#pragma unroll
                for (int ks = 0; ks < 4; ++ks) { const bf16x8 kf = *(const LAS bf16x8*)(lds + DA_K + (16 * wid + 16 * kt + fr) * DA_ST + (32 * ks + 8 * fq) * 2); a = mfma16(kf, qf[ks], a); }
                sc[kt] = a; }
            float mx = -INFINITY;
#pragma unroll
            for (int kt = 0; kt < 9; ++kt)
#pragma unroll
                for (int e = 0; e < 4; ++e) { const int dist = 128 + fr - 16 * kt - 4 * fq - e; const int j = 16 * wid + 16 * kt + 4 * fq + e;
                    const bool ok = (dist >= 0) && (dist <= 128) && (qs0 - 128 + j >= 0);
                    const float sv = ok ? sc[kt][e] * scale : -INFINITY; sc[kt][e] = sv; mx = fmaxf(mx, sv); }
            mx = fmaxf(mx, __shfl_xor(mx, 16)); mx = fmaxf(mx, __shfl_xor(mx, 32));
            float ls = 0.f;
#pragma unroll
            for (int kt = 0; kt < 9; ++kt)
#pragma unroll
                for (int e = 0; e < 4; ++e) { const float p = __expf(sc[kt][e] - mx); sc[kt][e] = p; ls += p; }
            ls += __shfl_xor(ls, 16); ls += __shfl_xor(ls, 32);
            f32x4 oacc[8];
#pragma unroll
            for (int dt = 0; dt < 8; ++dt) oacc[dt] = (f32x4){0.f, 0.f, 0.f, 0.f};
#pragma unroll
            for (int k2 = 0; k2 < 5; ++k2) { u32x4 pw; pw.x = pk2(sc[2 * k2][0], sc[2 * k2][1]); pw.y = pk2(sc[2 * k2][2], sc[2 * k2][3]);
                if (k2 < 4) { pw.z = pk2(sc[2 * k2 + 1][0], sc[2 * k2 + 1][1]); pw.w = pk2(sc[2 * k2 + 1][2], sc[2 * k2 + 1][3]); } else { pw.z = 0u; pw.w = 0u; }
                const bf16x8 pf = __builtin_bit_cast(bf16x8, pw);
#pragma unroll
                for (int dt = 0; dt < 8; ++dt) { const lds_t* p0 = lds + DA_V + (16 * wid + 32 * k2 + 4 * fq + lq) * DA_ST + (16 * dt + 4 * lp) * 2;
                    const bf16x8 vf = cat8(vtr(p0), vtr(p0 + 16 * DA_ST)); oacc[dt] = mfma16(vf, pf, oacc[dt]); } }
            const float il = 1.0f / ls;
            bf16* op = ((stage == 0) ? MIX + mq * DM + 1024 : D.O1 + (size_t)(stage - 1) * M * 1024 + mq * 1024) + h * 128 + 4 * fq;
#pragma unroll
            for (int dt = 0; dt < 8; ++dt) *(u32x2*)(op + 16 * dt) = pack4(oacc[dt] * il);
            if (fq == 0) { float* mlp = MLs + (mq * 8 + h) * 2; mlp[0] = mx; mlp[1] = ls; }
        }
    }
}

constexpr int R1_ST = 136, R1_AT = 0, R1_BT = 4352, R1_KT = 8704, R1_RT = 13056, R1_WT = 17408, R1_LDS = 17664, R1_TST = 72;
__device__ __forceinline__ bf16x8 r1_rowfrag(const lds_t* tile, int row, int ks, int fq) { const lds_t* p = tile + row * R1_ST + (32 * ks + 8 * fq) * 2; return cat8(*(const LAS s16x4*)p, *(const LAS s16x4*)(p + 8)); }
__device__ __forceinline__ bf16x8 pack8(f32x4 a, f32x4 b) { u32x4 w; w.x = pk2(a[0], a[1]); w.y = pk2(a[2], a[3]); w.z = pk2(b[0], b[1]); w.w = pk2(b[2], b[3]); return __builtin_bit_cast(bf16x8, w); }
template <bool DRY> __device__ __forceinline__ void ph_rwkv_r1(lds_t* lds, int vcu, int G, bf16* Z, const RwkvB& B) {
    float chk_ = 0.f;
    const int tid = opq_((int)threadIdx.x), wid = tid >> 6, lane = tid & 63, fr = lane & 15, fq = lane >> 4, lq = fr >> 2, lp = fr & 3;
    lds_t* wl = lds + wid * R1_LDS;
    const f32x4 zero4 = (f32x4){0.f, 0.f, 0.f, 0.f};
#pragma unroll 1
    for (int u = vcu * 8 + wid; u < 32 * 512; u += G * 8) {
        const int bh = u >> 9, c = u & 511, b = bh >> 4, h = bh & 15; const size_t m0 = (size_t)b * SEQ + (size_t)c * 32; const size_t ob = m0 * 1024 + h * 64;
        { float cum = 0.f, eprev = 1.f;
#pragma unroll 1
          for (int t0 = 0; t0 < 32; t0 += 8) { bf16 sl[8], sk[8], sb[8], sm[8], sr[8];
#pragma unroll
              for (int tt = 0; tt < 8; ++tt) { const size_t o = ob + (size_t)(t0 + tt) * 1024 + lane; sl[tt] = B.LD[o]; sk[tt] = B.KK[o]; sb[tt] = B.BV[o]; sm[tt] = B.KM[o]; sr[tt] = B.R[o]; }
#pragma unroll
              for (int tt = 0; tt < 8; ++tt) { const int t = t0 + tt; const size_t o = ob + (size_t)t * 1024 + lane;
                  const float ldv = bf2f(sl[tt]), kkv = bf2f(sk[tt]), bvv = bf2f(sb[tt]), kmv = bf2f(sm[tt]), rv = bf2f(sr[tt]);
                  cum += ldv; const float epos = __expf(cum), eneg = __expf(-cum);
                  const bf16 rt = (bf16)f2bf(rv * epos);
                  *(LAS bf16*)(wl + R1_AT + t * R1_ST + lane * 2) = (bf16)f2bf(-kkv * eprev);
                  *(LAS bf16*)(wl + R1_BT + t * R1_ST + lane * 2) = (bf16)f2bf(bvv * eneg);
                  *(LAS bf16*)(wl + R1_KT + t * R1_ST + lane * 2) = (bf16)f2bf(kmv * eneg);
                  *(LAS bf16*)(wl + R1_RT + t * R1_ST + lane * 2) = rt;
                  if (!DRY) B.LD[o] = rt; else chk_ += rv;
                  eprev = epos; } }
          *(LAS float*)(wl + R1_WT + lane * 4) = eprev; }
        bf16x8 mrbA[2], mrkA[2], lakA[2];
        { f32x4 x[2][2];
#define R1_TT(Atile, Btile, STRICT, OUT) do { \
            _Pragma("unroll") for (int ms = 0; ms < 2; ++ms) _Pragma("unroll") for (int nt = 0; nt < 2; ++nt) { f32x4 a_ = zero4; \
                _Pragma("unroll") for (int ks = 0; ks < 2; ++ks) a_ = mfma16(r1_rowfrag(wl + Atile, 16 * ms + fr, ks, fq), r1_rowfrag(wl + Btile, 16 * nt + fr, ks, fq), a_); \
                _Pragma("unroll") for (int i = 0; i < 4; ++i) { const int s_ = 16 * ms + 4 * fq + i, t_ = 16 * nt + fr; if (STRICT ? !(s_ < t_) : !(s_ <= t_)) a_[i] = 0.f; } x[ms][nt] = a_; } \
            OUT[0] = pack8(x[0][0], x[1][0]); OUT[1] = pack8(x[0][1], x[1][1]); } while (0)
          R1_TT(R1_BT, R1_RT, false, mrbA);
          R1_TT(R1_KT, R1_RT, false, mrkA);
          R1_TT(R1_KT, R1_AT, true, lakA);
#undef R1_TT
#pragma unroll
          for (int mt = 0; mt < 2; ++mt)
#pragma unroll
              for (int ns = 0; ns < 2; ++ns) { f32x4 a_ = zero4;
#pragma unroll
                  for (int ks = 0; ks < 2; ++ks) a_ = mfma16(r1_rowfrag(wl + R1_AT, 16 * mt + fr, ks, fq), r1_rowfrag(wl + R1_BT, 16 * ns + fr, ks, fq), a_);
#pragma unroll
                  for (int i = 0; i < 4; ++i) { const int t_ = 16 * mt + 4 * fq + i, s_ = 16 * ns + fr; *(LAS float*)(wl + R1_RT + (t_ * 32 + s_) * 4) = (s_ < t_) ? a_[i] : 0.f; } } }
        { const int j = lane & 31; float ci[32];
#pragma unroll
          for (int t = 0; t < 32; ++t) { float acc = (t == j) ? 1.f : 0.f;
#pragma unroll
              for (int s4 = 0; s4 < (t + 3) / 4; ++s4) { const f32x4 n4 = *(const LAS f32x4*)(wl + R1_RT + (t * 32 + 4 * s4) * 4);
#pragma unroll
                  for (int e = 0; e < 4; ++e) if (4 * s4 + e < t) acc += n4[e] * ci[4 * s4 + e]; }
              ci[t] = acc; }
#pragma unroll
          for (int t = 0; t < 32; ++t) *(LAS bf16*)(wl + R1_RT + t * R1_TST + j * 2) = (bf16)f2bf(ci[t]); }
        bf16x8 tiA[2], tiP[2];
#pragma unroll
        for (int mt = 0; mt < 2; ++mt) { const lds_t* p = wl + R1_RT + (16 * mt + fr) * R1_TST;
            tiA[mt] = cat8(*(const LAS s16x4*)(p + 16 * fq), *(const LAS s16x4*)(p + 16 * fq + 8));
            tiP[mt] = cat8(*(const LAS s16x4*)(p + 8 * fq), *(const LAS s16x4*)(p + 32 + 8 * fq)); }
        bf16x8 ahF[4];
#pragma unroll
        for (int kt = 0; kt < 4; ++kt) { const lds_t* p = wl + R1_AT + (8 * fq + lq) * R1_ST + (16 * kt + 4 * lp) * 2; const bf16x8 atB = cat8(vtr(p), vtr(p + 4 * R1_ST));
            const f32x4 a0 = mfma16(tiA[0], atB, zero4), a1 = mfma16(tiA[1], atB, zero4); ahF[kt] = pack8(a0, a1); }
        bf16x8 vF[4];
#pragma unroll
        for (int vt = 0; vt < 4; ++vt) { const bf16* vp = B.V + ob + 16 * vt + fr; bf16x8 f;
#pragma unroll
            for (int jj = 0; jj < 4; ++jj) { f[jj] = (short)vp[(size_t)(4 * fq + jj) * 1024]; f[4 + jj] = (short)vp[(size_t)(16 + 4 * fq + jj) * 1024]; }
            vF[vt] = f; }
        bf16x8 p1pF[4];
#pragma unroll
        for (int vt = 0; vt < 4; ++vt) { const f32x4 a0 = mfma16(lakA[0], vF[vt], zero4), a1 = mfma16(lakA[1], vF[vt], zero4); const bf16x8 p1F = pack8(a0, a1);
            const f32x4 c0 = mfma16(tiP[0], p1F, zero4), c1 = mfma16(tiP[1], p1F, zero4); p1pF[vt] = pack8(c0, c1); }
        asm volatile("s_waitcnt vmcnt(0)" ::: "memory");
#pragma unroll
        for (int mt = 0; mt < 2; ++mt) {
            { bf16 oldv[4][4];
#pragma unroll
              for (int kt = 0; kt < 4; ++kt)
#pragma unroll
                  for (int i = 0; i < 4; ++i) oldv[kt][i] = __builtin_nontemporal_load(B.LD + ob + (size_t)(16 * mt + 4 * fq + i) * 1024 + 16 * kt + fr);
#pragma unroll
              for (int kt = 0; kt < 4; ++kt) { const f32x4 a_ = mfma16(mrbA[mt], ahF[kt], zero4);
#pragma unroll
                  for (int i = 0; i < 4; ++i) { if (!DRY) B.LD[ob + (size_t)(16 * mt + 4 * fq + i) * 1024 + 16 * kt + fr] = (bf16)f2bf(bf2f(oldv[kt][i]) + a_[i]); else chk_ += bf2f(oldv[kt][i]) + a_[i]; } } }
#pragma unroll
            for (int vt = 0; vt < 4; ++vt) { f32x4 a_ = mfma16(mrbA[mt], p1pF[vt], zero4); a_ = mfma16(mrkA[mt], vF[vt], a_); const int v = 16 * vt + fr;
                if (!DRY) *(u32x2*)(B.KK + ob + (size_t)(v >> 1) * 1024 + (v & 1) * 32 + 16 * mt + 4 * fq) = pack4(a_); else chk_ += a_[0] + a_[1] + a_[2] + a_[3]; } }
        bf16x8 btP[4], ktP[4];
#pragma unroll
        for (int kt = 0; kt < 4; ++kt) { const lds_t* pb = wl + R1_BT + (4 * fq + lq) * R1_ST + (16 * kt + 4 * lp) * 2; btP[kt] = cat8(vtr(pb), vtr(pb + 16 * R1_ST));
            const lds_t* pk = wl + R1_KT + (4 * fq + lq) * R1_ST + (16 * kt + 4 * lp) * 2; ktP[kt] = cat8(vtr(pk), vtr(pk + 16 * R1_ST)); }
#pragma unroll
        for (int kt = 0; kt < 4; ++kt) { const int k = 16 * kt + fr; const float wk = *(const LAS float*)(wl + R1_WT + k * 4);
            bf16* prow = Z + (m0 + (k >> 1)) * OD_INP + h * 128 + (k & 1) * 64;
#pragma unroll
            for (int k2 = 0; k2 < 4; ++k2) { f32x4 a_ = mfma16(ahF[k2], btP[kt], zero4);
#pragma unroll
                for (int i = 0; i < 4; ++i) { const int kp = 16 * k2 + 4 * fq + i; a_[i] = wk * (a_[i] + ((kp == k) ? 1.f : 0.f)); }
                if (!DRY) *(u32x2*)(prow + 16 * k2 + 4 * fq) = pack4(a_); else chk_ += a_[0] + a_[1] + a_[2] + a_[3]; } }
#pragma unroll
        for (int kt = 0; kt < 4; ++kt) { const f32x4 w4 = *(const LAS f32x4*)(wl + R1_WT + (16 * kt + 4 * fq) * 4);
#pragma unroll
            for (int vt = 0; vt < 4; ++vt) { f32x4 a_ = mfma16(btP[kt], p1pF[vt], zero4); a_ = mfma16(ktP[kt], vF[vt], a_); const int v = 16 * vt + fr;
                bf16* dst = ((v < 32) ? B.BV : B.KM) + ob + (size_t)(v & 31) * 1024 + 16 * kt + 4 * fq; if (!DRY) *(u32x2*)dst = pack4(a_ * w4); else chk_ += a_[0] + a_[1] + a_[2] + a_[3]; } }
    }
    if (DRY) B.Y[(size_t)(vcu * 8 + wid) * 64 + lane] = (bf16)f2bf(chk_);
}
constexpr int R2_SLOT = 18432, R2_D = 8, R2_LDS = R2_SLOT * R2_D;
__device__ __forceinline__ void ph_rwkv_r2(lds_t* lds, int bh, int half, const bf16* __restrict__ Z, const RwkvB& B) {
    const int tid = opq_((int)threadIdx.x), wid = __builtin_amdgcn_readfirstlane(tid >> 6), lane = tid & 63, fr = lane & 15, fq = lane >> 4;
    const int b = bh >> 4, h = bh & 15;
    const size_t obase = (size_t)b * SEQ * 1024 + h * 64;
    const bool comp = wid < 2;
    const bf16* srcp[3]; size_t cstr[3];
#pragma unroll
    for (int i = 0; i < 3; ++i) { const int piece = 3 * (wid >= 2 ? wid - 2 : 0) + i, row8 = lane >> 3, ch = lane & 7;
        if (piece < 8) { const int k = 8 * piece + row8, sw = ch ^ (k & 7); srcp[i] = Z + ((size_t)b * SEQ + (k >> 1)) * OD_INP + h * 128 + (k & 1) * 64 + 8 * sw; cstr[i] = (size_t)32 * OD_INP; }
        else if (piece < 12) { const int t = 8 * (piece - 8) + row8, sw = ch ^ (t & 7); srcp[i] = B.LD + obase + (size_t)t * 1024 + 8 * sw; cstr[i] = (size_t)32 * 1024; }
        else if (piece < 16) { const int vl = 8 * (piece - 12) + row8, sw = ch ^ (vl & 7); srcp[i] = (half ? B.KM : B.BV) + obase + (size_t)vl * 1024 + 8 * sw; cstr[i] = (size_t)32 * 1024; }
        else { const int rl = 8 * (piece - 16) + row8, sw = ch ^ (rl & 7); srcp[i] = B.KK + obase + (size_t)(16 * half + rl) * 1024 + 8 * sw; cstr[i] = (size_t)32 * 1024; } }
#define R2_ISSUE(c_) do { const int c__ = (c_); lds_t* sl_ = lds + (c__ % R2_D) * R2_SLOT + 3 * (wid - 2) * 1024; \
        _Pragma("unroll") for (int i = 0; i < 3; ++i) __builtin_amdgcn_global_load_lds((const unsigned*)(srcp[i] + (size_t)c__ * cstr[i]), (LAS unsigned*)(sl_ + i * 1024), 16, 0, 0); } while (0)
    const int vl = 16 * wid + fr;
    bf16* ydst = B.Y + obase + (size_t)(4 * fq) * 1024 + 32 * half + vl;
    const int hb = (fq & 1) * 8, fh = fq >> 1;
    f32x4 X[4];
#pragma unroll
    for (int kt = 0; kt < 4; ++kt) X[kt] = (f32x4){0.f, 0.f, 0.f, 0.f};
    __syncthreads();
    if (!comp) {
#pragma unroll
        for (int c = 0; c < R2_D - 1; ++c) R2_ISSUE(c); }
#pragma unroll 1
    for (int c = 0; c < 512; ++c) {
        if (!comp) { if (c + R2_D - 1 <= 512) asm volatile("s_waitcnt vmcnt(18)" ::: "memory"); else asm volatile("s_waitcnt vmcnt(0)" ::: "memory"); }
        __builtin_amdgcn_s_barrier(); asm volatile("" ::: "memory");
        if (!comp) { if (c + R2_D - 1 < 512) R2_ISSUE(c + R2_D - 1); }
        else {
            const lds_t* sl = lds + (c % R2_D) * R2_SLOT;
            bf16x8 pm[4][2], rh[2][2]; f32x4 xn[4], y[2];
#pragma unroll
            for (int kt = 0; kt < 4; ++kt) { const int k = 16 * kt + fr; const lds_t* rp = sl + k * 128 + hb;
#pragma unroll
                for (int ks = 0; ks < 2; ++ks) { const int L = 4 * ks + fh; pm[kt][ks] = cat8(*(const LAS s16x4*)(rp + ((L ^ (k & 7)) << 4)), *(const LAS s16x4*)(rp + (((L + 2) ^ (k & 7)) << 4))); }
                const int Lq = 2 * kt + fh; xn[kt] = unpack4(*(const LAS u32x2*)(sl + 12288 + vl * 128 + ((Lq ^ (vl & 7)) << 4) + hb)); }
#pragma unroll
            for (int mt = 0; mt < 2; ++mt) { const int t = 16 * mt + fr; const lds_t* rp = sl + 8192 + t * 128 + hb;
#pragma unroll
                for (int ks = 0; ks < 2; ++ks) { const int L = 4 * ks + fh; rh[mt][ks] = cat8(*(const LAS s16x4*)(rp + ((L ^ (t & 7)) << 4)), *(const LAS s16x4*)(rp + (((L + 2) ^ (t & 7)) << 4))); }
                const int rl = vl >> 1, Lp = (vl & 1) * 4 + 2 * mt + fh; y[mt] = unpack4(*(const LAS u32x2*)(sl + 16384 + rl * 128 + ((Lp ^ (rl & 7)) << 4) + hb)); }
            const bf16x8 xb0 = pack8(X[0], X[1]), xb1 = pack8(X[2], X[3]);
#pragma unroll
            for (int kt = 0; kt < 4; ++kt) { xn[kt] = mfma16(pm[kt][0], xb0, xn[kt]); xn[kt] = mfma16(pm[kt][1], xb1, xn[kt]); }
#pragma unroll
            for (int mt = 0; mt < 2; ++mt) { y[mt] = mfma16(rh[mt][0], xb0, y[mt]); y[mt] = mfma16(rh[mt][1], xb1, y[mt]); }
#pragma unroll
            for (int kt = 0; kt < 4; ++kt) X[kt] = xn[kt];
#pragma unroll
            for (int mt = 0; mt < 2; ++mt)
#pragma unroll
                for (int i = 0; i < 4; ++i) ydst[((size_t)c * 32 + 16 * mt + i) * 1024] = (bf16)f2bf(y[mt][i]);
            asm volatile("s_waitcnt lgkmcnt(0)" ::: "memory");
        }
    }
    asm volatile("s_waitcnt vmcnt(0)" ::: "memory");
    __syncthreads();
#undef R2_ISSUE
}
__device__ __forceinline__ void ph_x0(int vcu, int G, const float* __restrict__ xin, bf16* __restrict__ xb, float* __restrict__ ss) {
    const int tix_ = opq_((int)threadIdx.x); const int wid = tix_ >> 6, lane = tix_ & 63;
    for (int row = vcu * 8 + wid; row < M; row += G * 8) {
        const f32x4* xr = (const f32x4*)(xin + (size_t)row * DM) + lane; u32x2* xo = (u32x2*)(xb + (size_t)row * DM) + lane;
        f32x4 v[8]; float s = 0.f;
#pragma unroll
        for (int j = 0; j < 8; ++j) v[j] = __builtin_nontemporal_load(xr + 64 * j);
#pragma unroll
        for (int j = 0; j < 8; ++j) { const u32x2 w = pack4(v[j]); xo[64 * j] = w; const f32x4 q = unpack4(w); s += (q[0] * q[0] + q[1] * q[1]) + (q[2] * q[2] + q[3] * q[3]); }
        s = wave_sum(s); if (lane == 0) ss[row] = s;
    }
}
__device__ __forceinline__ void ph_xss(int vcu, int G, const bf16* __restrict__ xb, float* __restrict__ ss) {
    const int tix_ = opq_((int)threadIdx.x); const int wid = tix_ >> 6, lane = tix_ & 63;
    for (int row = vcu * 8 + wid; row < M; row += G * 8) {
        const u32x2* xr = (const u32x2*)(xb + (size_t)row * DM) + lane; u32x2 w[8]; float s = 0.f;
#pragma unroll
        for (int j = 0; j < 8; ++j) w[j] = xr[64 * j];
#pragma unroll
        for (int j = 0; j < 8; ++j) { const f32x4 q = unpack4(w[j]); s += (q[0] * q[0] + q[1] * q[1]) + (q[2] * q[2] + q[3] * q[3]); }
        s = wave_sum(s); if (lane == 0) ss[row] = s;
    }
}
__device__ __forceinline__ void ph_xss_part(int vcu, int G, const float* __restrict__ ssp, float* __restrict__ ss) {
    const int tix_ = opq_((int)threadIdx.x);
    for (int row = vcu * 512 + tix_; row < M; row += G * 512) {
        const f32x4* p = (const f32x4*)(ssp + (size_t)row * 32); f32x4 v[8]; float s = 0.f;
#pragma unroll
        for (int j = 0; j < 8; ++j) v[j] = p[j];
#pragma unroll
        for (int j = 0; j < 8; ++j) s += (v[j][0] + v[j][1]) + (v[j][2] + v[j][3]);
        ss[row] = s;
    }
}
__device__ __forceinline__ void ph_norm_res(int vcu, int G, const bf16* __restrict__ y, bf16* x, const float* __restrict__ g1, float* __restrict__ rs) {
    const int tix_ = opq_((int)threadIdx.x); const int wid = tix_ >> 6, lane = tix_ & 63;
    for (int row = vcu * 8 + wid; row < M; row += G * 8) {
        const u32x2* yr = (const u32x2*)(y + (size_t)row * DM) + lane;
        u32x2* xr = (u32x2*)(x + (size_t)row * DM) + lane;
        u32x2 yw[8], xw[8];
#pragma unroll
        for (int j = 0; j < 8; ++j) { yw[j] = __builtin_nontemporal_load(yr + 64 * j); xw[j] = __builtin_nontemporal_load(xr + 64 * j); }
        f32x4 yv[8]; float s = 0.f;
#pragma unroll
        for (int j = 0; j < 8; ++j) { yv[j] = unpack4(yw[j]); s += (yv[j][0] * yv[j][0] + yv[j][1] * yv[j][1]) + (yv[j][2] * yv[j][2] + yv[j][3] * yv[j][3]); }
        s = wave_sum(s); const float rstd = 1.0f / sqrtf(s * (1.0f / DM) + 1e-6f);
        float s2 = 0.f;
#pragma unroll
        for (int j = 0; j < 8; ++j) { const f32x4 gg = ((const f32x4*)g1)[lane + 64 * j]; const u32x2 w = pack4(unpack4(xw[j]) + yv[j] * rstd * gg); xr[64 * j] = w; const f32x4 q = unpack4(w);
            s2 += (q[0] * q[0] + q[1] * q[1]) + (q[2] * q[2] + q[3] * q[3]); }
        s2 = wave_sum(s2); if (lane == 0) rs[row] = 1.0f / sqrtf(s2 * (1.0f / DM) + 1e-6f);
    }
}
__device__ __forceinline__ void wt_load(const float* __restrict__ W, const float* __restrict__ gk, int K, int N, int nblk, int item, int lane, float (&sw)[32]) {
    const int kb = item / nblk, nb = item % nblk, k0 = 64 * kb, n0 = 32 * nb; const int n = n0 + (lane & 31); const int nc = (n < N) ? n : 0;
#pragma unroll
    for (int i = 0; i < 32; ++i) { const int kk = 2 * i + (lane >> 5); const int kr = (k0 + kk < K) ? k0 + kk : 0; sw[i] = __builtin_nontemporal_load(W + (size_t)kr * N + nc) * (gk ? gk[kr] : 1.f); }
}
__device__ __forceinline__ void wt_store(int K, int N, bf16* __restrict__ Wt, int Kpad, int nblk, LAS float* scr, int item, int lane, const float (&sw)[32]) {
    const int kb = item / nblk, nb = item % nblk, k0 = 64 * kb, n0 = 32 * nb; const bool nok = n0 + (lane & 31) < N;
#pragma unroll
    for (int i = 0; i < 32; ++i) { const int kk = 2 * i + (lane >> 5); scr[kk * 33 + (lane & 31)] = (nok && k0 + kk < K) ? sw[i] : 0.f; }
    asm volatile("s_waitcnt lgkmcnt(0)" ::: "memory");
    const int c = lane & 7;
#pragma unroll
    for (int j = 0; j < 4; ++j) { const int n = (lane >> 3) + 8 * j; const LAS float* s = scr + (8 * c) * 33 + n;
        u32x4 o; o.x = pk2(s[0 * 33], s[1 * 33]); o.y = pk2(s[2 * 33], s[3 * 33]); o.z = pk2(s[4 * 33], s[5 * 33]); o.w = pk2(s[6 * 33], s[7 * 33]);
        *(u32x4*)(Wt + (size_t)(n0 + n) * Kpad + k0 + 8 * c) = o; }
    asm volatile("s_waitcnt lgkmcnt(0)" ::: "memory");
}
struct WtJob { const float* W; bf16* Wt; const float* gk; int K, N, Kpad, Npad; };
__device__ __forceinline__ void ph_wt(lds_t* lds, int gw, int NGW, const WtJob& jb, int& base) {
    const int nblk = jb.Npad / 32, nitems = (jb.Kpad / 64) * nblk; const int tix_ = opq_((int)threadIdx.x); const int lane = tix_ & 63;
    LAS float* scr = (LAS float*)(lds + (tix_ >> 6) * 16384);
    int first = (gw - base % NGW + NGW) % NGW;
#pragma unroll 1
    for (int it = first; it < nitems; it += 2 * NGW) { float sa[32], sb[32]; const bool two = it + NGW < nitems;
        wt_load(jb.W, jb.gk, jb.K, jb.N, nblk, it, lane, sa); if (two) wt_load(jb.W, jb.gk, jb.K, jb.N, nblk, it + NGW, lane, sb);
        wt_store(jb.K, jb.N, jb.Wt, jb.Kpad, nblk, scr, it, lane, sa); if (two) wt_store(jb.K, jb.N, jb.Wt, jb.Kpad, nblk, scr, it + NGW, lane, sb); }
    base += nitems;
}
#define XB_TMO      128
#define XB_XCNT(j)  (256  + 64 * (j))
#define XB_XSUB(j)  (1280 + 64 * (j))
#define XB_XGEN(j)  (2304 + 64 * (j))
#define XB_TOP      3328
#define XB_TOPGEN   3392
#define XCD_BAR_WORDS 3456
#define XB_SPIN_CAP (1u << 18)

__device__ __forceinline__ unsigned xb_ld(unsigned* p)              { return __hip_atomic_load(p, __ATOMIC_RELAXED, __HIP_MEMORY_SCOPE_AGENT); }
__device__ __forceinline__ unsigned xb_add(unsigned* p, unsigned v) { return __hip_atomic_fetch_add(p, v, __ATOMIC_RELAXED, __HIP_MEMORY_SCOPE_AGENT); }
__device__ __forceinline__ unsigned xb_xcc_id() { return (unsigned)__builtin_amdgcn_s_getreg((3 << 11) | 20) & 0xFu; }
#define XB_SPIN(cond, bar) do { unsigned _sp = 0; while (cond) { __builtin_amdgcn_s_sleep(1); \
    if ((++_sp & 255u) == 0u) { if (xb_ld(&(bar)[XB_TMO])) break; if (_sp > XB_SPIN_CAP) { atomicAdd(&(bar)[XB_TMO], 1u); break; } } } } while (0)

struct XcdBarrier {
    unsigned* bar; unsigned x;
    volatile LAS unsigned* st;
};

__device__ __forceinline__ XcdBarrier xcd_barrier_post(unsigned* bar, volatile LAS unsigned* st) {
    XcdBarrier b; b.bar = bar; b.x = xb_xcc_id(); b.st = st;
    if (threadIdx.x == 0) (void)xb_add(&bar[XB_XCNT(b.x)], 1u);
    return b;
}
__device__ __forceinline__ void xcd_barrier_complete(unsigned* bar, unsigned x, unsigned& nloc, unsigned& nx) {
    const unsigned G = gridDim.x * gridDim.y * gridDim.z;
    unsigned sum, cnt, mine, sp = 0u;
    for (;;) {
        sum = 0u; cnt = 0u; mine = 0u;
#pragma unroll
        for (unsigned j = 0; j < 16; ++j) { const unsigned c = xb_ld(&bar[XB_XCNT(j)]); sum += c; cnt += (c > 0u) ? 1u : 0u; mine = (j == x) ? c : mine; }
        if (sum == G) break;
        __builtin_amdgcn_s_sleep(1);
        if ((++sp & 255u) == 0u) { if (xb_ld(&bar[XB_TMO])) break; if (sp > XB_SPIN_CAP) { atomicAdd(&bar[XB_TMO], 1u); break; } }
    }
    nloc = mine > 0u ? mine : 1u; nx = cnt > 0u ? cnt : 1u;
}

__device__ __forceinline__ void xcd_barrier(const XcdBarrier& b) {
    asm volatile("s_waitcnt vmcnt(0)" ::: "memory");
    __syncthreads();
    if (threadIdx.x == 0) {
        unsigned* bar = b.bar;
        __builtin_amdgcn_s_waitcnt(0);
        unsigned nloc = b.st[0], nx = b.st[1];
        if (nloc == 0u) { xcd_barrier_complete(bar, b.x, nloc, nx); b.st[0] = nloc; b.st[1] = nx; }
        const unsigned old = xb_add(&bar[XB_XSUB(b.x)], 1u);
        const unsigned gen = old / nloc;
        if (old + 1u == (gen + 1u) * nloc) {
            __builtin_amdgcn_fence(__ATOMIC_RELEASE, "agent");
            asm volatile("s_waitcnt vmcnt(0)" ::: "memory");
            const unsigned og = xb_add(&bar[XB_TOP], 1u);
            const unsigned tg = og / nx;
            if (og + 1u == (tg + 1u) * nx) xb_add(&bar[XB_TOPGEN], 1u);
            else XB_SPIN(xb_ld(&bar[XB_TOPGEN]) == tg, bar);
            __builtin_amdgcn_fence(__ATOMIC_ACQUIRE, "agent");
            xb_add(&bar[XB_XGEN(b.x)], 1u);
            asm volatile("s_waitcnt vmcnt(0)" ::: "memory");
        } else {
            XB_SPIN(xb_ld(&bar[XB_XGEN(b.x)]) == gen, bar);
            __builtin_amdgcn_fence(__ATOMIC_ACQUIRE, "agent");
            asm volatile("s_waitcnt vmcnt(0)" ::: "memory");
        }
    }
    __syncthreads();
}

constexpr int LDS_MISC = 155648, LDS_BYTES = LDS_MISC + 256;
constexpr int CW_BAR = 4096;
constexpr size_t CTL_ZERO_BYTES = 1024 * 1024;
constexpr size_t CTL_SS = 256 * 1024  , CTL_RSA = 768 * 1024  , CTL_RSB = 896 * 1024  ;
constexpr int NPH = 12;
struct MKArgs { const float* in[31]; float* out; unsigned char* ws; int lo, hi; };
typedef __attribute__((address_space(4))) const unsigned long long kq_t;
__device__ __forceinline__ kq_t* karg_() { kq_t* p = (kq_t*)__builtin_amdgcn_kernarg_segment_ptr(); asm volatile("" : "+s"(p)); return p; }
#define GASP __attribute__((address_space(1)))
#define INP(k) ((const float*)(const GASP float*)karg_()[(k)])
#define OUTP() ((float*)(GASP float*)karg_()[31])
#define OUTB() ((unsigned char*)(GASP unsigned char*)karg_()[31])
#define WSP() ((unsigned char*)(GASP unsigned char*)karg_()[32])
__device__ __forceinline__ RwkvP mk_rwkvp(int j) { RwkvP P; P.mu = INP(15) + (size_t)j * 3360; P.w0 = INP(16) + (size_t)j * 1024; P.w2 = INP(17) + (size_t)j * 64 * 1024; P.a0 = INP(18) + (size_t)j * 1024; P.a2 = INP(19) + (size_t)j * 64 * 1024;
    P.g2 = INP(20) + (size_t)j * 160 * 1024; P.kk = INP(21) + (size_t)j * 1024; P.ka = INP(22) + (size_t)j * 1024; P.rk = INP(23) + (size_t)j * 1024; P.lnw = INP(24) + (size_t)j * 1024; P.lnb = INP(25) + (size_t)j * 1024; return P; }
__device__ __forceinline__ RwkvW mk_rwkvw(unsigned char* ws) { RwkvW RW; RW.W2T = (bf16*)(ws + WS_SMALL); RW.A2T = RW.W2T + 1024 * 64; RW.G2T = RW.A2T + 1024 * 64; return RW; }
__device__ __forceinline__ RwkvB mk_rwkvb(unsigned char* ws) { RwkvB RB; RB.R = (bf16*)(ws + WS_H); RB.LD = (bf16*)(ws + WS_H + SLOT); RB.KM = (bf16*)(OUTB() + 2 * SLOT); RB.KK = (bf16*)(OUTB() + 3 * SLOT);
    RB.BV = (bf16*)(ws + WS_T_OD); RB.V = (bf16*)(ws + WS_T_OD + SLOT); RB.G = (bf16*)(ws + WS_T_OD + 2 * SLOT); RB.Y = (bf16*)(ws + WS_T_OD + 3 * SLOT); RB.BON = (float*)(ws + WS_ML + 6 * MiB); return RB; }
__global__ void __launch_bounds__(512, 2) mk_fwd(MKArgs a_unused) {
    extern __shared__ __attribute__((aligned(16))) unsigned char lds_raw[]; lds_t* lds = (lds_t*)lds_raw;
    const int G = gridDim.x, bx = blockIdx.x;
    const int vcu = (G % 8 == 0) ? (bx % 8) * (G / 8) + bx / 8 : bx;
    if (threadIdx.x < 64) ((LAS unsigned*)(lds + LDS_MISC))[threadIdx.x] = 0u;
    __syncthreads();
    (void)xcd_barrier_post((unsigned*)(WSP() + WS_CTL) + CW_BAR, (volatile LAS unsigned*)(lds + LDS_MISC));
    const int lo = ((const int*)&a_unused.lo)[0], hi = a_unused.hi;
#define PH(p) (lo <= (p) && (p) < hi)
#define SEAM(p) do { if (PH(p) && PH((p) + 1)) { XcdBarrier b_; b_.bar = (unsigned*)(WSP() + WS_CTL) + CW_BAR; b_.x = xb_xcc_id(); b_.st = (volatile LAS unsigned*)(lds + LDS_MISC); xcd_barrier(b_); if (RBAR > 1) xcd_barrier(b_); } } while (0)
#define WS_(off) (ws + (off))
#pragma unroll 1
    for (int layer = 0; layer < DEPTH; ++layer) {
        const int j = layer >> 1; const bool odd = (layer & 1) != 0; const int pb = layer * NPH; const int NZ = odd ? OD_INP : EV_INP;
#define XCUR() ((bf16*)(odd ? WSP() + WS_XB : OUTB()))
#define YCUR() ((bf16*)(odd ? OUTB() : WSP() + WS_XB))
        if (PH(pb + 0)) {
            unsigned char* ws = WSP(); const int tid = opq_((int)threadIdx.x), wid = tid >> 6;
            const int gw = opqs_(vcu) * 8 + wid, NGW = opqs_(G) * 8;
            _Pragma("unroll 1") for (int rep0_ = 0; rep0_ < R0; ++rep0_) { int base = 0;
            __syncthreads();
            { WtJob jb; jb.gk = nullptr; if (odd) { jb.W = INP(13) + (size_t)j * DM * OD_IN; jb.N = OD_IN; } else { jb.W = INP(6) + (size_t)j * DM * EV_IN; jb.N = EV_IN; } jb.Wt = (bf16*)WS_(WS_WIN); jb.gk = INP(2) + (size_t)layer * DM; jb.K = DM; jb.Kpad = DM; jb.Npad = NZ; ph_wt(lds, gw, NGW, jb, base); }
            { WtJob jb; jb.gk = nullptr; jb.W = (odd ? INP(14) : INP(7)) + (size_t)j * DM * DM; jb.Wt = (bf16*)WS_(WS_WOUT); jb.K = DM; jb.N = DM; jb.Kpad = DM; jb.Npad = DM; ph_wt(lds, gw, NGW, jb, base); }
            { WtJob jb; jb.gk = nullptr; jb.W = INP(26) + (size_t)layer * DM * DFF; jb.Wt = (bf16*)WS_(WS_WUP); jb.gk = INP(4) + (size_t)layer * DM; jb.K = DM; jb.N = DFF; jb.Kpad = DM; jb.Npad = DFF; ph_wt(lds, gw, NGW, jb, base); }
            { WtJob jb; jb.gk = nullptr; jb.W = INP(27) + (size_t)layer * DFF * DM; jb.Wt = (bf16*)WS_(WS_WDN); jb.K = DFF; jb.N = DM; jb.Kpad = DFF; jb.Npad = DM; ph_wt(lds, gw, NGW, jb, base); }
            { WtJob jb; jb.gk = nullptr; jb.W = INP(29) + (size_t)layer * DM * DM; jb.Wt = (bf16*)WS_(WS_WGT); jb.gk = INP(30) + (size_t)layer * DM; jb.K = DM; jb.N = DM; jb.Kpad = DM; jb.Npad = DM; ph_wt(lds, gw, NGW, jb, base); }
            { WtJob jb; jb.gk = nullptr; jb.W = INP(28) + (size_t)layer * PLE * DM; jb.Wt = (bf16*)WS_(WS_WPJ); jb.K = PLE; jb.N = DM; jb.Kpad = PLE; jb.Npad = DM; ph_wt(lds, gw, NGW, jb, base); }
            if (odd) {
                const RwkvW RW = mk_rwkvw(ws);
                { WtJob jb; jb.gk = nullptr; jb.W = INP(17) + (size_t)j * 64 * 1024; jb.Wt = (bf16*)RW.W2T; jb.K = 64; jb.N = 1024; jb.Kpad = 64; jb.Npad = 1024; ph_wt(lds, gw, NGW, jb, base); }
                { WtJob jb; jb.gk = nullptr; jb.W = INP(19) + (size_t)j * 64 * 1024; jb.Wt = (bf16*)RW.A2T; jb.K = 64; jb.N = 1024; jb.Kpad = 64; jb.Npad = 1024; ph_wt(lds, gw, NGW, jb, base); }
                { WtJob jb; jb.gk = nullptr; jb.W = INP(20) + (size_t)j * 160 * 1024; jb.Wt = (bf16*)RW.G2T; jb.K = 160; jb.N = 1024; jb.Kpad = 192; jb.Npad = 1024; ph_wt(lds, gw, NGW, jb, base); }
            }
            { const f32x4* ps = (const f32x4*)(INP(1) + (size_t)layer * M * PLE); u32x2* pd = (u32x2*)WS_(WS_PB);
              for (size_t i = (size_t)opqs_(vcu) * 512 + tid; i < (size_t)M * PLE / 4; i += (size_t)opqs_(G) * 512) pd[i] = pack4(__builtin_nontemporal_load(ps + i)); }
            if (layer == 0) ph_x0(opqs_(vcu), opqs_(G), INP(0), XCUR(), (float*)WS_(WS_CTL + CTL_SS)); else ph_xss_part(opqs_(vcu), opqs_(G), (const float*)WS_(WS_T_EV), (float*)WS_(WS_CTL + CTL_SS) + (size_t)layer * M); }
        }
        SEAM(pb + 0);
        if (PH(pb + 1)) { unsigned char* ws = WSP(); pg8::Gemm g; g.A = XCUR(); g.Bt = (const bf16*)WS_(WS_WIN); g.M = M; g.N = NZ; g.K = DM; pg8::StaticOrder S; S.init(M, NZ, opqs_(G), opqs_(bx)); pg8::EpiBf16<0> E{(bf16*)WS_(WS_Z), NZ, (const float*)WS_(WS_CTL + CTL_SS) + (size_t)layer * M, 2};
            pg8::gemm_phase<pg8::EpiBf16<0>, pg8::StaticOrder, true, true>(lds, g, S, E);
#if RG == 2
            __syncthreads(); pg8::gemm_phase<pg8::EpiBf16<0>, pg8::StaticOrder, true, true>(lds, g, S, E);
#endif
            }
        SEAM(pb + 1);
        if (!odd) {
            if (PH(pb + 2)) { unsigned char* ws = WSP(); bf16* Z = (bf16*)WS_(WS_Z); bf16* MIX = (bf16*)WS_(WS_MIX);
                              _Pragma("unroll 1") for (int rep_ = 0; rep_ < REP; ++rep_) ph_pool(lds, opqs_(vcu), opqs_(G), Z, INP(8) + (size_t)j * 4 * 128 * 128, INP(9) + (size_t)j * 512, MIX);
                              if (RE1 > 2) ph_gla1<false>(lds, opqs_(vcu), opqs_(G), Z, INP(10) + (size_t)j * 16 * 768, INP(11) + (size_t)j * 768, (bf16*)(OUTB() + 2 * SLOT), (bf16*)WS_(WS_H), (bf16*)WS_(WS_T_EV), (float*)WS_(WS_DEC));
                              if (RE1 == 2) ph_gla1<true>(lds, opqs_(vcu), opqs_(G), Z, INP(10) + (size_t)j * 16 * 768, INP(11) + (size_t)j * 768, (bf16*)(OUTB() + 2 * SLOT), (bf16*)WS_(WS_H), (bf16*)WS_(WS_T_EV), (float*)WS_(WS_DEC));
                              ph_gla1<false>(lds, opqs_(vcu), opqs_(G), Z, INP(10) + (size_t)j * 16 * 768, INP(11) + (size_t)j * 768, (bf16*)(OUTB() + 2 * SLOT), (bf16*)WS_(WS_H), (bf16*)WS_(WS_T_EV), (float*)WS_(WS_DEC)); }
            SEAM(pb + 2);
            if (PH(pb + 3)) { unsigned char* ws = WSP(); ph_gla2(opqs_(vcu), opqs_(G), (bf16*)WS_(WS_T_EV), (const float*)WS_(WS_DEC)); }
            SEAM(pb + 3);
            if (PH(pb + 4)) _Pragma("unroll 1") for (int re3_ = 0; re3_ < RE3; ++re3_) { unsigned char* ws = WSP(); ph_gla3(lds, opqs_(vcu), opqs_(G), (const bf16*)WS_(WS_Z), (const bf16*)WS_(WS_T_EV), INP(12) + (size_t)j * 384, (const bf16*)(OUTB() + 2 * SLOT), (const bf16*)WS_(WS_H), (bf16*)WS_(WS_MIX)); }
            SEAM(pb + 4);
        } else {
            if (PH(pb + 2)) { unsigned char* ws = WSP(); const RwkvP P = mk_rwkvp(j); const RwkvW RW = mk_rwkvw(ws); const RwkvB RB = mk_rwkvb(ws); ph_rwkv_prep(lds, opqs_(vcu), opqs_(G), (bf16*)WS_(WS_Z), P, RW, RB); }
            SEAM(pb + 2);
            if (PH(pb + 3)) { unsigned char* ws = WSP(); const RwkvB RB = mk_rwkvb(ws); if (RR1 > 1) ph_rwkv_r1<true>(lds, opqs_(vcu), opqs_(G), (bf16*)WS_(WS_Z), RB); ph_rwkv_r1<false>(lds, opqs_(vcu), opqs_(G), (bf16*)WS_(WS_Z), RB); }
            SEAM(pb + 3);
            if (PH(pb + 4)) { unsigned char* ws = WSP();
                if (opqs_(bx) < 64) { const RwkvB RB = mk_rwkvb(ws); const int bx_ = opqs_(bx); _Pragma("unroll 1") for (int r2_ = 0; r2_ < RSC; ++r2_) ph_rwkv_r2(lds, (bx_ & 7) + 8 * (bx_ >> 4), (bx_ >> 3) & 1, (const bf16*)WS_(WS_Z), RB); }
                else { DilP D; D.O1 = (bf16*)OUTB(); D.ML0 = (float*)WS_(WS_ML);
                    _Pragma("unroll 1") for (int r3_ = 0; r3_ < RAT; ++r3_) ph_dil(lds, opqs_(bx) - 64, opqs_(G) - 64, (const bf16*)WS_(WS_Z), (bf16*)WS_(WS_MIX), D); } }
            SEAM(pb + 4);
            if (PH(pb + 5)) { unsigned char* ws = WSP(); const RwkvP P = mk_rwkvp(j); const RwkvB RB = mk_rwkvb(ws); DilP D; D.O1 = (bf16*)OUTB(); D.ML0 = (float*)WS_(WS_ML);
                ph_rwkv_fin(opqs_(vcu), opqs_(G), P, RB, D, (bf16*)WS_(WS_MIX)); }
            SEAM(pb + 5);
        }
        if (PH(pb + 6)) { unsigned char* ws = WSP(); pg8::Gemm g; g.A = (const bf16*)WS_(WS_MIX); g.Bt = (const bf16*)WS_(WS_WOUT); g.M = M; g.N = DM; g.K = DM; pg8::StaticOrder S; S.init(M, DM, opqs_(G), opqs_(bx)); pg8::EpiBf16<0> E{YCUR(), DM, nullptr, 0};
            pg8::gemm_phase<pg8::EpiBf16<0>, pg8::StaticOrder, true, true>(lds, g, S, E);
#if RG == 2
            __syncthreads(); pg8::gemm_phase<pg8::EpiBf16<0>, pg8::StaticOrder, true, true>(lds, g, S, E);
#endif
            }
        SEAM(pb + 6);
        if (PH(pb + 7)) { unsigned char* ws = WSP(); ph_norm_res(opqs_(vcu), opqs_(G), YCUR(), XCUR(), INP(3) + (size_t)layer * DM, (float*)WS_(WS_CTL + CTL_RSA)); }
        SEAM(pb + 7);
#pragma unroll 1
        for (int fs_ = 0; fs_ < FSPL; ++fs_) { const int fs = opqs_(fs_); constexpr int MS = M / FSPL;
            if (PH(pb + 8)) { unsigned char* ws = WSP(); pg8::Gemm g; g.A = XCUR() + (size_t)fs * MS * DM; g.Bt = (const bf16*)WS_(WS_WUP); g.M = MS; g.N = DFF; g.K = DM; pg8::StaticOrder S; S.init(MS, DFF, opqs_(G), opqs_(bx)); pg8::EpiBf16<2> E{(bf16*)WS_(WS_HID) + (size_t)fs * MS * DFF, DFF, (const float*)WS_(WS_CTL + CTL_RSA) + (size_t)fs * MS, 1};
                pg8::gemm_phase<pg8::EpiBf16<2>, pg8::StaticOrder, true, true>(lds, g, S, E); }
            SEAM(pb + 8);
            if (PH(pb + 9)) { unsigned char* ws = WSP(); pg8::Gemm g; g.A = (const bf16*)WS_(WS_HID) + (size_t)fs * MS * DFF; g.Bt = (const bf16*)WS_(WS_WDN); g.M = MS; g.N = DM; g.K = DFF; pg8::StaticOrder S; S.init(MS, DM, opqs_(G), opqs_(bx)); pg8::EpiBf16<0> E{YCUR() + (size_t)fs * MS * DM, DM, nullptr, 0};
                pg8::gemm_phase<pg8::EpiBf16<0>, pg8::StaticOrder, true, true>(lds, g, S, E); }
        }
        SEAM(pb + 9);
        if (PH(pb + 10)) { unsigned char* ws = WSP(); ph_norm_res(opqs_(vcu), opqs_(G), YCUR(), XCUR(), INP(5) + (size_t)layer * DM, (float*)WS_(WS_CTL + CTL_RSB));
            __syncthreads();
            pg8::Gemm g; g.A = (const bf16*)WS_(WS_PB); g.Bt = (const bf16*)WS_(WS_WPJ); g.M = M; g.N = DM; g.K = PLE; pg8::StaticOrder S; S.init(M, DM, opqs_(G), opqs_(bx)); pg8::EpiBf16<0> E{(bf16*)WS_(WS_MIX), DM, nullptr, 0};
            pg8::gemm_phase<pg8::EpiBf16<0>, pg8::StaticOrder, true, true>(lds, g, S, E);
#if RG == 2
            __syncthreads(); pg8::gemm_phase<pg8::EpiBf16<0>, pg8::StaticOrder, true, true>(lds, g, S, E);
#endif
            }
        SEAM(pb + 10);
        if (PH(pb + 11)) { unsigned char* ws = WSP(); pg8::Gemm g; g.A = XCUR(); g.Bt = (const bf16*)WS_(WS_WGT); g.M = M; g.N = DM; g.K = DM; pg8::StaticOrder S; S.init(M, DM, opqs_(G), opqs_(bx));
            pg8::EpiGate E{(const bf16*)WS_(WS_MIX), XCUR(), YCUR(), (layer == DEPTH - 1) ? OUTP() : nullptr, (const float*)WS_(WS_CTL + CTL_RSB), (layer == DEPTH - 1) ? nullptr : (float*)WS_(WS_T_EV)  , DM};
            pg8::gemm_phase<pg8::EpiGate, pg8::StaticOrder, true, true>(lds, g, S, E); }
        SEAM(pb + 11);
    }
#undef XCUR
#undef YCUR
#undef PH
#undef SEAM
#undef WS_
}
#ifndef MK_SPLIT
#define MK_SPLIT 0
#endif
extern "C" void kernel_launch(void* const* d_in, const int* in_sizes, int n_in, void* d_out, int out_size, void* d_ws, size_t ws_size, hipStream_t stream) {
    static int grid = 0;
    if (grid == 0) {
        if (n_in != 31 || out_size != M * DM || ws_size < WS_NEED) { fprintf(stderr, "kernel_launch: unexpected shapes n_in %d out %d ws %zu\n", n_in, out_size, ws_size); grid = -1; return; }
        int dev = 0, cus = 0, per_cu = 0;
        if (hipGetDevice(&dev) != hipSuccess || hipDeviceGetAttribute(&cus, hipDeviceAttributeMultiprocessorCount, dev) != hipSuccess) { grid = -1; return; }
        if (hipFuncSetAttribute((const void*)mk_fwd, hipFuncAttributeMaxDynamicSharedMemorySize, LDS_BYTES) != hipSuccess) { fprintf(stderr, "kernel_launch: hipFuncSetAttribute failed\n"); grid = -1; return; }
        if (hipOccupancyMaxActiveBlocksPerMultiprocessor(&per_cu, (const void*)mk_fwd, 512, LDS_BYTES) != hipSuccess || per_cu < 1) fprintf(stderr, "kernel_launch: occupancy query says %d\n", per_cu);
        (void)hipGetLastError();
        grid = cus;
        if (grid != 256) fprintf(stderr, "kernel_launch: note: %d CUs\n", grid);
    }
    if (grid < 0) return;
    if (hipMemsetAsync((char*)d_ws + WS_CTL, 0, CTL_ZERO_BYTES, stream) != hipSuccess) return;
    MKArgs a{};
    for (int i = 0; i < 31; ++i) a.in[i] = (const float*)d_in[i];
    a.out = (float*)d_out; a.ws = (unsigned char*)d_ws;
#if MK_SPLIT
    for (int p = 0; p < DEPTH * NPH; ++p) { a.lo = p; a.hi = p + 1; mk_fwd<<<grid, 512, LDS_BYTES, stream>>>(a); }
#else
    a.lo = 0; a.hi = DEPTH * NPH; mk_fwd<<<grid, 512, LDS_BYTES, stream>>>(a);
#endif
}
```
